# Optimizing an MI355X kernel written in HIP

```python
import jax, jax.numpy as jnp
from jax import lax
import numpy as np

D_MODEL = 2048
BATCH = 2
SEQ = 16384
DEPTH = 1
DEC_BATCH = 4
DEC_SEQ = 2048
PAST_LEN = 128

N_ATTN_HEADS = 8
QK_NOPE_DIM = 128
QK_ROPE_DIM = 64
QK_HEAD_DIM = QK_NOPE_DIM + QK_ROPE_DIM
V_HEAD_DIM = 128
ATTN_WIDTH = N_ATTN_HEADS * V_HEAD_DIM
Q_LORA_RANK = 512
KV_LORA_RANK = 256
ROPE_BASE = 10000.0
Q_BLOCK = 128
LRU_WIDTH = D_MODEL - ATTN_WIDTH
LRU_BLOCKS = 8
LRU_BLOCK_DIM = LRU_WIDTH // LRU_BLOCKS
CONV_WIDTH = 4
CONV_PAD_LEFT = 1
CONV_PAD_RIGHT = CONV_WIDTH - 1 - CONV_PAD_LEFT
LRU_C = 8.0
MIX_WIDTH = ATTN_WIDTH + LRU_WIDTH
D_FF = -(-8 * D_MODEL // (3 * 256)) * 256
EPS = 1e-6
OFF_Q = Q_LORA_RANK
OFF_KV = OFF_Q + KV_LORA_RANK
OFF_PE = OFF_KV + QK_ROPE_DIM
OFF_LX = OFF_PE + LRU_WIDTH
IN_COLS = OFF_LX + LRU_WIDTH

kernel_name = "hymba_mla_rglru_encoder"


def rms_norm(x, g):
    xf = x.astype(jnp.float32)
    y = xf * lax.rsqrt(jnp.mean(xf * xf, axis=-1, keepdims=True) + EPS)
    return (y * g.astype(jnp.float32)).astype(x.dtype)


def rope(x, positions):
    half = QK_ROPE_DIM // 2
    inv_freq = ROPE_BASE ** (-2.0 * jnp.arange(half, dtype=jnp.float32) / QK_ROPE_DIM)
    ang = positions[:, None] * inv_freq[None, :]
    cos = jnp.cos(ang)[:, None, :]
    sin = jnp.sin(ang)[:, None, :]
    xf = x.astype(jnp.float32)
    x1, x2 = xf[..., :half], xf[..., half:]
    out = jnp.concatenate([x1 * cos - x2 * sin, x2 * cos + x1 * sin], axis=-1)
    return out.astype(x.dtype)


def block_attention(q, k, v):
    B, S, H, Dk = q.shape
    nb = S // Q_BLOCK
    qb = q.reshape(B, nb, Q_BLOCK, H, Dk).transpose(1, 0, 2, 3, 4)
    scale = QK_HEAD_DIM ** -0.5

    def one_block(qi):
        s = jnp.einsum('bqhd,bkhd->bhqk', qi, k, preferred_element_type=jnp.float32) * scale
        p = jax.nn.softmax(s, axis=-1)
        return jnp.einsum('bhqk,bkhd->bqhd', p.astype(v.dtype), v)

    o = lax.map(one_block, qb)
    return o.transpose(1, 0, 2, 3, 4).reshape(B, S, H, V_HEAD_DIM)


def mla_mixer(c_q, c_kv, k_pe, positions, q_a_norm_g, w_uq, kv_a_norm_g, w_ukv,
              q_norm_g, k_norm_g):
    B, S, _ = c_q.shape
    q = (rms_norm(c_q, q_a_norm_g) @ w_uq).reshape(B, S, N_ATTN_HEADS, QK_HEAD_DIM)
    kv = (rms_norm(c_kv, kv_a_norm_g) @ w_ukv).reshape(B, S, N_ATTN_HEADS, QK_NOPE_DIM + V_HEAD_DIM)
    k_nope, v = kv[..., :QK_NOPE_DIM], kv[..., QK_NOPE_DIM:]
    k_pe_h = jnp.broadcast_to(k_pe[:, :, None, :], (B, S, N_ATTN_HEADS, QK_ROPE_DIM))
    k = jnp.concatenate([k_nope, k_pe_h], axis=-1)
    q = rms_norm(q, q_norm_g)
    k = rms_norm(k, k_norm_g)
    q = jnp.concatenate([q[..., :QK_NOPE_DIM], rope(q[..., QK_NOPE_DIM:], positions)], axis=-1)
    k = jnp.concatenate([k[..., :QK_NOPE_DIM], rope(k[..., QK_NOPE_DIM:], positions)], axis=-1)
    o = block_attention(q, k, v)
    return o.reshape(B, S, ATTN_WIDTH)


def centred_depthwise_conv(x, w, b):
    S = x.shape[1]
    xp = jnp.pad(x, ((0, 0), (CONV_PAD_LEFT, CONV_PAD_RIGHT), (0, 0)))
    y = b
    for t in range(CONV_WIDTH):
        y = y + xp[:, t:t + S] * w[t]
    return y


def block_diag(x, w, b):
    B, S, _ = x.shape
    xb = x.reshape(B, S, LRU_BLOCKS, LRU_BLOCK_DIM)
    return (jnp.einsum('bsnc,ncd->bsnd', xb, w) + b).reshape(B, S, LRU_WIDTH)


def linear_scan(a, bx, reverse):
    def combine(l, r):
        a_l, b_l = l
        a_r, b_r = r
        return a_l * a_r, a_r * b_l + b_r
    _, h = lax.associative_scan(combine, (a, bx), axis=1, reverse=reverse)
    return h


def rg_lru_direction(xf, w_r, b_r, w_i, b_i, lam, reverse):
    f32 = jnp.float32
    r = jax.nn.sigmoid(block_diag(xf, w_r.astype(f32), b_r.astype(f32)))
    i = jax.nn.sigmoid(block_diag(xf, w_i.astype(f32), b_i.astype(f32)))
    log_a = -LRU_C * r * jax.nn.softplus(-lam.astype(f32))
    a = jnp.exp(log_a)
    mult = jnp.sqrt(-jnp.expm1(2.0 * log_a))
    return linear_scan(a, mult * (i * xf), reverse)


def rglru_mixer(u_x, u_gate, conv_w, conv_b, w_rg_r, b_rg_r, w_rg_i, b_rg_i, lru_lambda):
    xc = centred_depthwise_conv(u_x, conv_w, conv_b).astype(jnp.float32)
    h = (rg_lru_direction(xc, w_rg_r[0], b_rg_r[0], w_rg_i[0], b_rg_i[0], lru_lambda[0], False)
         + rg_lru_direction(xc, w_rg_r[1], b_rg_r[1], w_rg_i[1], b_rg_i[1], lru_lambda[1], True))
    return (h * jax.nn.gelu(u_gate.astype(jnp.float32))).astype(u_x.dtype)


def encoder_layer(x, attn_norm_g, w_in, q_a_norm_g, w_uq, kv_a_norm_g, w_ukv, q_norm_g,
                  k_norm_g, conv_w, conv_b, w_rg_r, b_rg_r, w_rg_i, b_rg_i, lru_lambda,
                  attn_out_norm_g, lru_out_norm_g, w_out, ffn_norm_g, w_gate, w_up, w_down):
    S = x.shape[1]
    positions = jnp.arange(S, dtype=jnp.float32)
    h = rms_norm(x, attn_norm_g)
    u = h @ w_in
    c_q = u[..., :OFF_Q]
    c_kv = u[..., OFF_Q:OFF_KV]
    k_pe = u[..., OFF_KV:OFF_PE]
    u_x = u[..., OFF_PE:OFF_LX]
    u_gate = u[..., OFF_LX:]
    attn = mla_mixer(c_q, c_kv, k_pe, positions, q_a_norm_g, w_uq, kv_a_norm_g, w_ukv,
                     q_norm_g, k_norm_g)
    lru = rglru_mixer(u_x, u_gate, conv_w, conv_b, w_rg_r, b_rg_r, w_rg_i, b_rg_i,
                      lru_lambda)
    mixed = jnp.concatenate([rms_norm(attn, attn_out_norm_g), rms_norm(lru, lru_out_norm_g)], axis=-1)
    x = x + mixed @ w_out
    h = rms_norm(x, ffn_norm_g)
    x = x + (jax.nn.silu(h @ w_gate) * (h @ w_up)) @ w_down
    return x


def setup_inputs(seed: int = 0) -> dict:
    key = jax.random.key(seed)
    ks = jax.random.split(key, 32)
    f32 = jnp.float32

    def dense(k, shape, fan_in):
        return jax.random.normal(k, shape, f32) * fan_in ** -0.5

    def gain(k, n):
        return 1.0 + 0.01 * jax.random.normal(k, (DEPTH, n), f32)

    def small(k, shape):
        return 0.01 * jax.random.normal(k, shape, f32)

    u = jax.random.uniform(ks[18], (DEPTH, 2, LRU_WIDTH), f32, minval=0.9, maxval=0.999)
    return {
        "x_prompt": jax.random.normal(ks[0], (BATCH, SEQ, D_MODEL), f32),
        "x_sample": jax.random.normal(ks[1], (DEC_BATCH, DEC_SEQ, D_MODEL), f32),
        "attn_norm_g": gain(ks[2], D_MODEL),
        "w_in": dense(ks[3], (DEPTH, D_MODEL, IN_COLS), D_MODEL),
        "q_a_norm_g": gain(ks[4], Q_LORA_RANK),
        "w_uq": dense(ks[5], (DEPTH, Q_LORA_RANK, N_ATTN_HEADS * QK_HEAD_DIM), Q_LORA_RANK),
        "kv_a_norm_g": gain(ks[6], KV_LORA_RANK),
        "w_ukv": dense(ks[7], (DEPTH, KV_LORA_RANK, N_ATTN_HEADS * (QK_NOPE_DIM + V_HEAD_DIM)), KV_LORA_RANK),
        "q_norm_g": gain(ks[8], QK_HEAD_DIM),
        "k_norm_g": gain(ks[9], QK_HEAD_DIM),
        "conv_w": dense(ks[10], (DEPTH, CONV_WIDTH, LRU_WIDTH), CONV_WIDTH),
        "conv_b": small(ks[11], (DEPTH, LRU_WIDTH)),
        "w_rg_r": dense(ks[12], (DEPTH, 2, LRU_BLOCKS, LRU_BLOCK_DIM, LRU_BLOCK_DIM), LRU_BLOCK_DIM),
        "b_rg_r": small(ks[13], (DEPTH, 2, LRU_BLOCKS, LRU_BLOCK_DIM)),
        "w_rg_i": dense(ks[14], (DEPTH, 2, LRU_BLOCKS, LRU_BLOCK_DIM, LRU_BLOCK_DIM), LRU_BLOCK_DIM),
        "b_rg_i": small(ks[15], (DEPTH, 2, LRU_BLOCKS, LRU_BLOCK_DIM)),
        "lru_lambda": jnp.log(u) - jnp.log1p(-u),
        "attn_out_norm_g": gain(ks[16], ATTN_WIDTH),
        "lru_out_norm_g": gain(ks[17], LRU_WIDTH),
        "w_out": dense(ks[19], (DEPTH, MIX_WIDTH, D_MODEL), MIX_WIDTH),
        "ffn_norm_g": gain(ks[20], D_MODEL),
        "w_gate": dense(ks[21], (DEPTH, D_MODEL, D_FF), D_MODEL),
        "w_up": dense(ks[22], (DEPTH, D_MODEL, D_FF), D_MODEL),
        "w_down": dense(ks[23], (DEPTH, D_FF, D_MODEL), D_FF),
    }


def reference(x_prompt, x_sample, attn_norm_g, w_in, q_a_norm_g, w_uq, kv_a_norm_g, w_ukv,
              q_norm_g, k_norm_g, conv_w, conv_b, w_rg_r, b_rg_r, w_rg_i, b_rg_i, lru_lambda,
              attn_out_norm_g, lru_out_norm_g, w_out, ffn_norm_g, w_gate, w_up, w_down):
    y_prompt = x_prompt
    y_sample = x_sample
    for l in range(DEPTH):
        p = (attn_norm_g[l], w_in[l], q_a_norm_g[l], w_uq[l], kv_a_norm_g[l], w_ukv[l],
             q_norm_g[l], k_norm_g[l], conv_w[l], conv_b[l], w_rg_r[l], b_rg_r[l],
             w_rg_i[l], b_rg_i[l], lru_lambda[l], attn_out_norm_g[l], lru_out_norm_g[l],
             w_out[l], ffn_norm_g[l], w_gate[l], w_up[l], w_down[l])
        y_prompt = encoder_layer(y_prompt, *p)
        y_sample = encoder_layer(y_sample, *p)
    return (y_prompt, y_sample)
```

```cpp
#include <hip/hip_runtime.h>
#include <hip/hip_cooperative_groups.h>
#include <cstdio>
#include <cstdint>
namespace cg = cooperative_groups;

#define LAS __attribute__((address_space(3)))
typedef unsigned short bf16_t;
typedef short bf16x8 __attribute__((ext_vector_type(8)));
typedef short s16x4 __attribute__((ext_vector_type(4)));
typedef float f32x4 __attribute__((ext_vector_type(4)));
typedef float f32x2 __attribute__((ext_vector_type(2)));
typedef float f32x16 __attribute__((ext_vector_type(16)));
typedef unsigned u32x4 __attribute__((ext_vector_type(4)));
typedef unsigned u32x2 __attribute__((ext_vector_type(2)));

constexpr int M = 40960, MP = 32768, SEQP = 16384, SEQS = 2048, DM = 2048;
constexpr int LDU = 3072, UC_Q = 0, UC_KV = 512, UC_X = 768, UC_G = 1792, UC_PE = 2816;
constexpr int NH = 8, DK = 192, DV = 128, DFF = 5632;
constexpr float EPS = 1e-6f;
constexpr int NCHUNK = M / 256;

constexpr size_t MiB = 1u << 20, KiB = 1024;
constexpr size_t WS_RS1 = 0;
constexpr size_t WS_ZERO = 256 * KiB;
constexpr size_t WS_SSQ_Q = WS_ZERO, WS_SSQ_KV = WS_ZERO + 256 * KiB, WS_SSQ_PE = WS_ZERO + 512 * KiB, WS_SSQ_A = WS_ZERO + 768 * KiB,
                 WS_SSQ_L = WS_ZERO + 1024 * KiB, WS_SSQ_2 = WS_ZERO + 1280 * KiB;
constexpr size_t ZERO_BYTES = 1536 * KiB;
constexpr size_t WS_ROPE = 2 * MiB;
constexpr size_t WS_AGG = 6 * MiB;
constexpr size_t WS_BIN = 16 * MiB, WS_BUQ = 28 * MiB, WS_BUKV = 30 * MiB, WS_BRG = 31 * MiB, WS_BOUT = 32 * MiB, WS_BGU = 40 * MiB, WS_BDN = 84 * MiB;
constexpr size_t WS_XB = 112 * MiB;
constexpr size_t WS_U = 272 * MiB;
constexpr size_t WS_Q = 512 * MiB, WS_K = 632 * MiB, WS_V = 752 * MiB;
constexpr size_t WS_ACT = 512 * MiB;
constexpr size_t WS_END = 952 * MiB;

constexpr int RING_BYTES = 131072, XCH_OFF = 131072, LDS_BYTES = 147456;

struct Params {
  const float* in[24];
  float* out;
  unsigned char* ws;
};

__device__ const double INV_FREQ[32] = {1.0, 0.7498942093324559, 0.5623413251903491, 0.4216965034285822, 0.31622776601683794, 0.23713737056616552, 0.1778279410038923, 0.1333521432163324, 0.1, 0.07498942093324558, 0.05623413251903491, 0.042169650342858224, 0.03162277660168379, 0.023713737056616554, 0.01778279410038923, 0.01333521432163324, 0.01, 0.007498942093324558, 0.005623413251903491, 0.004216965034285823, 0.0031622776601683794, 0.0023713737056616554, 0.0017782794100389228, 0.001333521432163324, 0.001, 0.0007498942093324559, 0.0005623413251903491, 0.00042169650342858224, 0.00031622776601683794, 0.00023713737056616554, 0.00017782794100389227, 0.0001333521432163324};

__device__ __forceinline__ unsigned cvt_pk_bf16(float lo, float hi) { unsigned r; asm volatile("v_cvt_pk_bf16_f32 %0, %1, %2" : "=v"(r) : "v"(lo), "v"(hi)); return r; }
__device__ __forceinline__ float bf2f(bf16_t v) { return __uint_as_float(((unsigned)v) << 16); }
__device__ __forceinline__ float bflo(unsigned w) { return __uint_as_float(w << 16); }
__device__ __forceinline__ float bfhi(unsigned w) { return __uint_as_float(w & 0xffff0000u); }
__device__ __forceinline__ float wave_sum(float v) {
#pragma unroll
  for (int o = 1; o < 64; o <<= 1) v += __shfl_xor(v, o);
  return v;
}
__device__ __forceinline__ float shflx(float v, int lane, int mask) { return __int_as_float(__builtin_amdgcn_ds_bpermute((lane ^ mask) << 2, __float_as_int(v))); }
__device__ __forceinline__ float sigmoidf_(float x) { return __builtin_amdgcn_rcpf(1.0f + __expf(-x)); }
__device__ __forceinline__ int crow(int r, int hi) { return (r & 3) + 8 * (r >> 2) + 4 * hi; }
__device__ __forceinline__ size_t plane_row(int m, int h) {
  if (m < MP) { const int b = m >> 14, s = m & (SEQP - 1); return ((size_t)(b * NH + h) * SEQP + s); }
  const int mm = m - MP, b = mm >> 11, s = mm & (SEQS - 1); return (size_t)MP * NH + ((size_t)(b * NH + h) * SEQS + s);
}
__device__ __forceinline__ int seq_pos(int m) { return m < MP ? (m & (SEQP - 1)) : ((m - MP) & (SEQS - 1)); }

namespace pg8 {
constexpr int BM = 256, BK = 64, HALF = 128, HTB = HALF * BK * 2, STAGE_BYTES = 8 * HTB, NXCD = 8, WGM = 8;
__host__ __device__ __forceinline__ int lds_byte(int r, int c) { const int st = (r >> 4) * 2 + (c >> 5), rr = r & 15, cc = c & 31, ob = rr * 64 + cc * 2; return st * 1024 + (ob ^ (((ob >> 9) & 1) << 5)); }
__host__ __device__ __forceinline__ void stage_rc(int b, int& R, int& C) { const int st = b / 1024, sb = b % 1024, swz = sb ^ (((sb >> 9) & 1) << 5); R = (st >> 1) * 16 + swz / 64; C = (st & 1) * 32 + (swz % 64) / 2; }
__host__ __device__ __forceinline__ int perm32(int rho) { const int n = rho >> 4, i = rho & 15; return 8 * (i >> 2) + 4 * n + (i & 3); }
struct Unit { int pm, pn; };
struct Gemm { const bf16_t* A; const bf16_t* Bt; int lda, N, K; };
struct StaticOrder {
  int nM, nN, nwg, G, c;
  __device__ void init(int Mr, int N, int G_, int c_) { nM = Mr / BM; nN = N / BM; nwg = nM * nN; G = G_; c = c_; }
  __device__ bool next(int i, Unit& u) const {
    const long L = (long)i * G + c; if (L >= nwg) return false;
    int wgid = (int)L; { const int q = nwg / NXCD, r = nwg % NXCD, xcd = wgid % NXCD, off = wgid / NXCD; wgid = (xcd < r ? xcd * (q + 1) : r * (q + 1) + (xcd - r) * q) + off; }
    const int nig = WGM * nN, gid = wgid / nig, fm = gid * WGM, gsz = (nM - fm) < WGM ? (nM - fm) : WGM;
    u.pm = fm + ((wgid % nig) % gsz); u.pn = (wgid % nig) / gsz; return true;
  }
};
template <class Epi>
__device__ __forceinline__ void gemm_phase(LAS unsigned char* lds, const Gemm g, const StaticOrder& S, const Epi& E) {
  int tid_ = threadIdx.x; asm volatile("" : "+v"(tid_));
  const int tid = tid_, wid = __builtin_amdgcn_readfirstlane(tid >> 6), lane = tid & 63, wr = wid >> 2, wc = wid & 3, fr = lane & 15, fq = lane >> 4;
  const int K = g.K, nt = K / BK, lda = g.lda;
  unsigned voffA[2], voffB[2];
#pragma unroll
  for (int i = 0; i < 2; ++i) { int R, C; stage_rc(tid * 16 + i * 8192, R, C); const int Rb = Epi::PERM ? ((R & ~31) + perm32(R & 31)) : R;
    voffA[i] = (unsigned)(R * lda + C) * 2u; voffB[i] = (unsigned)(Rb * K + C) * 2u; }
  const size_t kstep = (size_t)(BK * 2);
  const size_t hstepA = (size_t)HALF * lda * 2, hstepB = (size_t)HALF * K * 2;
  const size_t tstepA = 2 * hstepA, tstepB = 2 * hstepB;
  const unsigned ldsw = (unsigned)wid * 1024u;
  const int aoff = lds_byte(wr * 64 + fr, fq * 8), boff = lds_byte(wc * 32 + fr, fq * 8);
#define PG8_SA(b, h) (((b) * 2 + (h)) * HTB)
#define PG8_SB(b, h) ((4 + (b) * 2 + (h)) * HTB)
#define PG8_STAGE(bufoff, gbase, voff) do { _Pragma("unroll") for (int _i = 0; _i < 2; ++_i) \
    __builtin_amdgcn_global_load_lds((const unsigned*)((const char*)(gbase) + (voff)[_i]), (LAS unsigned*)(lds + (bufoff) + ldsw + _i * 8192), 16, 0, 0); } while (0)
#define PG8_LDA(dst, b, h) do { _Pragma("unroll") for (int m = 0; m < 4; ++m) _Pragma("unroll") for (int k = 0; k < 2; ++k) dst[m][k] = *(const LAS bf16x8*)(lds + PG8_SA(b, h) + aoff + m * 2048 + k * 1024); } while (0)
#define PG8_LDB(dst, b, h) do { _Pragma("unroll") for (int n = 0; n < 2; ++n) _Pragma("unroll") for (int k = 0; k < 2; ++k) dst[n][k] = *(const LAS bf16x8*)(lds + PG8_SB(b, h) + boff + n * 2048 + k * 1024); } while (0)
#define PG8_MMA(ai, bj, At, Bt) do { __builtin_amdgcn_s_setprio(1); _Pragma("unroll") for (int m = 0; m < 4; ++m) _Pragma("unroll") for (int n = 0; n < 2; ++n) _Pragma("unroll") for (int k = 0; k < 2; ++k) \
    acc[ai][bj][m][n] = __builtin_amdgcn_mfma_f32_16x16x32_bf16(Bt[n][k], At[m][k], acc[ai][bj][m][n], 0, 0, 0); __builtin_amdgcn_s_setprio(0); } while (0)
#define PG8_WAIT_V(n) asm volatile("s_waitcnt vmcnt(" #n ")" ::: "memory")
#define PG8_WAIT_L(n) asm volatile("s_waitcnt lgkmcnt(" #n ")" ::: "memory")
#define PG8_BAR __builtin_amdgcn_s_barrier()
#define PG8_SCHED __builtin_amdgcn_sched_barrier(0)
  Unit cur, nxt; int ui = 0;
  if (!S.next(0, cur)) return;
  f32x4 acc[2][2][4][2];
#pragma unroll
  for (int a = 0; a < 2; ++a)
#pragma unroll
    for (int b = 0; b < 2; ++b)
#pragma unroll
      for (int m = 0; m < 4; ++m)
#pragma unroll
        for (int n = 0; n < 2; ++n) acc[a][b][m][n] = (f32x4){0.f, 0.f, 0.f, 0.f};
  bf16x8 At[4][2], B0[2][2], B1[2][2];
  const char* cA = (const char*)g.A + (size_t)cur.pm * tstepA; const char* cB = (const char*)g.Bt + (size_t)cur.pn * tstepB;
  PG8_STAGE(PG8_SB(0, 0), cB, voffB); PG8_STAGE(PG8_SB(0, 1), cB + hstepB, voffB); PG8_STAGE(PG8_SA(0, 0), cA, voffA); PG8_STAGE(PG8_SA(0, 1), cA + hstepA, voffA);
  if (wr == 1) PG8_BAR;
  PG8_WAIT_V(2); PG8_BAR;
  PG8_STAGE(PG8_SB(1, 0), cB + kstep, voffB); PG8_STAGE(PG8_SA(1, 0), cA + kstep, voffA); PG8_STAGE(PG8_SB(1, 1), cB + hstepB + kstep, voffB);
  PG8_WAIT_V(6); PG8_BAR;
  for (;;) {
    const bool has_next = S.next(ui + 1, nxt);
    const char* nA = has_next ? (const char*)g.A + (size_t)nxt.pm * tstepA : cA; const char* nB = has_next ? (const char*)g.Bt + (size_t)nxt.pn * tstepB : cB;
    for (int t = 0; t < nt; t += 2) {
      const bool last = (t == nt - 2);
      const char* a1 = cA + (size_t)(t + 1) * kstep;
      const char* a2 = last ? nA : cA + (size_t)(t + 2) * kstep; const char* b2 = last ? nB : cB + (size_t)(t + 2) * kstep;
      const char* a3 = a2 + kstep; const char* b3 = b2 + kstep;
      if constexpr (Epi::MIDK) { if (t == (nt >> 1)) E.mid(acc, cur, wr, fr); }
      PG8_LDB(B0, 0, 0); PG8_LDB(B1, 0, 1); PG8_SCHED; PG8_LDA(At, 0, 0); PG8_STAGE(PG8_SA(1, 1), a1 + hstepA, voffA);
      PG8_WAIT_V(8); PG8_WAIT_L(0); PG8_BAR; PG8_MMA(0, 0, At, B0); PG8_MMA(0, 1, At, B1); PG8_BAR; PG8_SCHED;
      PG8_LDA(At, 0, 1); PG8_STAGE(PG8_SB(0, 0), b2, voffB); PG8_STAGE(PG8_SB(0, 1), b2 + hstepB, voffB); PG8_STAGE(PG8_SA(0, 0), a2, voffA);
      PG8_WAIT_V(8); PG8_WAIT_L(0); PG8_BAR; PG8_MMA(1, 0, At, B0); PG8_MMA(1, 1, At, B1); PG8_BAR; PG8_SCHED;
      PG8_LDB(B0, 1, 0); PG8_LDB(B1, 1, 1); PG8_SCHED; PG8_LDA(At, 1, 0); PG8_STAGE(PG8_SA(0, 1), a2 + hstepA, voffA);
      PG8_WAIT_V(8); PG8_WAIT_L(0); PG8_BAR; PG8_MMA(0, 0, At, B0); PG8_MMA(0, 1, At, B1); PG8_BAR; PG8_SCHED;
      PG8_LDA(At, 1, 1); PG8_STAGE(PG8_SB(1, 0), b3, voffB); PG8_STAGE(PG8_SB(1, 1), b3 + hstepB, voffB); PG8_STAGE(PG8_SA(1, 0), a3, voffA);
      PG8_WAIT_V(8); PG8_WAIT_L(0); PG8_BAR; PG8_MMA(1, 0, At, B0); PG8_MMA(1, 1, At, B1); PG8_BAR; PG8_SCHED;
    }
    if (wr == 0) PG8_BAR;
    E(acc, cur, wr, wc, fr, fq);
    if (!has_next) break;
#pragma unroll
    for (int a = 0; a < 2; ++a)
#pragma unroll
      for (int b = 0; b < 2; ++b)
#pragma unroll
        for (int m = 0; m < 4; ++m)
#pragma unroll
          for (int n = 0; n < 2; ++n) acc[a][b][m][n] = (f32x4){0.f, 0.f, 0.f, 0.f};
    cur = nxt; cA = nA; cB = nB; ++ui;
    if (wr == 1) PG8_BAR;
  }
  PG8_WAIT_V(0);
  PG8_BAR;
#undef PG8_SA
#undef PG8_SB
#undef PG8_STAGE
#undef PG8_LDA
#undef PG8_LDB
#undef PG8_MMA
}

struct EpiU {
  static constexpr bool PERM = true, MIDK = false;
  bf16_t* U; const float* rs1; float* ssq_q; float* ssq_kv; float* ssq_pe;
  __device__ __forceinline__ void operator()(const f32x4 (&acc)[2][2][4][2], const Unit& u, int wr, int wc, int fr_, int fq_) const {
    int fr = fr_, fq = fq_; asm volatile("" : "+v"(fr), "+v"(fq));
    float* ssq = (u.pn < 2) ? ssq_q : (u.pn == 2 ? ssq_kv : (u.pn == 11 ? ssq_pe : (float*)nullptr));
    const int col0 = u.pn * BM + wc * 32 + 8 * fq;
#pragma unroll
    for (int ai = 0; ai < 2; ++ai)
#pragma unroll
      for (int m = 0; m < 4; ++m) {
        const int row = u.pm * BM + ai * HALF + wr * 64 + m * 16 + fr; const float s = rs1[row]; float q = 0.f;
        bf16_t* rowp = U + (size_t)row * LDU + col0;
#pragma unroll
        for (int bj = 0; bj < 2; ++bj) { const f32x4 v0 = acc[ai][bj][m][0] * s, v1 = acc[ai][bj][m][1] * s;
          q += (v0[0] * v0[0] + v0[1] * v0[1]) + (v0[2] * v0[2] + v0[3] * v0[3]) + (v1[0] * v1[0] + v1[1] * v1[1]) + (v1[2] * v1[2] + v1[3] * v1[3]);
          u32x4 w; w.x = cvt_pk_bf16(v0[0], v0[1]); w.y = cvt_pk_bf16(v0[2], v0[3]); w.z = cvt_pk_bf16(v1[0], v1[1]); w.w = cvt_pk_bf16(v1[2], v1[3]);
          *(u32x4*)(rowp + bj * HALF) = w; }
        if (ssq) { q += __shfl_xor(q, 16); q += __shfl_xor(q, 32); if (fq == 0) atomicAdd(ssq + row, q); }
      }
  }
};

struct EpiQ {
  static constexpr bool PERM = false, MIDK = false;
  bf16_t* Q; const float* ssq_q; const float* g_qn; const f32x2* rope; LAS float* xch;
  __device__ __forceinline__ void operator()(const f32x4 (&acc)[2][2][4][2], const Unit& u, int wr, int wc, int fr_, int fq_) const {
    int fr = fr_, fq = fq_; asm volatile("" : "+v"(fr), "+v"(fq));
    float rsq[2][4];
#pragma unroll
    for (int ai = 0; ai < 2; ++ai)
#pragma unroll
      for (int m = 0; m < 4; ++m) {
        const int rl = ai * HALF + wr * 64 + m * 16 + fr; const int row = u.pm * BM + rl;
        const float s = __builtin_amdgcn_rsqf(ssq_q[row] * (1.0f / 512.0f) + EPS); rsq[ai][m] = s; float q = 0.f;
#pragma unroll
        for (int bj = 0; bj < 2; ++bj)
#pragma unroll
          for (int n = 0; n < 2; ++n) { const f32x4 v = acc[ai][bj][m][n] * s; q += (v[0] * v[0] + v[1] * v[1]) + (v[2] * v[2] + v[3] * v[3]); }
        q += __shfl_xor(q, 16); q += __shfl_xor(q, 32);
        if (fq == 0) xch[rl * 4 + wc] = q;
      }
    asm volatile("s_waitcnt lgkmcnt(0)" ::: "memory"); __builtin_amdgcn_s_barrier(); asm volatile("" ::: "memory");
    const int h = u.pn;
#pragma unroll
    for (int ai = 0; ai < 2; ++ai)
#pragma unroll
      for (int m = 0; m < 4; ++m) {
        const int rl = ai * HALF + wr * 64 + m * 16 + fr; const int row = u.pm * BM + rl;
        const f32x4 pq = *(const LAS f32x4*)(xch + rl * 4);
        const float tot = (pq[0] + pq[1]) + (pq[2] + pq[3]);
        const float sc = rsq[ai][m] * __builtin_amdgcn_rsqf(tot * (1.0f / 192.0f) + EPS);
        bf16_t* qrow = Q + (plane_row(row, h)) * DK;
        if (wc == 3) {
          const int s = seq_pos(row);
#pragma unroll
          for (int n = 0; n < 2; ++n) { const int i0 = 16 * n + 4 * fq;
            const f32x4 g1 = *(const f32x4*)(g_qn + 128 + i0), g2 = *(const f32x4*)(g_qn + 160 + i0);
            const f32x4 x1 = acc[ai][0][m][n] * sc * g1, x2 = acc[ai][1][m][n] * sc * g2; float o1[4], o2[4];
#pragma unroll
            for (int j = 0; j < 4; ++j) { const f32x2 cs = rope[(size_t)s * 32 + i0 + j]; o1[j] = x1[j] * cs.x - x2[j] * cs.y; o2[j] = x2[j] * cs.x + x1[j] * cs.y; }
            u32x2 w1, w2; w1.x = cvt_pk_bf16(o1[0], o1[1]); w1.y = cvt_pk_bf16(o1[2], o1[3]); w2.x = cvt_pk_bf16(o2[0], o2[1]); w2.y = cvt_pk_bf16(o2[2], o2[3]);
            *(u32x2*)(qrow + 128 + i0) = w1; *(u32x2*)(qrow + 160 + i0) = w2; }
        } else {
#pragma unroll
          for (int n = 0; n < 2; ++n) { const int d = 32 * wc + 16 * n + 4 * fq;
            const f32x4 gg = *(const f32x4*)(g_qn + d); const f32x4 v = acc[ai][0][m][n] * sc * gg;
            u32x2 w; w.x = cvt_pk_bf16(v[0], v[1]); w.y = cvt_pk_bf16(v[2], v[3]); *(u32x2*)(qrow + d) = w; }
          if (wc == 0) {
#pragma unroll
            for (int n = 0; n < 2; ++n) { const int d = 96 + 16 * n + 4 * fq;
              const f32x4 gg = *(const f32x4*)(g_qn + d); const f32x4 v = acc[ai][1][m][n] * sc * gg;
              u32x2 w; w.x = cvt_pk_bf16(v[0], v[1]); w.y = cvt_pk_bf16(v[2], v[3]); *(u32x2*)(qrow + d) = w; }
          }
        }
      }
  }
};

struct EpiKV {
  static constexpr bool PERM = false, MIDK = false;
  bf16_t* Kt; bf16_t* Vt; const bf16_t* U; const float* ssq_kv; const float* ssq_pe; const float* g_kn; const f32x2* rope; LAS float* xch;
  __device__ __forceinline__ void operator()(const f32x4 (&acc)[2][2][4][2], const Unit& u, int wr, int wc, int fr_, int fq_) const {
    int fr = fr_, fq = fq_; asm volatile("" : "+v"(fr), "+v"(fq));
    float rsq[2][4];
#pragma unroll
    for (int ai = 0; ai < 2; ++ai)
#pragma unroll
      for (int m = 0; m < 4; ++m) {
        const int rl = ai * HALF + wr * 64 + m * 16 + fr; const int row = u.pm * BM + rl;
        const float s = __builtin_amdgcn_rsqf(ssq_kv[row] * (1.0f / 256.0f) + EPS); rsq[ai][m] = s; float q = 0.f;
#pragma unroll
        for (int n = 0; n < 2; ++n) { const f32x4 v = acc[ai][0][m][n] * s; q += (v[0] * v[0] + v[1] * v[1]) + (v[2] * v[2] + v[3] * v[3]); }
        q += __shfl_xor(q, 16); q += __shfl_xor(q, 32);
        if (fq == 0) xch[rl * 4 + wc] = q;
      }
    asm volatile("s_waitcnt lgkmcnt(0)" ::: "memory"); __builtin_amdgcn_s_barrier(); asm volatile("" ::: "memory");
    const int h = u.pn;
#pragma unroll
    for (int ai = 0; ai < 2; ++ai)
#pragma unroll
      for (int m = 0; m < 4; ++m) {
        const int rl = ai * HALF + wr * 64 + m * 16 + fr; const int row = u.pm * BM + rl;
        const f32x4 pq = *(const LAS f32x4*)(xch + rl * 4);
        const float tot = (pq[0] + pq[1]) + (pq[2] + pq[3]) + ssq_pe[row];
        const float rstd = __builtin_amdgcn_rsqf(tot * (1.0f / 192.0f) + EPS);
        const float sc = rsq[ai][m] * rstd;
        const size_t pr = plane_row(row, h);
        bf16_t* krow = Kt + pr * DK; bf16_t* vrow = Vt + pr * DV;
#pragma unroll
        for (int n = 0; n < 2; ++n) { const int d = 32 * wc + 16 * n + 4 * fq;
          const f32x4 gg = *(const f32x4*)(g_kn + d); const f32x4 kv = acc[ai][0][m][n] * sc * gg; const f32x4 vv = acc[ai][1][m][n] * rsq[ai][m];
          u32x2 w; w.x = cvt_pk_bf16(kv[0], kv[1]); w.y = cvt_pk_bf16(kv[2], kv[3]); *(u32x2*)(krow + d) = w;
          u32x2 wv; wv.x = cvt_pk_bf16(vv[0], vv[1]); wv.y = cvt_pk_bf16(vv[2], vv[3]); *(u32x2*)(vrow + d) = wv; }
        { const int i0 = 8 * wc + 2 * fq; const int s = seq_pos(row);
          const unsigned p1 = *(const unsigned*)(U + (size_t)row * LDU + UC_PE + i0), p2 = *(const unsigned*)(U + (size_t)row * LDU + UC_PE + 32 + i0);
          const float x1a = bflo(p1) * rstd * g_kn[128 + i0], x1b = bfhi(p1) * rstd * g_kn[128 + i0 + 1];
          const float x2a = bflo(p2) * rstd * g_kn[160 + i0], x2b = bfhi(p2) * rstd * g_kn[160 + i0 + 1];
          const f32x2 ca = rope[(size_t)s * 32 + i0], cb = rope[(size_t)s * 32 + i0 + 1];
          *(unsigned*)(krow + 128 + i0) = cvt_pk_bf16(x1a * ca.x - x2a * ca.y, x1b * cb.x - x2b * cb.y);
          *(unsigned*)(krow + 160 + i0) = cvt_pk_bf16(x2a * ca.x + x1a * ca.y, x2b * cb.x + x1b * cb.y); }
        asm volatile("" ::: "memory");
      }
  }
};

struct EpiOut {
  static constexpr bool PERM = false, MIDK = true;
  const float* xp; const float* xs; float* out; bf16_t* x1b; const float* ssq_a; const float* ssq_l; float* ssq2;
  __device__ __forceinline__ void mid(f32x4 (&acc)[2][2][4][2], const Unit& u, int wr, int fr_) const {
    int fr = fr_; asm volatile("" : "+v"(fr));
#pragma unroll
    for (int ai = 0; ai < 2; ++ai)
#pragma unroll
      for (int m = 0; m < 4; ++m) { const int row = u.pm * BM + ai * HALF + wr * 64 + m * 16 + fr;
        const float sa = __builtin_amdgcn_rsqf(ssq_a[row] * (1.0f / 1024.0f) + EPS), sl = __builtin_amdgcn_rsqf(ssq_l[row] * (1.0f / 1024.0f) + EPS);
        const float ratio = sa / sl;
#pragma unroll
        for (int bj = 0; bj < 2; ++bj)
#pragma unroll
          for (int n = 0; n < 2; ++n) acc[ai][bj][m][n] *= ratio; }
  }
  __device__ __forceinline__ void operator()(const f32x4 (&acc)[2][2][4][2], const Unit& u, int wr, int wc, int fr_, int fq_) const {
    int fr = fr_, fq = fq_; asm volatile("" : "+v"(fr), "+v"(fq));
    const int col0 = u.pn * BM + wc * 32 + 4 * fq;
#pragma unroll
    for (int ai = 0; ai < 2; ++ai)
#pragma unroll
      for (int m = 0; m < 4; ++m) { const int row = u.pm * BM + ai * HALF + wr * 64 + m * 16 + fr;
        const float sl = __builtin_amdgcn_rsqf(ssq_l[row] * (1.0f / 1024.0f) + EPS);
        const float* xrow = (row < MP) ? xp + (size_t)row * DM : xs + (size_t)(row - MP) * DM; float q = 0.f;
#pragma unroll
        for (int bj = 0; bj < 2; ++bj)
#pragma unroll
          for (int n = 0; n < 2; ++n) { const int c = col0 + bj * HALF + n * 16;
            const f32x4 xv = *(const f32x4*)(xrow + c); const f32x4 o = xv + acc[ai][bj][m][n] * sl;
            *(f32x4*)(out + (size_t)row * DM + c) = o; q += (o[0] * o[0] + o[1] * o[1]) + (o[2] * o[2] + o[3] * o[3]);
            u32x2 w; w.x = cvt_pk_bf16(o[0], o[1]); w.y = cvt_pk_bf16(o[2], o[3]); *(u32x2*)(x1b + (size_t)row * DM + c) = w; }
        q += __shfl_xor(q, 16); q += __shfl_xor(q, 32); if (fq == 0) atomicAdd(ssq2 + row, q); }
  }
};

struct EpiGU {
  static constexpr bool PERM = true, MIDK = false;
  bf16_t* act; const float* ssq2;
  __device__ __forceinline__ void operator()(const f32x4 (&acc)[2][2][4][2], const Unit& u, int wr, int wc, int fr_, int fq_) const {
    int fr = fr_, fq = fq_; asm volatile("" : "+v"(fr), "+v"(fq));
    const int col0 = u.pn * HALF + wc * 32 + 8 * fq;
#pragma unroll
    for (int ai = 0; ai < 2; ++ai)
#pragma unroll
      for (int m = 0; m < 4; ++m) { const int row = u.pm * BM + ai * HALF + wr * 64 + m * 16 + fr;
        const float rs = __builtin_amdgcn_rsqf(ssq2[row] * (1.0f / 2048.0f) + EPS);
        float r[8];
#pragma unroll
        for (int n = 0; n < 2; ++n)
#pragma unroll
          for (int j = 0; j < 4; ++j) { const float gv = acc[ai][0][m][n][j] * rs, uv = acc[ai][1][m][n][j] * rs; r[n * 4 + j] = gv * sigmoidf_(gv) * uv; }
        u32x4 w; w.x = cvt_pk_bf16(r[0], r[1]); w.y = cvt_pk_bf16(r[2], r[3]); w.z = cvt_pk_bf16(r[4], r[5]); w.w = cvt_pk_bf16(r[6], r[7]);
        *(u32x4*)(act + (size_t)row * DFF + col0) = w; }
  }
};

struct EpiDown {
  static constexpr bool PERM = false, MIDK = false;
  float* out;
  __device__ __forceinline__ void operator()(const f32x4 (&acc)[2][2][4][2], const Unit& u, int wr, int wc, int fr_, int fq_) const {
    int fr = fr_, fq = fq_; asm volatile("" : "+v"(fr), "+v"(fq));
    const int col0 = u.pn * BM + wc * 32 + 4 * fq;
#pragma unroll
    for (int ai = 0; ai < 2; ++ai)
#pragma unroll
      for (int m = 0; m < 4; ++m) { const int row = u.pm * BM + ai * HALF + wr * 64 + m * 16 + fr;
#pragma unroll
        for (int bj = 0; bj < 2; ++bj)
#pragma unroll
          for (int n = 0; n < 2; ++n) { float* p = out + (size_t)row * DM + col0 + bj * HALF + n * 16; const f32x4 xv = *(const f32x4*)p; *(f32x4*)p = xv + acc[ai][bj][m][n]; } }
  }
};
}

namespace att {
constexpr int NW = 8, QBLK = 32, KVBLK = 64;
constexpr float SCALE = 0.07216878364870322f;
constexpr float THR = 8.f;
constexpr int KROWB = 400;
constexpr int SHM_V = KVBLK * DV * 2, SHM_K = KVBLK * KROWB;
constexpr int QRP = 144;
constexpr int SHM_QR = 2 * SHM_V + 2 * SHM_K + NW * 64 * 4;
constexpr int SHM_ATTN = SHM_QR + NW * 32 * QRP;
#define SBAR() __builtin_amdgcn_sched_barrier(0)
__device__ __forceinline__ void partialSM(f32x16& p0, f32x16& p1, float& m_reg, float& mn, float& alpha) {
  constexpr float C = SCALE * 1.4426950408889634f;
  float pmax = p0[0];
#pragma unroll
  for (int r = 1; r < 16; ++r) pmax = fmaxf(pmax, p0[r]);
#pragma unroll
  for (int r = 0; r < 16; ++r) pmax = fmaxf(pmax, p1[r]);
  { auto rr = __builtin_amdgcn_permlane32_swap(__float_as_uint(pmax), __float_as_uint(pmax), false, false);
    pmax = fmaxf(__uint_as_float(rr[0]), __uint_as_float(rr[1])); }
  if (__builtin_expect(__all(pmax - m_reg <= THR / SCALE), 1)) { mn = m_reg; alpha = 1.f; }
  else { mn = fmaxf(m_reg, pmax); alpha = __builtin_amdgcn_exp2f((m_reg - mn) * C); m_reg = mn; }
  const float mnC = -mn * C;
#pragma unroll
  for (int r = 0; r < 16; ++r) p0[r] = fmaf(p0[r], C, mnC);
#pragma unroll
  for (int r = 0; r < 16; ++r) p1[r] = fmaf(p1[r], C, mnC);
#pragma unroll
  for (int r = 0; r < 16; ++r) p0[r] = __builtin_amdgcn_exp2f(p0[r]);
}
__device__ __forceinline__ void finishSM(f32x16& p0, f32x16& p1, float alpha, float& l_reg, bf16x8& pa0, bf16x8& pa1, bf16x8& pa2, bf16x8& pa3) {
#pragma unroll
  for (int r = 0; r < 16; ++r) p1[r] = __builtin_amdgcn_exp2f(p1[r]);
  float ps = 0;
#pragma unroll
  for (int r = 0; r < 16; ++r) ps += p0[r];
#pragma unroll
  for (int r = 0; r < 16; ++r) ps += p1[r];
  { auto rr = __builtin_amdgcn_permlane32_swap(__float_as_uint(ps), __float_as_uint(ps), false, false);
    ps = __uint_as_float(rr[0]) + __uint_as_float(rr[1]); }
  l_reg = l_reg * alpha + ps;
#define PK4(P, BASE, OUT) do { unsigned a0 = cvt_pk_bf16(P[BASE + 0], P[BASE + 1]), a1 = cvt_pk_bf16(P[BASE + 2], P[BASE + 3]);   \
    unsigned b0 = cvt_pk_bf16(P[BASE + 4], P[BASE + 5]), b1 = cvt_pk_bf16(P[BASE + 6], P[BASE + 7]);                              \
    auto r0 = __builtin_amdgcn_permlane32_swap(a0, b0, false, false); auto r1 = __builtin_amdgcn_permlane32_swap(a1, b1, false, false); \
    u32x4 w = {r0[0], r1[0], r0[1], r1[1]}; OUT = *reinterpret_cast<bf16x8*>(&w); } while (0)
  PK4(p0, 0, pa0); PK4(p0, 8, pa1); PK4(p1, 0, pa2); PK4(p1, 8, pa3);
#undef PK4
}
__device__ __forceinline__ void qkt(f32x16& p0, f32x16& p1, const char* Ks, const bf16x8* qr, const char* qrl, int r32, int hi) {
  p0 = f32x16{}; p1 = f32x16{};
#pragma unroll
  for (int d0 = 0; d0 < 12; ++d0) { const int cb = (d0 * 16 + hi * 8) * 2;
    const bf16x8 b0 = *reinterpret_cast<const bf16x8*>(Ks + r32 * KROWB + cb);
    const bf16x8 b1 = *reinterpret_cast<const bf16x8*>(Ks + (32 + r32) * KROWB + cb);
    const bf16x8 qf = (d0 < 8) ? qr[d0 < 8 ? d0 : 0] : *reinterpret_cast<const bf16x8*>(qrl + (d0 - 8) * 32);
    p0 = __builtin_amdgcn_mfma_f32_32x32x16_bf16(b0, qf, p0, 0, 0, 0);
    p1 = __builtin_amdgcn_mfma_f32_32x32x16_bf16(b1, qf, p1, 0, 0, 0); }
}
__device__ __forceinline__ int v_st(int k, int c) { const int kk = (k & ~0xC) | ((k & 4) << 1) | ((k & 8) >> 1); return ((kk >> 3) * 4 + (c >> 5)) * 512 + ((kk & 7) * 32 + (c & 31)) * 2; }
__device__ __forceinline__ int v_rd_base(int lane) { return ((lane & 3) << 3) | (((lane >> 2) & 3) << 6) | (((lane >> 4) & 1) << 5) | (((lane >> 5) & 1) << 8); }
constexpr int v_rd_off(int d0, int ks, int half) { return d0 * 512 + ks * 4096 + half * 2048; }
template <int OFF> __device__ __forceinline__ s16x4 tr_read(int vb) {
  s16x4 r; asm volatile("ds_read_b64_tr_b16 %0, %1 offset:%2" : "=&v"(r) : "v"(vb), "i"(OFF) : "memory"); return r;
}
template <int D0> __device__ __forceinline__ void pv_one(f32x16& od, int vb, bf16x8 pa0, bf16x8 pa1, bf16x8 pa2, bf16x8 pa3) {
  const s16x4 l0 = tr_read<v_rd_off(D0, 0, 0)>(vb), h0 = tr_read<v_rd_off(D0, 0, 1)>(vb), l1 = tr_read<v_rd_off(D0, 1, 0)>(vb), h1 = tr_read<v_rd_off(D0, 1, 1)>(vb);
  const s16x4 l2 = tr_read<v_rd_off(D0, 2, 0)>(vb), h2 = tr_read<v_rd_off(D0, 2, 1)>(vb), l3 = tr_read<v_rd_off(D0, 3, 0)>(vb), h3 = tr_read<v_rd_off(D0, 3, 1)>(vb);
  asm volatile("s_waitcnt lgkmcnt(0)" ::: "memory"); SBAR();
#define PK(L, H) (bf16x8){L[0], L[1], L[2], L[3], H[0], H[1], H[2], H[3]}
  od = __builtin_amdgcn_mfma_f32_32x32x16_bf16(pa0, PK(l0, h0), od, 0, 0, 0);
  od = __builtin_amdgcn_mfma_f32_32x32x16_bf16(pa1, PK(l1, h1), od, 0, 0, 0);
  od = __builtin_amdgcn_mfma_f32_32x32x16_bf16(pa2, PK(l2, h2), od, 0, 0, 0);
  od = __builtin_amdgcn_mfma_f32_32x32x16_bf16(pa3, PK(l3, h3), od, 0, 0, 0);
#undef PK
}
__device__ __forceinline__ void pv_d0(f32x16* o, int vb, bf16x8 pa0, bf16x8 pa1, bf16x8 pa2, bf16x8 pa3) {
  pv_one<0>(o[0], vb, pa0, pa1, pa2, pa3); pv_one<1>(o[1], vb, pa0, pa1, pa2, pa3); pv_one<2>(o[2], vb, pa0, pa1, pa2, pa3); pv_one<3>(o[3], vb, pa0, pa1, pa2, pa3);
}
__device__ __forceinline__ void attn_unit(const bf16_t* __restrict__ Qb, const bf16_t* __restrict__ Kh, const bf16_t* __restrict__ Vh, bf16_t* __restrict__ Ob, float* __restrict__ ssq, int seq, char* lds) {
  int tid_ = threadIdx.x; asm volatile("" : "+v"(tid_));
  const int tid = tid_, wid = tid >> 6, lane = tid & 63, r32 = lane & 31, hi = lane >> 5;
  char* V_lds = lds; char* K_lds = lds + 2 * SHM_V;
  float* ws = (float*)(lds + 2 * SHM_V + 2 * SHM_K) + wid * 64; float* li_l = ws; float* al_l = ws + 32;
  float m_reg = -1e30f, l_reg = 0; f32x16 o[4] = {}; bf16x8 qr[8];
  const bf16_t* Qw = Qb + (size_t)(wid * QBLK + r32) * DK + hi * 8;
#pragma unroll
  for (int d0 = 0; d0 < 8; ++d0) qr[d0] = *reinterpret_cast<const bf16x8*>(Qw + d0 * 16);
  char* qrl = lds + SHM_QR + (wid * 32 + r32) * QRP + hi * 16;
#pragma unroll
  for (int d0 = 8; d0 < 12; ++d0) *reinterpret_cast<bf16x8*>(qrl + (d0 - 8) * 32) = *reinterpret_cast<const bf16x8*>(Qw + d0 * 16);
  const int sr = tid >> 4, sc = (tid & 15) * 8, vst0 = v_st(sr, sc), vst1 = v_st(32 + sr, sc);
  const int kr = tid >> 3, kc = (tid & 7) * 8;
  const int kst = kr * KROWB + kc * 2;
  const int vb0 = (int)(uintptr_t)V_lds + v_rd_base(lane);
  bf16x8 vs0, vs1, ks0, ks1, ks2;
#define SLOAD(k0) do { vs0 = *reinterpret_cast<const bf16x8*>(&Vh[(size_t)((k0) + sr) * DV + sc]); vs1 = *reinterpret_cast<const bf16x8*>(&Vh[(size_t)((k0) + 32 + sr) * DV + sc]); \
    ks0 = *reinterpret_cast<const bf16x8*>(&Kh[(size_t)((k0) + kr) * DK + kc]); ks1 = *reinterpret_cast<const bf16x8*>(&Kh[(size_t)((k0) + kr) * DK + kc + 64]); \
    ks2 = *reinterpret_cast<const bf16x8*>(&Kh[(size_t)((k0) + kr) * DK + kc + 128]); } while (0)
#define SWRITE(b) do { *(bf16x8*)(V_lds + (b) * SHM_V + vst0) = vs0; *(bf16x8*)(V_lds + (b) * SHM_V + vst1) = vs1; \
    *(bf16x8*)(K_lds + (b) * SHM_K + kst) = ks0; *(bf16x8*)(K_lds + (b) * SHM_K + kst + 128) = ks1; *(bf16x8*)(K_lds + (b) * SHM_K + kst + 256) = ks2; } while (0)
#define SWAIT() asm volatile("s_waitcnt vmcnt(0)" ::: "memory")
#define RESC(a) do { if (__any((a) < 1.f)) { if (hi == 0) al_l[r32] = (a); asm volatile("s_waitcnt lgkmcnt(0)" ::: "memory"); \
    _Pragma("unroll") for (int d = 0; d < 4; ++d) _Pragma("unroll") for (int r = 0; r < 16; ++r) o[d][r] *= al_l[crow(r, hi)]; } } while (0)
  f32x16 pA0, pA1, pB0, pB1; float mnA, mnB, alA, alB; bf16x8 pa0, pa1, pa2, pa3; const int NT = seq / KVBLK;
  SLOAD(0); SWAIT(); SWRITE(0); __syncthreads();
  qkt(pA0, pA1, K_lds, qr, qrl, r32, hi); partialSM(pA0, pA1, m_reg, mnA, alA);
  SLOAD(KVBLK);
  SWAIT(); SWRITE(1); __syncthreads();
  for (int j = 1; j + 1 < NT; j += 2) {
    SBAR(); qkt(pB0, pB1, K_lds + SHM_K, qr, qrl, r32, hi);
    finishSM(pA0, pA1, alA, l_reg, pa0, pa1, pa2, pa3); SBAR();
    SLOAD((j + 1) * KVBLK); SBAR();
    pv_d0(o, vb0, pa0, pa1, pa2, pa3); partialSM(pB0, pB1, m_reg, mnB, alB);
    __syncthreads(); SWAIT(); SWRITE(0);
    RESC(alB); __syncthreads();
    SBAR(); qkt(pA0, pA1, K_lds, qr, qrl, r32, hi);
    finishSM(pB0, pB1, alB, l_reg, pa0, pa1, pa2, pa3); SBAR();
    SLOAD((j + 2) * KVBLK); SBAR();
    pv_d0(o, vb0 + SHM_V, pa0, pa1, pa2, pa3); partialSM(pA0, pA1, m_reg, mnA, alA);
    __syncthreads(); SWAIT(); SWRITE(1);
    RESC(alA); __syncthreads();
  }
  SBAR(); qkt(pB0, pB1, K_lds + SHM_K, qr, qrl, r32, hi);
  finishSM(pA0, pA1, alA, l_reg, pa0, pa1, pa2, pa3); SBAR();
  pv_d0(o, vb0, pa0, pa1, pa2, pa3); partialSM(pB0, pB1, m_reg, mnB, alB);
  __syncthreads(); RESC(alB);
  finishSM(pB0, pB1, alB, l_reg, pa0, pa1, pa2, pa3); SBAR();
  pv_d0(o, vb0 + SHM_V, pa0, pa1, pa2, pa3);
  if (hi == 0) li_l[r32] = l_reg; asm volatile("s_waitcnt lgkmcnt(0)" ::: "memory");
  int lane_e = lane; asm volatile("" : "+v"(lane_e));
  const int r32e = lane_e & 31, hie = lane_e >> 5;
  float rli[16];
#pragma unroll
  for (int r = 0; r < 16; ++r) rli[r] = __builtin_amdgcn_rcpf(li_l[crow(r, hie)]);
  __syncthreads();
  bf16_t* stg = (bf16_t*)(lds + wid * 8192);
#pragma unroll
  for (int r = 0; r < 16; ++r) { const int orow = crow(r, hie);
#pragma unroll
    for (int d0 = 0; d0 < 4; ++d0) { const float v = o[d0][r] * rli[r]; stg[orow * 128 + d0 * 32 + r32e] = (bf16_t)(cvt_pk_bf16(v, v) & 0xffffu); } }
  asm volatile("s_waitcnt lgkmcnt(0)" ::: "memory");
#pragma unroll
  for (int i = 0; i < 8; ++i) { const int row = i * 4 + (lane_e >> 4), ch = lane_e & 15;
    const u32x4 v = *(const u32x4*)(stg + row * 128 + ch * 8);
    *(u32x4*)(Ob + (size_t)(wid * QBLK + row) * DM + ch * 8) = v;
    float q = bflo(v.x) * bflo(v.x) + bfhi(v.x) * bfhi(v.x) + bflo(v.y) * bflo(v.y) + bfhi(v.y) * bfhi(v.y) + bflo(v.z) * bflo(v.z) + bfhi(v.z) * bfhi(v.z) + bflo(v.w) * bflo(v.w) + bfhi(v.w) * bfhi(v.w);
    q += shflx(q, lane_e, 1); q += shflx(q, lane_e, 2); q += shflx(q, lane_e, 4); q += shflx(q, lane_e, 8);
    if (ch == 0) atomicAdd(ssq + wid * QBLK + row, q); }
  __syncthreads();
#undef SLOAD
#undef SWRITE
#undef SWAIT
#undef RESC
}
#undef SBAR
}

namespace lru {
constexpr int XROW = 136;
constexpr int X_BYTES = 256 * XROW * 2;
constexpr int COMP_OFF = X_BYTES, COMP_BYTES = 4 * 2 * 8 * 32 * 8;
constexpr int CARRY_OFF = COMP_OFF + COMP_BYTES;
template <bool REV> __device__ __forceinline__ void seg_comp(const float (&a)[16], const float (&bx)[16], float (&A)[4], float (&B)[4]) {
#pragma unroll
  for (int q = 0; q < 4; ++q) { float Aq = 1.f, Bq = 0.f;
#pragma unroll
    for (int ee = 0; ee < 4; ++ee) { const int e = REV ? 3 - ee : ee; const int r = 4 * q + e; Bq = a[r] * Bq + bx[r]; Aq *= a[r]; }
    A[q] = Aq; B[q] = Bq; }
}
template <bool REV> __device__ __forceinline__ float seg_prefix(const float (&loA)[4], const float (&loB)[4], const float (&hiA)[4], const float (&hiB)[4], int hi, float st, float (&start)[4]) {
#pragma unroll
  for (int qq = 0; qq < 4; ++qq) { const int q = REV ? 3 - qq : qq;
    if (!REV) { const float t1 = loA[q] * st + loB[q]; start[q] = hi ? t1 : st; st = hiA[q] * t1 + hiB[q]; }
    else { const float t1 = hiA[q] * st + hiB[q]; start[q] = hi ? st : t1; st = loA[q] * t1 + loB[q]; } }
  return st;
}
template <int PASS>
__device__ __forceinline__ void unit(const Params& p, int chunk, int n, char* lds) {
  int tid_ = threadIdx.x; asm volatile("" : "+v"(tid_));
  const int tid = tid_, wid = __builtin_amdgcn_readfirstlane(tid >> 6), lane = tid & 63, j = lane & 31, hi = lane >> 5;
  const int row0 = chunk * 256;
  int seq_start, seq_len;
  if (row0 < MP) { seq_start = row0 & ~(SEQP - 1); seq_len = SEQP; } else { seq_start = MP + ((row0 - MP) & ~(SEQS - 1)); seq_len = SEQS; }
  const int cs = (row0 - seq_start) >> 8, nch = seq_len >> 8, cbase = seq_start >> 8;
  const bf16_t* U = (const bf16_t*)(p.ws + WS_U);
  bf16_t* X = (bf16_t*)lds;
  f32x2* comp = (f32x2*)(lds + COMP_OFF);
  float* carry = (float*)(lds + CARRY_OFF);
  f32x2* agg = (f32x2*)(p.ws + WS_AGG);
  { const int cg8 = (tid & 15) * 8, tg = tid >> 4; const int c0 = n * 128 + cg8;
    const float* cw = p.in[10]; const float* cb = p.in[11];
    float w[4][8], bb[8];
#pragma unroll
    for (int t = 0; t < 4; ++t) { const f32x4 a = *(const f32x4*)(cw + t * 1024 + c0), b = *(const f32x4*)(cw + t * 1024 + c0 + 4);
      w[t][0] = a[0]; w[t][1] = a[1]; w[t][2] = a[2]; w[t][3] = a[3]; w[t][4] = b[0]; w[t][5] = b[1]; w[t][6] = b[2]; w[t][7] = b[3]; }
    { const f32x4 a = *(const f32x4*)(cb + c0), b = *(const f32x4*)(cb + c0 + 4); bb[0] = a[0]; bb[1] = a[1]; bb[2] = a[2]; bb[3] = a[3]; bb[4] = b[0]; bb[5] = b[1]; bb[6] = b[2]; bb[7] = b[3]; }
    u32x4 rw[11];
#pragma unroll
    for (int rr = 0; rr < 11; ++rr) { const int grow = row0 + tg * 8 + rr - 1; const bool ok = (grow >= seq_start) && (grow < seq_start + seq_len);
      rw[rr] = ok ? *(const u32x4*)(U + (size_t)grow * LDU + UC_X + c0) : (u32x4){0u, 0u, 0u, 0u}; }
#pragma unroll
    for (int t = 0; t < 8; ++t) { float y[8];
#pragma unroll
      for (int c = 0; c < 8; ++c) y[c] = bb[c];
#pragma unroll
      for (int tp = 0; tp < 4; ++tp) { const u32x4 v = rw[t + tp];
        y[0] += w[tp][0] * bflo(v.x); y[1] += w[tp][1] * bfhi(v.x); y[2] += w[tp][2] * bflo(v.y); y[3] += w[tp][3] * bfhi(v.y);
        y[4] += w[tp][4] * bflo(v.z); y[5] += w[tp][5] * bfhi(v.z); y[6] += w[tp][6] * bflo(v.w); y[7] += w[tp][7] * bfhi(v.w); }
      u32x4 o; o.x = cvt_pk_bf16(y[0], y[1]); o.y = cvt_pk_bf16(y[2], y[3]); o.z = cvt_pk_bf16(y[4], y[5]); o.w = cvt_pk_bf16(y[6], y[7]);
      *(u32x4*)(X + (tg * 8 + t) * XROW + cg8) = o; }
  }
  if (PASS == 2 && tid < 256) { const int dir = tid >> 7, ch = tid & 127; float st = 0.f;
    if (dir == 0) { for (int c = 0; c < cs; ++c) { const f32x2 ab = agg[(size_t)(0 * NCHUNK + cbase + c) * 1024 + n * 128 + ch]; st = ab.x * st + ab.y; } }
    else { for (int c = nch - 1; c > cs; --c) { const f32x2 ab = agg[(size_t)(1 * NCHUNK + cbase + c) * 1024 + n * 128 + ch]; st = ab.x * st + ab.y; } }
    carry[dir * 128 + ch] = st; }
  __syncthreads();
  const bf16_t* Wf = (const bf16_t*)(p.ws + WS_BRG) + (size_t)n * 4 * 4 * 8 * 64 * 8;
  const float* lam = p.in[16];
  const bf16_t* Xw = X + (32 * wid + j) * XROW + 8 * hi;
  for (int cgp = 0; cgp < 4; ++cgp) {
    const int ch = 32 * cgp + j, gch = n * 128 + ch;
    float sum[16];
#pragma unroll
    for (int dir = 0; dir < 2; ++dir) {
      f32x16 accr = f32x16{}, acci = f32x16{};
#pragma unroll
      for (int ks = 0; ks < 8; ++ks) { const bf16x8 xa = *(const bf16x8*)(Xw + 16 * ks);
        const bf16x8 bfr = *(const bf16x8*)(Wf + ((size_t)(((2 * dir) * 4 + cgp) * 8 + ks) * 64 + lane) * 8);
        const bf16x8 bfi = *(const bf16x8*)(Wf + ((size_t)(((2 * dir + 1) * 4 + cgp) * 8 + ks) * 64 + lane) * 8);
        accr = __builtin_amdgcn_mfma_f32_32x32x16_bf16(xa, bfr, accr, 0, 0, 0);
        acci = __builtin_amdgcn_mfma_f32_32x32x16_bf16(xa, bfi, acci, 0, 0, 0); }
      const float br = p.in[13][(dir * 8 + n) * 128 + ch], bi = p.in[15][(dir * 8 + n) * 128 + ch];
      const float lm = lam[dir * 1024 + gch]; const float c8 = 8.0f * log1pf(__expf(-lm));
      float a[16], bx[16];
#pragma unroll
      for (int r = 0; r < 16; ++r) { const float xv = bf2f(X[(32 * wid + crow(r, hi)) * XROW + ch]);
        const float rg = sigmoidf_(accr[r] + br), ig = sigmoidf_(acci[r] + bi);
        const float av = __expf(-c8 * rg); a[r] = av; bx[r] = sqrtf(fmaxf(1.0f - av * av, 0.f)) * ig * xv; }
      float A[4], B[4], loA[4], loB[4], hiA[4], hiB[4], start[4];
      if (dir == 0) seg_comp<false>(a, bx, A, B); else seg_comp<true>(a, bx, A, B);
#pragma unroll
      for (int q = 0; q < 4; ++q) { const float pA = __shfl_xor(A[q], 32), pB = __shfl_xor(B[q], 32);
        loA[q] = hi ? pA : A[q]; loB[q] = hi ? pB : B[q]; hiA[q] = hi ? A[q] : pA; hiB[q] = hi ? B[q] : pB; }
      float Aw = 1.f;
#pragma unroll
      for (int q = 0; q < 4; ++q) Aw *= loA[q] * hiA[q];
      const float Bw = (dir == 0) ? seg_prefix<false>(loA, loB, hiA, hiB, hi, 0.f, start) : seg_prefix<true>(loA, loB, hiA, hiB, hi, 0.f, start);
      if (hi == 0) comp[((cgp * 2 + dir) * 8 + wid) * 32 + j] = (f32x2){Aw, Bw};
      if (PASS == 2) {
        __syncthreads();
        float st = carry[dir * 128 + ch];
        if (dir == 0) { for (int w2 = 0; w2 < wid; ++w2) { const f32x2 ab = comp[((cgp * 2 + 0) * 8 + w2) * 32 + j]; st = ab.x * st + ab.y; } }
        else { for (int w2 = 7; w2 > wid; --w2) { const f32x2 ab = comp[((cgp * 2 + 1) * 8 + w2) * 32 + j]; st = ab.x * st + ab.y; } }
        if (dir == 0) { (void)seg_prefix<false>(loA, loB, hiA, hiB, hi, st, start);
#pragma unroll
          for (int q = 0; q < 4; ++q) { float h = start[q];
#pragma unroll
            for (int e = 0; e < 4; ++e) { const int r = 4 * q + e; h = a[r] * h + bx[r]; sum[r] = h; } } }
        else { (void)seg_prefix<true>(loA, loB, hiA, hiB, hi, st, start);
#pragma unroll
          for (int q = 0; q < 4; ++q) { float h = start[q];
#pragma unroll
            for (int ee = 0; ee < 4; ++ee) { const int r = 4 * q + 3 - ee; h = a[r] * h + bx[r]; sum[r] += h; } } }
      }
    }
    if (PASS == 2) {
      bf16_t* mixed = (bf16_t*)(p.ws + WS_XB); float* ssq_l = (float*)(p.ws + WS_SSQ_L);
#pragma unroll
      for (int r = 0; r < 16; ++r) { const int row = row0 + 32 * wid + crow(r, hi);
        const float g = bf2f(U[(size_t)row * LDU + UC_G + gch]);
        const float u3 = 0.7978845608028654f * (g + 0.044715f * g * g * g);
        const float th = 1.0f - 2.0f * __builtin_amdgcn_rcpf(1.0f + __expf(2.0f * u3));
        const float val = sum[r] * (0.5f * g * (1.0f + th));
        const unsigned pk = cvt_pk_bf16(val, val); const bf16_t hv = (bf16_t)(pk & 0xffffu);
        mixed[(size_t)row * DM + 1024 + gch] = hv;
        float q = bf2f(hv); q = q * q;
        q += __shfl_xor(q, 1); q += __shfl_xor(q, 2); q += __shfl_xor(q, 4); q += __shfl_xor(q, 8); q += __shfl_xor(q, 16);
        if (j == 0) atomicAdd(ssq_l + row, q); }
    }
  }
  if (PASS == 1) {
    __syncthreads();
    if (tid < 256) { const int dir = tid >> 7, ch = tid & 127, cgp = ch >> 5, jj = ch & 31; float A = 1.f, B = 0.f;
      if (dir == 0) { for (int w2 = 0; w2 < 8; ++w2) { const f32x2 ab = comp[((cgp * 2 + 0) * 8 + w2) * 32 + jj]; B = ab.x * B + ab.y; A *= ab.x; } }
      else { for (int w2 = 7; w2 >= 0; --w2) { const f32x2 ab = comp[((cgp * 2 + 1) * 8 + w2) * 32 + jj]; B = ab.x * B + ab.y; A *= ab.x; } }
      agg[(size_t)(dir * NCHUNK + chunk) * 1024 + n * 128 + ch] = (f32x2){A, B}; }
  }
  __syncthreads();
}
}

__device__ __forceinline__ void tr_item(const float* W, int ldw, int K, int srccol0, const float* gk, bf16_t* dst, int k0, LAS float* scr, int lane) {
#pragma unroll 8
  for (int i = 0; i < 32; ++i) { const int kk = 2 * i + (lane >> 5); float v = 0.f;
    if (srccol0 >= 0) { v = W[(size_t)(k0 + kk) * ldw + srccol0 + (lane & 31)]; if (gk) v *= gk[kk]; }
    scr[kk * 33 + (lane & 31)] = v; }
  asm volatile("s_waitcnt lgkmcnt(0)" ::: "memory");
  const int c = lane & 7;
#pragma unroll
  for (int jq = 0; jq < 4; ++jq) { const int nn = (lane >> 3) + 8 * jq; const LAS float* s = scr + (8 * c) * 33 + nn;
    u32x4 o; o.x = cvt_pk_bf16(s[0 * 33], s[1 * 33]); o.y = cvt_pk_bf16(s[2 * 33], s[3 * 33]); o.z = cvt_pk_bf16(s[4 * 33], s[5 * 33]); o.w = cvt_pk_bf16(s[6 * 33], s[7 * 33]);
    *(u32x4*)(dst + (size_t)nn * K + k0 + 8 * c) = o; }
  asm volatile("s_waitcnt lgkmcnt(0)" ::: "memory");
}

__device__ __forceinline__ void p0_prologue(const Params& p, LAS unsigned char* lds, int vcu, int G) {
  int tid_ = threadIdx.x; asm volatile("" : "+v"(tid_));
  const int tid = tid_, lane = tid & 63, wave = __builtin_amdgcn_readfirstlane(tid >> 6);
  const int gw = vcu * 8 + wave, NGW = G * 8;
  const size_t gt = (size_t)blockIdx.x * 512 + tid, NGT = (size_t)G * 512;
  unsigned char* ws = p.ws;
  { float* z = (float*)(ws + WS_ZERO); for (size_t i = gt; i < ZERO_BYTES / 4; i += NGT) z[i] = 0.f; }
  { f32x2* rt = (f32x2*)(ws + WS_ROPE);
    for (size_t i = gt; i < (size_t)SEQP * 32; i += NGT) { const int s = (int)(i >> 5), f = (int)(i & 31);
      double rev = (double)s * INV_FREQ[f] * 0.15915494309189535; rev -= __builtin_rint(rev); const float r = (float)rev;
      rt[i] = (f32x2){__builtin_amdgcn_cosf(r), __builtin_amdgcn_sinf(r)}; } }
  { bf16_t* wf = (bf16_t*)(ws + WS_BRG);
    for (size_t ci = gt; ci < 65536; ci += NGT) { const int ln = (int)(ci & 63), ks = (int)((ci >> 6) & 7), cgp = (int)((ci >> 9) & 3), dw = (int)((ci >> 11) & 3), n = (int)(ci >> 13);
      const int jj = ln & 31, kg = ln >> 5, dir = dw >> 1, wh = dw & 1;
      const float* src = (wh ? p.in[14] : p.in[12]) + (size_t)(dir * 8 + n) * 128 * 128 + (size_t)(16 * ks + 8 * kg) * 128 + 32 * cgp + jj;
      u32x4 o; o.x = cvt_pk_bf16(src[0], src[128]); o.y = cvt_pk_bf16(src[256], src[384]); o.z = cvt_pk_bf16(src[512], src[640]); o.w = cvt_pk_bf16(src[768], src[896]);
      *(u32x4*)(wf + ci * 8) = o; } }
  { bf16_t* xb = (bf16_t*)(ws + WS_XB); float* rs1 = (float*)(ws + WS_RS1);
    for (int m = gw; m < M; m += NGW) { const float* xrow = (m < MP) ? p.in[0] + (size_t)m * DM : p.in[1] + (size_t)(m - MP) * DM;
      f32x4 v[8]; float s = 0.f;
#pragma unroll
      for (int q = 0; q < 8; ++q) { v[q] = *(const f32x4*)(xrow + q * 256 + lane * 4); s += (v[q][0] * v[q][0] + v[q][1] * v[q][1]) + (v[q][2] * v[q][2] + v[q][3] * v[q][3]); }
      s = wave_sum(s);
      if (lane == 0) rs1[m] = 1.0f / sqrtf(s * (1.0f / DM) + EPS);
#pragma unroll
      for (int q = 0; q < 8; ++q) { u32x2 w; w.x = cvt_pk_bf16(v[q][0], v[q][1]); w.y = cvt_pk_bf16(v[q][2], v[q][3]); *(u32x2*)(xb + (size_t)m * DM + q * 256 + lane * 4) = w; } } }
  LAS float* scr = (LAS float*)(lds + wave * 16384);
  constexpr int I_IN = 96 * 32, I_UQ = 64 * 8, I_UKV = 64 * 4, I_OUT = 64 * 32, I_GU = 352 * 32, I_DN = 64 * 88;
  constexpr int NITEMS = I_IN + I_UQ + I_UKV + I_OUT + I_GU + I_DN;
  for (int it = gw; it < NITEMS; it += NGW) {
    int r = it;
    if (r < I_IN) { const int ng = r >> 5, kb = r & 31, dc = ng * 32; int sc;
      if (dc < 768) sc = dc; else if (dc < 1792) sc = dc - 768 + 832; else if (dc < 2816) sc = dc - 1792 + 1856; else if (dc < 2880) sc = dc - 2816 + 768; else sc = -1;
      tr_item(p.in[3], 2880, 2048, sc, p.in[2] + kb * 64, (bf16_t*)(ws + WS_BIN) + (size_t)dc * 2048, kb * 64, scr, lane); continue; } r -= I_IN;
    if (r < I_UQ) { const int ng = r >> 3, kb = r & 7, h = ng >> 3, t0 = (ng & 7) * 32; int d;
      if (t0 < 96) d = t0; else if (t0 == 96) d = 128; else if (t0 == 128) d = 96; else if (t0 == 224) d = 160; else d = -1;
      tr_item(p.in[5], 1536, 512, d < 0 ? -1 : h * 192 + d, p.in[4] + kb * 64, (bf16_t*)(ws + WS_BUQ) + (size_t)(ng * 32) * 512, kb * 64, scr, lane); continue; } r -= I_UQ;
    if (r < I_UKV) { const int ng = r >> 2, kb = r & 3;
      tr_item(p.in[7], 2048, 256, ng * 32, p.in[6] + kb * 64, (bf16_t*)(ws + WS_BUKV) + (size_t)(ng * 32) * 256, kb * 64, scr, lane); continue; } r -= I_UKV;
    if (r < I_OUT) { const int ng = r >> 5, kb = r & 31; const float* gk = (kb < 16) ? p.in[17] + kb * 64 : p.in[18] + (kb - 16) * 64;
      tr_item(p.in[19], 2048, 2048, ng * 32, gk, (bf16_t*)(ws + WS_BOUT) + (size_t)(ng * 32) * 2048, kb * 64, scr, lane); continue; } r -= I_OUT;
    if (r < I_GU) { const int ng = r >> 5, kb = r & 31, R = ng * 32, pn = R >> 8, within = R & 255, bj = within >> 7, c = within & 127;
      tr_item(bj ? p.in[22] : p.in[21], DFF, 2048, pn * 128 + c, p.in[20] + kb * 64, (bf16_t*)(ws + WS_BGU) + (size_t)R * 2048, kb * 64, scr, lane); continue; } r -= I_GU;
    { const int ng = r / 88, kb = r % 88;
      tr_item(p.in[23], 2048, DFF, ng * 32, nullptr, (bf16_t*)(ws + WS_BDN) + (size_t)(ng * 32) * DFF, kb * 64, scr, lane); }
  }
}

__global__ void __launch_bounds__(512, 2) hymba_fwd(Params p) {
  extern __shared__ __attribute__((aligned(16))) unsigned char lds[];
  cg::grid_group grid = cg::this_grid();
  LAS unsigned char* ldsl = (LAS unsigned char*)lds;
  const int G = gridDim.x, bx = blockIdx.x;
  const int vcu = (G % 8 == 0) ? (bx % 8) * (G / 8) + bx / 8 : bx;
  unsigned char* ws = p.ws;

#ifndef NO_P0
  p0_prologue(p, ldsl, vcu, G);
#endif
  grid.sync();

  { pg8::Gemm g{(const bf16_t*)(ws + WS_XB), (const bf16_t*)(ws + WS_BIN), DM, LDU, DM}; pg8::StaticOrder S; S.init(M, LDU, G, bx);
    pg8::EpiU E{(bf16_t*)(ws + WS_U), (const float*)(ws + WS_RS1), (float*)(ws + WS_SSQ_Q), (float*)(ws + WS_SSQ_KV), (float*)(ws + WS_SSQ_PE)};

#ifndef NO_EPIU
    pg8::gemm_phase<pg8::EpiU>(ldsl, g, S, E);
#endif
  }
  grid.sync();

  { pg8::Gemm g{(const bf16_t*)(ws + WS_U) + UC_Q, (const bf16_t*)(ws + WS_BUQ), LDU, 2048, 512}; pg8::StaticOrder S; S.init(M, 2048, G, bx);
    pg8::EpiQ E{(bf16_t*)(ws + WS_Q), (const float*)(ws + WS_SSQ_Q), p.in[8], (const f32x2*)(ws + WS_ROPE), (LAS float*)(ldsl + XCH_OFF)};

#ifndef NO_EPIQ
    pg8::gemm_phase<pg8::EpiQ>(ldsl, g, S, E);
#endif
  }
  { pg8::Gemm g{(const bf16_t*)(ws + WS_U) + UC_KV, (const bf16_t*)(ws + WS_BUKV), LDU, 2048, 256}; pg8::StaticOrder S; S.init(M, 2048, G, bx);
    pg8::EpiKV E{(bf16_t*)(ws + WS_K), (bf16_t*)(ws + WS_V), (const bf16_t*)(ws + WS_U), (const float*)(ws + WS_SSQ_KV), (const float*)(ws + WS_SSQ_PE), p.in[9], (const f32x2*)(ws + WS_ROPE), (LAS float*)(ldsl + XCH_OFF)};

#ifndef NO_EPIKV
    pg8::gemm_phase<pg8::EpiKV>(ldsl, g, S, E);
#endif
  }
#ifndef NO_LRU1
  for (int u = vcu; u < NCHUNK * 8; u += G) lru::unit<1>(p, u >> 3, u & 7, (char*)lds);
#endif
  grid.sync();

#ifndef NO_LRU2
  for (int u = vcu; u < NCHUNK * 8; u += G) lru::unit<2>(p, u >> 3, u & 7, (char*)lds);
#endif
#ifndef NO_ATT
  { const bf16_t* Qt = (const bf16_t*)(ws + WS_Q); const bf16_t* Kt = (const bf16_t*)(ws + WS_K); const bf16_t* Vt = (const bf16_t*)(ws + WS_V);
    bf16_t* mixed = (bf16_t*)(ws + WS_XB); float* ssq_a = (float*)(ws + WS_SSQ_A);
    const int nrp = (1024 + G - 1) / G, nrs = (256 + G - 1) / G;
    for (int i = 0; i < nrp + nrs; ++i) { int pl, qb, seq, row0; size_t prow;
      if (i < nrp) { if (G == 256) { pl = 2 * (vcu >> 5) + (i >> 1); qb = (vcu & 31) + 32 * (i & 1); } else { const int uu = i * G + vcu; if (uu >= 1024) continue; pl = uu >> 6; qb = uu & 63; }
        prow = (size_t)pl * SEQP; seq = SEQP; row0 = (pl >> 3) * SEQP + qb * 256; }
      else { const int uu = (i - nrp) * G + vcu; if (uu >= 256) continue; pl = uu >> 3; qb = uu & 7; prow = (size_t)MP * NH + (size_t)pl * SEQS; seq = SEQS; row0 = MP + (pl >> 3) * SEQS + qb * 256; }
      const int h = pl & 7;
      att::attn_unit(Qt + (prow + qb * 256) * DK, Kt + prow * DK, Vt + prow * DV, mixed + (size_t)row0 * DM + h * 128, ssq_a + row0, seq, (char*)lds); }
  }
#endif
  grid.sync();

  { pg8::Gemm g{(const bf16_t*)(ws + WS_XB), (const bf16_t*)(ws + WS_BOUT), DM, DM, DM}; pg8::StaticOrder S; S.init(M, DM, G, bx);
    pg8::EpiOut E{p.in[0], p.in[1], p.out, (bf16_t*)(ws + WS_U), (const float*)(ws + WS_SSQ_A), (const float*)(ws + WS_SSQ_L), (float*)(ws + WS_SSQ_2)};

#ifndef NO_EPIOUT
    pg8::gemm_phase<pg8::EpiOut>(ldsl, g, S, E);
#endif
  }
  grid.sync();

  { pg8::Gemm g{(const bf16_t*)(ws + WS_U), (const bf16_t*)(ws + WS_BGU), DM, 2 * DFF, DM}; pg8::StaticOrder S; S.init(M, 2 * DFF, G, bx);
    pg8::EpiGU E{(bf16_t*)(ws + WS_ACT), (const float*)(ws + WS_SSQ_2)};

#ifndef NO_EPIGU
    pg8::gemm_phase<pg8::EpiGU>(ldsl, g, S, E);
#endif
  }
  grid.sync();

  { pg8::Gemm g{(const bf16_t*)(ws + WS_ACT), (const bf16_t*)(ws + WS_BDN), DFF, DM, DFF}; pg8::StaticOrder S; S.init(M, DM, G, bx);
    pg8::EpiDown E{p.out};

#ifndef NO_EPIDOWN
    pg8::gemm_phase<pg8::EpiDown>(ldsl, g, S, E);
#endif
  }
}

extern "C" void kernel_launch(void* const* d_in, const int* in_sizes, int n_in, void* d_out, int out_size, void* d_ws, size_t ws_size, hipStream_t stream) {
  static int grid = 0;
  if (grid == 0) {
    if (n_in != 24 || out_size != M * DM || ws_size < WS_END) { fprintf(stderr, "kernel_launch: unexpected shapes: n_in %d out %d ws %zu (need %zu)\n", n_in, out_size, ws_size, (size_t)WS_END); grid = -1; return; }
    int dev = 0, cus = 0, per_cu = 0;
    hipGetDevice(&dev); hipDeviceGetAttribute(&cus, hipDeviceAttributeMultiprocessorCount, dev);
    if (hipFuncSetAttribute((const void*)hymba_fwd, hipFuncAttributeMaxDynamicSharedMemorySize, LDS_BYTES) != hipSuccess) { fprintf(stderr, "kernel_launch: hipFuncSetAttribute failed\n"); grid = -1; return; }
    if (hipOccupancyMaxActiveBlocksPerMultiprocessor(&per_cu, (const void*)hymba_fwd, 512, LDS_BYTES) != hipSuccess || per_cu < 1) { fprintf(stderr, "kernel_launch: occupancy query says %d\n", per_cu); per_cu = 1; }
    (void)hipGetLastError();
    grid = cus * 1;
  }
  if (grid < 0) return;
  Params p{};
  for (int i = 0; i < 24; ++i) p.in[i] = (const float*)d_in[i];
  p.out = (float*)d_out; p.ws = (unsigned char*)d_ws;
  void* args[] = {&p};
  hipError_t e = hipLaunchCooperativeKernel((const void*)hymba_fwd, dim3(grid), dim3(512), args, LDS_BYTES, stream);
  if (e != hipSuccess) fprintf(stderr, "cooperative launch failed: %s (grid %d)\n", hipGetErrorString(e), grid);
}
```

```cpp
#include <hip/hip_runtime.h>
#include <hip/hip_cooperative_groups.h>
#include <cstdio>
#include <cstdint>
namespace cg = cooperative_groups;

#define LAS __attribute__((address_space(3)))
typedef unsigned short bf16_t;
typedef short bf16x8 __attribute__((ext_vector_type(8)));
typedef short s16x4 __attribute__((ext_vector_type(4)));
typedef float f32x4 __attribute__((ext_vector_type(4)));
typedef float f32x2 __attribute__((ext_vector_type(2)));
typedef float f32x16 __attribute__((ext_vector_type(16)));
typedef unsigned u32x4 __attribute__((ext_vector_type(4)));
typedef unsigned u32x2 __attribute__((ext_vector_type(2)));

constexpr int M = 40960, MP = 32768, SEQP = 16384, SEQS = 2048, DM = 2048;
constexpr int LDU = 3072, UC_Q = 0, UC_KV = 512, UC_X = 768, UC_G = 1792, UC_PE = 2816;
constexpr int NH = 8, DK = 192, DV = 128, DFF = 5632;
constexpr float EPS = 1e-6f;
constexpr int NCHUNK = M / 256;

constexpr size_t MiB = 1u << 20, KiB = 1024;
constexpr size_t WS_RS1 = 0;
constexpr size_t WS_ZERO = 256 * KiB;
constexpr size_t WS_SSQ_Q = WS_ZERO, WS_SSQ_KV = WS_ZERO + 256 * KiB, WS_SSQ_PE = WS_ZERO + 512 * KiB, WS_SSQ_A = WS_ZERO + 768 * KiB,
                 WS_SSQ_L = WS_ZERO + 1024 * KiB, WS_SSQ_2 = WS_ZERO + 1280 * KiB;
constexpr size_t ZERO_BYTES = 1536 * KiB;
constexpr size_t WS_ROPE = 2 * MiB;
constexpr size_t WS_AGG = 6 * MiB;
constexpr size_t WS_DUMMY = 12 * MiB;
constexpr size_t WS_BIN = 16 * MiB, WS_BUQ = 28 * MiB, WS_BUKV = 30 * MiB, WS_BRG = 31 * MiB, WS_BOUT = 32 * MiB, WS_BGU = 40 * MiB, WS_BDN = 84 * MiB;
constexpr size_t WS_XB = 112 * MiB;
constexpr size_t WS_U = 272 * MiB;
constexpr size_t WS_Q = 512 * MiB, WS_K = 632 * MiB, WS_V = 752 * MiB;
constexpr size_t WS_ACT = 512 * MiB;
constexpr size_t WS_END = 952 * MiB;

constexpr int RING_BYTES = 131072, XCH_OFF = 131072, LDS_BYTES = 147456;

#ifndef PROBE_REPEAT
#define PROBE_REPEAT 0
#endif
#define NREP(bit) ((PROBE_REPEAT >> (bit)) & 1 ? 2 : 1)
struct Params {
  const float* in[24];
  float* out;
  unsigned char* ws;
};

__device__ const double INV_FREQ[32] = {1.0, 0.7498942093324559, 0.5623413251903491, 0.4216965034285822, 0.31622776601683794, 0.23713737056616552, 0.1778279410038923, 0.1333521432163324, 0.1, 0.07498942093324558, 0.05623413251903491, 0.042169650342858224, 0.03162277660168379, 0.023713737056616554, 0.01778279410038923, 0.01333521432163324, 0.01, 0.007498942093324558, 0.005623413251903491, 0.004216965034285823, 0.0031622776601683794, 0.0023713737056616554, 0.0017782794100389228, 0.001333521432163324, 0.001, 0.0007498942093324559, 0.0005623413251903491, 0.00042169650342858224, 0.00031622776601683794, 0.00023713737056616554, 0.00017782794100389227, 0.0001333521432163324};

__device__ __forceinline__ unsigned cvt_pk_bf16(float lo, float hi) { unsigned r; asm volatile("v_cvt_pk_bf16_f32 %0, %1, %2" : "=v"(r) : "v"(lo), "v"(hi)); return r; }
__device__ __forceinline__ float bf2f(bf16_t v) { return __uint_as_float(((unsigned)v) << 16); }
__device__ __forceinline__ float bflo(unsigned w) { return __uint_as_float(w << 16); }
__device__ __forceinline__ float bfhi(unsigned w) { return __uint_as_float(w & 0xffff0000u); }
__device__ __forceinline__ float wave_sum(float v) {
#pragma unroll
  for (int o = 1; o < 64; o <<= 1) v += __shfl_xor(v, o);
  return v;
}
__device__ __forceinline__ float shflx(float v, int lane, int mask) { return __int_as_float(__builtin_amdgcn_ds_bpermute((lane ^ mask) << 2, __float_as_int(v))); }
__device__ __forceinline__ float sigmoidf_(float x) { return __builtin_amdgcn_rcpf(1.0f + __builtin_amdgcn_exp2f(x * -1.4426950408889634f)); }
__device__ __forceinline__ int crow(int r, int hi) { return (r & 3) + 8 * (r >> 2) + 4 * hi; }
__device__ __forceinline__ size_t plane_row(int m, int h) {
  if (m < MP) { const int b = m >> 14, s = m & (SEQP - 1); return ((size_t)(b * NH + h) * SEQP + s); }
  const int mm = m - MP, b = mm >> 11, s = mm & (SEQS - 1); return (size_t)MP * NH + ((size_t)(b * NH + h) * SEQS + s);
}
__device__ __forceinline__ int seq_pos(int m) { return m < MP ? (m & (SEQP - 1)) : ((m - MP) & (SEQS - 1)); }

namespace pg8 {
constexpr int BM = 256, BK = 64, HALF = 128, HTB = HALF * BK * 2, STAGE_BYTES = 8 * HTB, NXCD = 8, WGM = 8;
__host__ __device__ __forceinline__ int lds_byte(int r, int c) { const int st = (r >> 4) * 2 + (c >> 5), rr = r & 15, cc = c & 31, ob = rr * 64 + cc * 2; return st * 1024 + (ob ^ (((ob >> 9) & 1) << 5)); }
__host__ __device__ __forceinline__ void stage_rc(int b, int& R, int& C) { const int st = b / 1024, sb = b % 1024, swz = sb ^ (((sb >> 9) & 1) << 5); R = (st >> 1) * 16 + swz / 64; C = (st & 1) * 32 + (swz % 64) / 2; }
__host__ __device__ __forceinline__ int perm32(int rho) { const int n = rho >> 4, i = rho & 15; return 8 * (i >> 2) + 4 * n + (i & 3); }
struct Unit { int pm, pn; };
struct Gemm { const bf16_t* A; const bf16_t* Bt; int lda, N, K; };
struct StaticOrder {
  int nM, nN, nwg, G, c;
  __device__ void init(int Mr, int N, int G_, int c_) { nM = Mr / BM; nN = N / BM; nwg = nM * nN; G = G_; c = c_; }
  __device__ bool next(int i, Unit& u) const {
    const long L = (long)i * G + c; if (L >= nwg) return false;
    int wgid = (int)L; { const int q = nwg / NXCD, r = nwg % NXCD, xcd = wgid % NXCD, off = wgid / NXCD; wgid = (xcd < r ? xcd * (q + 1) : r * (q + 1) + (xcd - r) * q) + off; }
    const int nig = WGM * nN, gid = wgid / nig, fm = gid * WGM, gsz = (nM - fm) < WGM ? (nM - fm) : WGM;
    u.pm = fm + ((wgid % nig) % gsz); u.pn = (wgid % nig) / gsz; return true;
  }
};
template <class Epi>
__device__ __forceinline__ void gemm_phase(LAS unsigned char* lds, const Gemm g, const StaticOrder& S, const Epi& E) {
  int tid_ = threadIdx.x; asm volatile("" : "+v"(tid_));
  const int tid = tid_, wid = __builtin_amdgcn_readfirstlane(tid >> 6), lane = tid & 63, wr = wid >> 2, wc = wid & 3, fr = lane & 15, fq = lane >> 4;
  const int K = g.K, nt = K / BK, lda = g.lda;
  unsigned voffA[2], voffB[2];
#pragma unroll
  for (int i = 0; i < 2; ++i) { int R, C; stage_rc(tid * 16 + i * 8192, R, C); const int Rb = Epi::PERM ? ((R & ~31) + perm32(R & 31)) : R;
    voffA[i] = (unsigned)(R * lda + C) * 2u; voffB[i] = (unsigned)(Rb * K + C) * 2u; }
  const size_t kstep = (size_t)(BK * 2);
  const size_t hstepA = (size_t)HALF * lda * 2, hstepB = (size_t)HALF * K * 2;
  const size_t tstepA = 2 * hstepA, tstepB = 2 * hstepB;
  const unsigned ldsw = (unsigned)wid * 1024u;
  const int aoff = lds_byte(wr * 64 + fr, fq * 8), boff = lds_byte(wc * 32 + fr, fq * 8);
#define PG8_SA(b, h) (((b) * 2 + (h)) * HTB)
#define PG8_SB(b, h) ((4 + (b) * 2 + (h)) * HTB)
#define PG8_STAGE(bufoff, gbase, voff) do { _Pragma("unroll") for (int _i = 0; _i < 2; ++_i) \
    __builtin_amdgcn_global_load_lds((const unsigned*)((const char*)(gbase) + (voff)[_i]), (LAS unsigned*)(lds + (bufoff) + ldsw + _i * 8192), 16, 0, 0); } while (0)
#define PG8_LDA(dst, b, h) do { _Pragma("unroll") for (int m = 0; m < 4; ++m) _Pragma("unroll") for (int k = 0; k < 2; ++k) dst[m][k] = *(const LAS bf16x8*)(lds + PG8_SA(b, h) + aoff + m * 2048 + k * 1024); } while (0)
#define PG8_LDB(dst, b, h) do { _Pragma("unroll") for (int n = 0; n < 2; ++n) _Pragma("unroll") for (int k = 0; k < 2; ++k) dst[n][k] = *(const LAS bf16x8*)(lds + PG8_SB(b, h) + boff + n * 2048 + k * 1024); } while (0)
#define PG8_MMA(ai, bj, At, Bt) do { __builtin_amdgcn_s_setprio(1); _Pragma("unroll") for (int m = 0; m < 4; ++m) _Pragma("unroll") for (int n = 0; n < 2; ++n) _Pragma("unroll") for (int k = 0; k < 2; ++k) \
    acc[ai][bj][m][n] = __builtin_amdgcn_mfma_f32_16x16x32_bf16(Bt[n][k], At[m][k], acc[ai][bj][m][n], 0, 0, 0); __builtin_amdgcn_s_setprio(0); } while (0)
#define PG8_WAIT_V(n) asm volatile("s_waitcnt vmcnt(" #n ")" ::: "memory")
#define PG8_WAIT_L(n) asm volatile("s_waitcnt lgkmcnt(" #n ")" ::: "memory")
#define PG8_BAR __builtin_amdgcn_s_barrier()
#define PG8_SCHED __builtin_amdgcn_sched_barrier(0)
  Unit cur, nxt; int ui = 0;
  if (!S.next(0, cur)) return;
  f32x4 acc[2][2][4][2];
#pragma unroll
  for (int a = 0; a < 2; ++a)
#pragma unroll
    for (int b = 0; b < 2; ++b)
#pragma unroll
      for (int m = 0; m < 4; ++m)
#pragma unroll
        for (int n = 0; n < 2; ++n) acc[a][b][m][n] = (f32x4){0.f, 0.f, 0.f, 0.f};
  bf16x8 At[4][2], B0[2][2], B1[2][2];
  const char* cA = (const char*)g.A + (size_t)cur.pm * tstepA; const char* cB = (const char*)g.Bt + (size_t)cur.pn * tstepB;
  PG8_STAGE(PG8_SB(0, 0), cB, voffB); PG8_STAGE(PG8_SB(0, 1), cB + hstepB, voffB); PG8_STAGE(PG8_SA(0, 0), cA, voffA); PG8_STAGE(PG8_SA(0, 1), cA + hstepA, voffA);
  if (wr == 1) PG8_BAR;
  PG8_WAIT_V(2); PG8_BAR;
  PG8_STAGE(PG8_SB(1, 0), cB + kstep, voffB); PG8_STAGE(PG8_SA(1, 0), cA + kstep, voffA); PG8_STAGE(PG8_SB(1, 1), cB + hstepB + kstep, voffB);
  PG8_WAIT_V(6); PG8_BAR;
  for (;;) {
    const bool has_next = S.next(ui + 1, nxt);
    const char* nA = has_next ? (const char*)g.A + (size_t)nxt.pm * tstepA : cA; const char* nB = has_next ? (const char*)g.Bt + (size_t)nxt.pn * tstepB : cB;
    for (int t = 0; t < nt; t += 2) {
      const bool last = (t == nt - 2);
      const char* a1 = cA + (size_t)(t + 1) * kstep;
      const char* a2 = last ? nA : cA + (size_t)(t + 2) * kstep; const char* b2 = last ? nB : cB + (size_t)(t + 2) * kstep;
      const char* a3 = a2 + kstep; const char* b3 = b2 + kstep;
      if constexpr (Epi::MIDK) { if (t == (nt >> 1)) E.mid(acc, cur, wr, fr); }
      PG8_LDB(B0, 0, 0); PG8_LDB(B1, 0, 1); PG8_SCHED; PG8_LDA(At, 0, 0); PG8_STAGE(PG8_SA(1, 1), a1 + hstepA, voffA);
      PG8_WAIT_V(8); PG8_WAIT_L(0); PG8_BAR; PG8_MMA(0, 0, At, B0); PG8_MMA(0, 1, At, B1); PG8_BAR; PG8_SCHED;
      PG8_LDA(At, 0, 1); PG8_STAGE(PG8_SB(0, 0), b2, voffB); PG8_STAGE(PG8_SB(0, 1), b2 + hstepB, voffB); PG8_STAGE(PG8_SA(0, 0), a2, voffA);
      PG8_WAIT_V(8); PG8_WAIT_L(0); PG8_BAR; PG8_MMA(1, 0, At, B0); PG8_MMA(1, 1, At, B1); PG8_BAR; PG8_SCHED;
      PG8_LDB(B0, 1, 0); PG8_LDB(B1, 1, 1); PG8_SCHED; PG8_LDA(At, 1, 0); PG8_STAGE(PG8_SA(0, 1), a2 + hstepA, voffA);
      PG8_WAIT_V(8); PG8_WAIT_L(0); PG8_BAR; PG8_MMA(0, 0, At, B0); PG8_MMA(0, 1, At, B1); PG8_BAR; PG8_SCHED;
      PG8_LDA(At, 1, 1); PG8_STAGE(PG8_SB(1, 0), b3, voffB); PG8_STAGE(PG8_SB(1, 1), b3 + hstepB, voffB); PG8_STAGE(PG8_SA(1, 0), a3, voffA);
      PG8_WAIT_V(8); PG8_WAIT_L(0); PG8_BAR; PG8_MMA(1, 0, At, B0); PG8_MMA(1, 1, At, B1); PG8_BAR; PG8_SCHED;
    }
    if (wr == 0) PG8_BAR;
    E(acc, cur, wr, wc, fr, fq);
    if (!has_next) break;
#pragma unroll
    for (int a = 0; a < 2; ++a)
#pragma unroll
      for (int b = 0; b < 2; ++b)
#pragma unroll
        for (int m = 0; m < 4; ++m)
#pragma unroll
          for (int n = 0; n < 2; ++n) acc[a][b][m][n] = (f32x4){0.f, 0.f, 0.f, 0.f};
    cur = nxt; cA = nA; cB = nB; ++ui;
    if (wr == 1) PG8_BAR;
  }
  PG8_WAIT_V(0);
  PG8_BAR;
#undef PG8_SA
#undef PG8_SB
#undef PG8_STAGE
#undef PG8_LDA
#undef PG8_LDB
#undef PG8_MMA
}

struct EpiU {
  static constexpr bool PERM = true, MIDK = false;
  bf16_t* U; const float* rs1; float* ssq_q; float* ssq_kv; float* ssq_pe;
  __device__ __forceinline__ void operator()(const f32x4 (&acc)[2][2][4][2], const Unit& u, int wr, int wc, int fr_, int fq_) const {
    int fr = fr_, fq = fq_; asm volatile("" : "+v"(fr), "+v"(fq));
    float* ssq = (u.pn < 2) ? ssq_q : (u.pn == 2 ? ssq_kv : (u.pn == 11 ? ssq_pe : (float*)nullptr));
    const int col0 = u.pn * BM + wc * 32 + 8 * fq;
#pragma unroll
    for (int ai = 0; ai < 2; ++ai)
#pragma unroll
      for (int m = 0; m < 4; ++m) {
        const int row = u.pm * BM + ai * HALF + wr * 64 + m * 16 + fr; const float s = rs1[row]; float q = 0.f;
        bf16_t* rowp = U + (size_t)row * LDU + col0;
#pragma unroll
        for (int bj = 0; bj < 2; ++bj) { const f32x4 v0 = acc[ai][bj][m][0] * s, v1 = acc[ai][bj][m][1] * s;
          q += (v0[0] * v0[0] + v0[1] * v0[1]) + (v0[2] * v0[2] + v0[3] * v0[3]) + (v1[0] * v1[0] + v1[1] * v1[1]) + (v1[2] * v1[2] + v1[3] * v1[3]);
          u32x4 w; w.x = cvt_pk_bf16(v0[0], v0[1]); w.y = cvt_pk_bf16(v0[2], v0[3]); w.z = cvt_pk_bf16(v1[0], v1[1]); w.w = cvt_pk_bf16(v1[2], v1[3]);
          *(u32x4*)(rowp + bj * HALF) = w; }
        if (ssq) { q += __shfl_xor(q, 16); q += __shfl_xor(q, 32); if (fq == 0) atomicAdd(ssq + row, q); }
      }
  }
};

struct EpiQ {
  static constexpr bool PERM = false, MIDK = false;
  bf16_t* Q; const float* ssq_q; const float* g_qn; const f32x2* rope; LAS float* xch;
  __device__ __forceinline__ void operator()(const f32x4 (&acc)[2][2][4][2], const Unit& u, int wr, int wc, int fr_, int fq_) const {
    int fr = fr_, fq = fq_; asm volatile("" : "+v"(fr), "+v"(fq));
    float rsq[2][4];
#pragma unroll
    for (int ai = 0; ai < 2; ++ai)
#pragma unroll
      for (int m = 0; m < 4; ++m) {
        const int rl = ai * HALF + wr * 64 + m * 16 + fr; const int row = u.pm * BM + rl;
        const float s = __builtin_amdgcn_rsqf(ssq_q[row] * (1.0f / 512.0f) + EPS); rsq[ai][m] = s; float q = 0.f;
#pragma unroll
        for (int bj = 0; bj < 2; ++bj)
#pragma unroll
          for (int n = 0; n < 2; ++n) { const f32x4 v = acc[ai][bj][m][n] * s; q += (v[0] * v[0] + v[1] * v[1]) + (v[2] * v[2] + v[3] * v[3]); }
        q += __shfl_xor(q, 16); q += __shfl_xor(q, 32);
        if (fq == 0) xch[rl * 4 + wc] = q;
      }
    asm volatile("s_waitcnt lgkmcnt(0)" ::: "memory"); __builtin_amdgcn_s_barrier(); asm volatile("" ::: "memory");
    const int h = u.pn;
#pragma unroll
    for (int ai = 0; ai < 2; ++ai)
#pragma unroll
      for (int m = 0; m < 4; ++m) {
        const int rl = ai * HALF + wr * 64 + m * 16 + fr; const int row = u.pm * BM + rl;
        const f32x4 pq = *(const LAS f32x4*)(xch + rl * 4);
        const float tot = (pq[0] + pq[1]) + (pq[2] + pq[3]);
        const float sc = rsq[ai][m] * __builtin_amdgcn_rsqf(tot * (1.0f / 192.0f) + EPS) * 0.10411754627697264f;
        bf16_t* qrow = Q + (plane_row(row, h)) * DK;
        if (wc == 3) {
          const int s = seq_pos(row);
#pragma unroll
          for (int n = 0; n < 2; ++n) { const int i0 = 16 * n + 4 * fq;
            const f32x4 g1 = *(const f32x4*)(g_qn + 128 + i0), g2 = *(const f32x4*)(g_qn + 160 + i0);
            const f32x4 x1 = acc[ai][0][m][n] * sc * g1, x2 = acc[ai][1][m][n] * sc * g2; float o1[4], o2[4];
#pragma unroll
            for (int j = 0; j < 4; ++j) { const f32x2 cs = rope[(size_t)s * 32 + i0 + j]; o1[j] = x1[j] * cs.x - x2[j] * cs.y; o2[j] = x2[j] * cs.x + x1[j] * cs.y; }
            u32x2 w1, w2; w1.x = cvt_pk_bf16(o1[0], o1[1]); w1.y = cvt_pk_bf16(o1[2], o1[3]); w2.x = cvt_pk_bf16(o2[0], o2[1]); w2.y = cvt_pk_bf16(o2[2], o2[3]);
            *(u32x2*)(qrow + 128 + i0) = w1; *(u32x2*)(qrow + 160 + i0) = w2; }
        } else {
#pragma unroll
          for (int n = 0; n < 2; ++n) { const int d = 32 * wc + 16 * n + 4 * fq;
            const f32x4 gg = *(const f32x4*)(g_qn + d); const f32x4 v = acc[ai][0][m][n] * sc * gg;
            u32x2 w; w.x = cvt_pk_bf16(v[0], v[1]); w.y = cvt_pk_bf16(v[2], v[3]); *(u32x2*)(qrow + d) = w; }
          if (wc == 0) {
#pragma unroll
            for (int n = 0; n < 2; ++n) { const int d = 96 + 16 * n + 4 * fq;
              const f32x4 gg = *(const f32x4*)(g_qn + d); const f32x4 v = acc[ai][1][m][n] * sc * gg;
              u32x2 w; w.x = cvt_pk_bf16(v[0], v[1]); w.y = cvt_pk_bf16(v[2], v[3]); *(u32x2*)(qrow + d) = w; }
          }
        }
      }
  }
};

struct EpiKV {
  static constexpr bool PERM = false, MIDK = false;
  bf16_t* Kt; bf16_t* Vt; const bf16_t* U; const float* ssq_kv; const float* ssq_pe; const float* g_kn; const f32x2* rope; LAS float* xch;
  __device__ __forceinline__ void operator()(const f32x4 (&acc)[2][2][4][2], const Unit& u, int wr, int wc, int fr_, int fq_) const {
    int fr = fr_, fq = fq_; asm volatile("" : "+v"(fr), "+v"(fq));
    float rsq[2][4];
#pragma unroll
    for (int ai = 0; ai < 2; ++ai)
#pragma unroll
      for (int m = 0; m < 4; ++m) {
        const int rl = ai * HALF + wr * 64 + m * 16 + fr; const int row = u.pm * BM + rl;
        const float s = __builtin_amdgcn_rsqf(ssq_kv[row] * (1.0f / 256.0f) + EPS); rsq[ai][m] = s; float q = 0.f;
#pragma unroll
        for (int n = 0; n < 2; ++n) { const f32x4 v = acc[ai][0][m][n] * s; q += (v[0] * v[0] + v[1] * v[1]) + (v[2] * v[2] + v[3] * v[3]); }
        q += __shfl_xor(q, 16); q += __shfl_xor(q, 32);
        if (fq == 0) xch[rl * 4 + wc] = q;
      }
    asm volatile("s_waitcnt lgkmcnt(0)" ::: "memory"); __builtin_amdgcn_s_barrier(); asm volatile("" ::: "memory");
    const int h = u.pn;
#pragma unroll
    for (int ai = 0; ai < 2; ++ai)
#pragma unroll
      for (int m = 0; m < 4; ++m) {
        const int rl = ai * HALF + wr * 64 + m * 16 + fr; const int row = u.pm * BM + rl;
        const f32x4 pq = *(const LAS f32x4*)(xch + rl * 4);
        const float tot = (pq[0] + pq[1]) + (pq[2] + pq[3]) + ssq_pe[row];
        const float rstd = __builtin_amdgcn_rsqf(tot * (1.0f / 192.0f) + EPS);
        const float sc = rsq[ai][m] * rstd;
        const size_t pr = plane_row(row, h);
        bf16_t* krow = Kt + pr * DK; bf16_t* vrow = Vt + pr * DV;
#pragma unroll
        for (int n = 0; n < 2; ++n) { const int d = 32 * wc + 16 * n + 4 * fq;
          const f32x4 gg = *(const f32x4*)(g_kn + d); const f32x4 kv = acc[ai][0][m][n] * sc * gg; const f32x4 vv = acc[ai][1][m][n] * rsq[ai][m];
          u32x2 w; w.x = cvt_pk_bf16(kv[0], kv[1]); w.y = cvt_pk_bf16(kv[2], kv[3]); *(u32x2*)(krow + d) = w;
          u32x2 wv; wv.x = cvt_pk_bf16(vv[0], vv[1]); wv.y = cvt_pk_bf16(vv[2], vv[3]); *(u32x2*)(vrow + d) = wv; }
        { const int i0 = 8 * wc + 2 * fq; const int s = seq_pos(row);
          const unsigned p1 = *(const unsigned*)(U + (size_t)row * LDU + UC_PE + i0), p2 = *(const unsigned*)(U + (size_t)row * LDU + UC_PE + 32 + i0);
          const float x1a = bflo(p1) * rstd * g_kn[128 + i0], x1b = bfhi(p1) * rstd * g_kn[128 + i0 + 1];
          const float x2a = bflo(p2) * rstd * g_kn[160 + i0], x2b = bfhi(p2) * rstd * g_kn[160 + i0 + 1];
          const f32x2 ca = rope[(size_t)s * 32 + i0], cb = rope[(size_t)s * 32 + i0 + 1];
          *(unsigned*)(krow + 128 + i0) = cvt_pk_bf16(x1a * ca.x - x2a * ca.y, x1b * cb.x - x2b * cb.y);
          *(unsigned*)(krow + 160 + i0) = cvt_pk_bf16(x2a * ca.x + x1a * ca.y, x2b * cb.x + x1b * cb.y); }
        asm volatile("" ::: "memory");
      }
  }
};

struct EpiOut {
  static constexpr bool PERM = false, MIDK = true;
  const float* xp; const float* xs; float* out; bf16_t* x1b; const float* ssq_a; const float* ssq_l; float* ssq2;
  __device__ __forceinline__ void mid(f32x4 (&acc)[2][2][4][2], const Unit& u, int wr, int fr_) const {
    int fr = fr_; asm volatile("" : "+v"(fr));
#pragma unroll
    for (int ai = 0; ai < 2; ++ai)
#pragma unroll
      for (int m = 0; m < 4; ++m) { const int row = u.pm * BM + ai * HALF + wr * 64 + m * 16 + fr;
        const float sa = __builtin_amdgcn_rsqf(ssq_a[row] * (1.0f / 1024.0f) + EPS), sl = __builtin_amdgcn_rsqf(ssq_l[row] * (1.0f / 1024.0f) + EPS);
        const float ratio = sa / sl;
#pragma unroll
        for (int bj = 0; bj < 2; ++bj)
#pragma unroll
          for (int n = 0; n < 2; ++n) acc[ai][bj][m][n] *= ratio; }
  }
  __device__ __forceinline__ void operator()(const f32x4 (&acc)[2][2][4][2], const Unit& u, int wr, int wc, int fr_, int fq_) const {
    int fr = fr_, fq = fq_; asm volatile("" : "+v"(fr), "+v"(fq));
    const int col0 = u.pn * BM + wc * 32 + 4 * fq;
#pragma unroll
    for (int ai = 0; ai < 2; ++ai)
#pragma unroll
      for (int m = 0; m < 4; ++m) { const int row = u.pm * BM + ai * HALF + wr * 64 + m * 16 + fr;
        const float sl = __builtin_amdgcn_rsqf(ssq_l[row] * (1.0f / 1024.0f) + EPS);
        const float* xrow = (row < MP) ? xp + (size_t)row * DM : xs + (size_t)(row - MP) * DM; float q = 0.f;
#pragma unroll
        for (int bj = 0; bj < 2; ++bj)
#pragma unroll
          for (int n = 0; n < 2; ++n) { const int c = col0 + bj * HALF + n * 16;
            const f32x4 xv = *(const f32x4*)(xrow + c); const f32x4 o = xv + acc[ai][bj][m][n] * sl;
            *(f32x4*)(out + (size_t)row * DM + c) = o; q += (o[0] * o[0] + o[1] * o[1]) + (o[2] * o[2] + o[3] * o[3]);
            u32x2 w; w.x = cvt_pk_bf16(o[0], o[1]); w.y = cvt_pk_bf16(o[2], o[3]); *(u32x2*)(x1b + (size_t)row * DM + c) = w; }
        q += __shfl_xor(q, 16); q += __shfl_xor(q, 32); if (fq == 0) atomicAdd(ssq2 + row, q); }
  }
};

struct EpiGU {
  static constexpr bool PERM = true, MIDK = false;
  bf16_t* act; const float* ssq2;
  __device__ __forceinline__ void operator()(const f32x4 (&acc)[2][2][4][2], const Unit& u, int wr, int wc, int fr_, int fq_) const {
    int fr = fr_, fq = fq_; asm volatile("" : "+v"(fr), "+v"(fq));
    const int col0 = u.pn * HALF + wc * 32 + 8 * fq;
#pragma unroll
    for (int ai = 0; ai < 2; ++ai)
#pragma unroll
      for (int m = 0; m < 4; ++m) { const int row = u.pm * BM + ai * HALF + wr * 64 + m * 16 + fr;
        const float rs = __builtin_amdgcn_rsqf(ssq2[row] * (1.0f / 2048.0f) + EPS);
        float r[8];
#pragma unroll
        for (int n = 0; n < 2; ++n)
#pragma unroll
          for (int j = 0; j < 4; ++j) { const float gv = acc[ai][0][m][n][j] * rs, uv = acc[ai][1][m][n][j] * rs; r[n * 4 + j] = gv * sigmoidf_(gv) * uv; }
        u32x4 w; w.x = cvt_pk_bf16(r[0], r[1]); w.y = cvt_pk_bf16(r[2], r[3]); w.z = cvt_pk_bf16(r[4], r[5]); w.w = cvt_pk_bf16(r[6], r[7]);
        *(u32x4*)(act + (size_t)row * DFF + col0) = w; }
  }
};

struct EpiDown {
  static constexpr bool PERM = false, MIDK = false;
  float* out;
  __device__ __forceinline__ void operator()(const f32x4 (&acc)[2][2][4][2], const Unit& u, int wr, int wc, int fr_, int fq_) const {
    int fr = fr_, fq = fq_; asm volatile("" : "+v"(fr), "+v"(fq));
    const int col0 = u.pn * BM + wc * 32 + 4 * fq;
#pragma unroll
    for (int ai = 0; ai < 2; ++ai)
#pragma unroll
      for (int m = 0; m < 4; ++m) { const int row = u.pm * BM + ai * HALF + wr * 64 + m * 16 + fr;
#pragma unroll
        for (int bj = 0; bj < 2; ++bj)
#pragma unroll
          for (int n = 0; n < 2; ++n) { float* p = out + (size_t)row * DM + col0 + bj * HALF + n * 16; const f32x4 xv = *(const f32x4*)p; *(f32x4*)p = xv + acc[ai][bj][m][n]; } }
  }
};
}

namespace att {
constexpr int NW = 8, QBLK = 32, KVBLK = 64;
constexpr float QSCALE = 0.10411754627697264f;
constexpr int KROWB = 400;
constexpr int SHM_V = KVBLK * DV * 2, SHM_K = KVBLK * KROWB;
constexpr int QRP = 144;
constexpr int SHM_QR = 2 * SHM_V + 2 * SHM_K + NW * 64 * 4;
constexpr int SHM_ATTN = SHM_QR + NW * 32 * QRP;
#define SBAR() __builtin_amdgcn_sched_barrier(0)
#define SGB(mask, n) __builtin_amdgcn_sched_group_barrier(mask, n, 0)
__device__ __forceinline__ void sched_qk_sm() {
  SGB(0x100, 4);
#pragma unroll
  for (int i = 0; i < 10; ++i) { SGB(0x008, 2); SGB(0x100, 2); SGB(0x402, 8); }
#pragma unroll
  for (int i = 0; i < 2; ++i) { SGB(0x008, 2); SGB(0x402, 8); }
}
typedef __bf16 bf16x2_t __attribute__((ext_vector_type(2)));
__device__ __forceinline__ unsigned cvtpk_s(float lo, float hi) { f32x2 v = {lo, hi}; bf16x2_t b = __builtin_convertvector(v, bf16x2_t); return __builtin_bit_cast(unsigned, b); }
__device__ __forceinline__ void expA(f32x16& p0) {
#pragma unroll
  for (int r = 0; r < 16; ++r) p0[r] = __builtin_amdgcn_exp2f(p0[r]);
}
__device__ __forceinline__ void finishSM(f32x16& p0, f32x16& p1, float& l_reg, bf16x8& pa0, bf16x8& pa1, bf16x8& pa2, bf16x8& pa3) {
#pragma unroll
  for (int r = 0; r < 16; ++r) p1[r] = __builtin_amdgcn_exp2f(p1[r]);
  float ps = 0;
#pragma unroll
  for (int r = 0; r < 16; ++r) ps += p0[r];
#pragma unroll
  for (int r = 0; r < 16; ++r) ps += p1[r];
  l_reg += ps;
#define PK4(P, BASE, OUT) do { unsigned a0 = cvtpk_s(P[BASE + 0], P[BASE + 1]), a1 = cvtpk_s(P[BASE + 2], P[BASE + 3]);   \
    unsigned b0 = cvtpk_s(P[BASE + 4], P[BASE + 5]), b1 = cvtpk_s(P[BASE + 6], P[BASE + 7]);                              \
    auto r0 = __builtin_amdgcn_permlane32_swap(a0, b0, false, false); auto r1 = __builtin_amdgcn_permlane32_swap(a1, b1, false, false); \
    u32x4 w = {r0[0], r1[0], r0[1], r1[1]}; OUT = *reinterpret_cast<bf16x8*>(&w); } while (0)
  PK4(p0, 0, pa0); PK4(p0, 8, pa1); PK4(p1, 0, pa2); PK4(p1, 8, pa3);
#undef PK4
}
__device__ __forceinline__ void qkt(f32x16& p0, f32x16& p1, const char* Ks, const bf16x8* qr, const char* qrl, const f32x16& negm, int r32, int hi) {
  p0 = negm; p1 = negm;
#pragma unroll
  for (int d0 = 0; d0 < 12; ++d0) { const int cb = (d0 * 16 + hi * 8) * 2;
    const bf16x8 b0 = *reinterpret_cast<const bf16x8*>(Ks + r32 * KROWB + cb);
    const bf16x8 b1 = *reinterpret_cast<const bf16x8*>(Ks + (32 + r32) * KROWB + cb);
    const bf16x8 qf = qr[d0];
    p0 = __builtin_amdgcn_mfma_f32_32x32x16_bf16(b0, qf, p0, 0, 0, 0);
    p1 = __builtin_amdgcn_mfma_f32_32x32x16_bf16(b1, qf, p1, 0, 0, 0); }
}
__device__ __forceinline__ int v_st(int k, int c) { const int kk = (k & ~0xC) | ((k & 4) << 1) | ((k & 8) >> 1); return ((kk >> 3) * 4 + (c >> 5)) * 512 + ((kk & 7) * 32 + (c & 31)) * 2; }
__device__ __forceinline__ int v_rd_base(int lane) { return ((lane & 3) << 3) | (((lane >> 2) & 3) << 6) | (((lane >> 4) & 1) << 5) | (((lane >> 5) & 1) << 8); }
constexpr int v_rd_off(int d0, int ks, int half) { return d0 * 512 + ks * 4096 + half * 2048; }
template <int OFF> __device__ __forceinline__ s16x4 tr_read(int vb) {
  s16x4 r; asm volatile("ds_read_b64_tr_b16 %0, %1 offset:%2" : "=&v"(r) : "v"(vb), "i"(OFF) : "memory"); return r;
}
template <int D0> __device__ __forceinline__ void pv_one(f32x16& od, int vb, bf16x8 pa0, bf16x8 pa1, bf16x8 pa2, bf16x8 pa3) {
  const s16x4 l0 = tr_read<v_rd_off(D0, 0, 0)>(vb), h0 = tr_read<v_rd_off(D0, 0, 1)>(vb), l1 = tr_read<v_rd_off(D0, 1, 0)>(vb), h1 = tr_read<v_rd_off(D0, 1, 1)>(vb);
  const s16x4 l2 = tr_read<v_rd_off(D0, 2, 0)>(vb), h2 = tr_read<v_rd_off(D0, 2, 1)>(vb), l3 = tr_read<v_rd_off(D0, 3, 0)>(vb), h3 = tr_read<v_rd_off(D0, 3, 1)>(vb);
  asm volatile("s_waitcnt lgkmcnt(0)" ::: "memory"); SBAR();
#define PK(L, H) (bf16x8){L[0], L[1], L[2], L[3], H[0], H[1], H[2], H[3]}
  od = __builtin_amdgcn_mfma_f32_32x32x16_bf16(pa0, PK(l0, h0), od, 0, 0, 0);
  od = __builtin_amdgcn_mfma_f32_32x32x16_bf16(pa1, PK(l1, h1), od, 0, 0, 0);
  od = __builtin_amdgcn_mfma_f32_32x32x16_bf16(pa2, PK(l2, h2), od, 0, 0, 0);
  od = __builtin_amdgcn_mfma_f32_32x32x16_bf16(pa3, PK(l3, h3), od, 0, 0, 0);
#undef PK
}
__device__ __forceinline__ void pv_d0(f32x16* o, int vb, bf16x8 pa0, bf16x8 pa1, bf16x8 pa2, bf16x8 pa3) {
  pv_one<0>(o[0], vb, pa0, pa1, pa2, pa3); pv_one<1>(o[1], vb, pa0, pa1, pa2, pa3); pv_one<2>(o[2], vb, pa0, pa1, pa2, pa3); pv_one<3>(o[3], vb, pa0, pa1, pa2, pa3);
}
__device__ __forceinline__ void attn_unit(const bf16_t* __restrict__ Qb, const bf16_t* __restrict__ Kh, const bf16_t* __restrict__ Vh, bf16_t* __restrict__ Ob, float* __restrict__ ssq, int seq, float kbound, char* lds) {
  int tid_ = threadIdx.x; asm volatile("" : "+v"(tid_));
  const int tid = tid_, wid = tid >> 6, lane = tid & 63, r32 = lane & 31, hi = lane >> 5;
  char* V_lds = lds; char* K_lds = lds + 2 * SHM_V;
  float* ws = (float*)(lds + 2 * SHM_V + 2 * SHM_K) + wid * 64; float* li_l = ws;
  float l_reg = 0; f32x16 o[4] = {}; bf16x8 qr[12];
  const bf16_t* Qw = Qb + (size_t)(wid * QBLK + r32) * DK + hi * 8;
  float qss = 0.f;
#pragma unroll
  for (int d0 = 0; d0 < 8; ++d0) { qr[d0] = *reinterpret_cast<const bf16x8*>(Qw + d0 * 16);
#pragma unroll
    for (int e = 0; e < 8; ++e) { const float v = bf2f((bf16_t)qr[d0][e]); qss += v * v; } }
  const char* qrl = nullptr;
#pragma unroll
  for (int d0 = 8; d0 < 12; ++d0) { const bf16x8 qv = *reinterpret_cast<const bf16x8*>(Qw + d0 * 16); qr[d0] = qv;
#pragma unroll
    for (int e = 0; e < 8; ++e) { const float v = bf2f((bf16_t)qv[e]); qss += v * v; } }
  { auto rr = __builtin_amdgcn_permlane32_swap(__float_as_uint(qss), __float_as_uint(qss), false, false); qss = __uint_as_float(rr[0]) + __uint_as_float(rr[1]); }
  f32x16 negm; { const float nm = -sqrtf(qss) * kbound;
#pragma unroll
    for (int r = 0; r < 16; ++r) negm[r] = nm; }
  asm volatile("" : "+v"(negm));
  const int sr = tid >> 4, sc = (tid & 15) * 8, vst0 = v_st(sr, sc), vst1 = v_st(32 + sr, sc);
  const int kr = tid >> 3, kc = (tid & 7) * 8;
  const int kst = kr * KROWB + kc * 2;
  const int vb0 = (int)(uintptr_t)V_lds + v_rd_base(lane);
  bf16x8 vs0, vs1, ks0, ks1, ks2;
#define SLOAD(k0) do { vs0 = *reinterpret_cast<const bf16x8*>(&Vh[(size_t)((k0) + sr) * DV + sc]); vs1 = *reinterpret_cast<const bf16x8*>(&Vh[(size_t)((k0) + 32 + sr) * DV + sc]); \
    ks0 = *reinterpret_cast<const bf16x8*>(&Kh[(size_t)((k0) + kr) * DK + kc]); ks1 = *reinterpret_cast<const bf16x8*>(&Kh[(size_t)((k0) + kr) * DK + kc + 64]); \
    ks2 = *reinterpret_cast<const bf16x8*>(&Kh[(size_t)((k0) + kr) * DK + kc + 128]); } while (0)
#define SWRITE(b) do { *(bf16x8*)(V_lds + (b) * SHM_V + vst0) = vs0; *(bf16x8*)(V_lds + (b) * SHM_V + vst1) = vs1; \
    *(bf16x8*)(K_lds + (b) * SHM_K + kst) = ks0; *(bf16x8*)(K_lds + (b) * SHM_K + kst + 128) = ks1; *(bf16x8*)(K_lds + (b) * SHM_K + kst + 256) = ks2; } while (0)
#define SWAIT() asm volatile("s_waitcnt vmcnt(0)" ::: "memory")
  f32x16 pA0, pA1, pB0, pB1; bf16x8 pa0, pa1, pa2, pa3; const int NT = seq / KVBLK;
  SLOAD(0); SWAIT(); SWRITE(0); __syncthreads();
  qkt(pA0, pA1, K_lds, qr, qrl, negm, r32, hi); expA(pA0);
  SLOAD(KVBLK);
  SWAIT(); SWRITE(1); __syncthreads();
  for (int j = 1; j + 1 < NT; j += 2) {
    SBAR(); qkt(pB0, pB1, K_lds + SHM_K, qr, qrl, negm, r32, hi);
    finishSM(pA0, pA1, l_reg, pa0, pa1, pa2, pa3); sched_qk_sm(); SBAR();
    SLOAD((j + 1) * KVBLK); SBAR();
    pv_d0(o, vb0, pa0, pa1, pa2, pa3); expA(pB0);
    __syncthreads(); SWAIT(); SWRITE(0);
    __syncthreads();
    SBAR(); qkt(pA0, pA1, K_lds, qr, qrl, negm, r32, hi);
    finishSM(pB0, pB1, l_reg, pa0, pa1, pa2, pa3); sched_qk_sm(); SBAR();
    SLOAD((j + 2) * KVBLK); SBAR();
    pv_d0(o, vb0 + SHM_V, pa0, pa1, pa2, pa3); expA(pA0);
    __syncthreads(); SWAIT(); SWRITE(1);
    __syncthreads();
  }
  SBAR(); qkt(pB0, pB1, K_lds + SHM_K, qr, qrl, negm, r32, hi);
  finishSM(pA0, pA1, l_reg, pa0, pa1, pa2, pa3); SBAR();
  pv_d0(o, vb0, pa0, pa1, pa2, pa3); expA(pB0);
  finishSM(pB0, pB1, l_reg, pa0, pa1, pa2, pa3); SBAR();
  pv_d0(o, vb0 + SHM_V, pa0, pa1, pa2, pa3);
  { auto rr = __builtin_amdgcn_permlane32_swap(__float_as_uint(l_reg), __float_as_uint(l_reg), false, false); l_reg = __uint_as_float(rr[0]) + __uint_as_float(rr[1]); }
  if (hi == 0) li_l[r32] = l_reg; asm volatile("s_waitcnt lgkmcnt(0)" ::: "memory");
  int lane_e = lane; asm volatile("" : "+v"(lane_e));
  const int r32e = lane_e & 31, hie = lane_e >> 5;
  float rli[16];
#pragma unroll
  for (int r = 0; r < 16; ++r) rli[r] = __builtin_amdgcn_rcpf(li_l[crow(r, hie)]);
  __syncthreads();
  bf16_t* stg = (bf16_t*)(lds + wid * 8192);
#pragma unroll
  for (int r = 0; r < 16; ++r) { const int orow = crow(r, hie);
#pragma unroll
    for (int d0 = 0; d0 < 4; ++d0) { const float v = o[d0][r] * rli[r]; stg[orow * 128 + d0 * 32 + r32e] = (bf16_t)(cvt_pk_bf16(v, v) & 0xffffu); } }
  asm volatile("s_waitcnt lgkmcnt(0)" ::: "memory");
#pragma unroll
  for (int i = 0; i < 8; ++i) { const int row = i * 4 + (lane_e >> 4), ch = lane_e & 15;
    const u32x4 v = *(const u32x4*)(stg + row * 128 + ch * 8);
    *(u32x4*)(Ob + (size_t)(wid * QBLK + row) * DM + ch * 8) = v;
    float q = bflo(v.x) * bflo(v.x) + bfhi(v.x) * bfhi(v.x) + bflo(v.y) * bflo(v.y) + bfhi(v.y) * bfhi(v.y) + bflo(v.z) * bflo(v.z) + bfhi(v.z) * bfhi(v.z) + bflo(v.w) * bflo(v.w) + bfhi(v.w) * bfhi(v.w);
    q += shflx(q, lane_e, 1); q += shflx(q, lane_e, 2); q += shflx(q, lane_e, 4); q += shflx(q, lane_e, 8);
    if (ch == 0) atomicAdd(ssq + wid * QBLK + row, q); }
  __syncthreads();
#undef SLOAD
#undef SWRITE
#undef SWAIT
}
#undef SBAR
}

namespace lru {
constexpr int XROW = 136;
constexpr int X_BYTES = 256 * XROW * 2;
constexpr int COMP_OFF = X_BYTES, COMP_BYTES = 4 * 2 * 8 * 32 * 8;
constexpr int CARRY_OFF = COMP_OFF + COMP_BYTES;
constexpr int WB_OFF = CARRY_OFF + 1024;
template <bool REV> __device__ __forceinline__ void seg_comp(const float (&a)[16], const float (&bx)[16], float (&A)[4], float (&B)[4]) {
#pragma unroll
  for (int q = 0; q < 4; ++q) { float Aq = 1.f, Bq = 0.f;
#pragma unroll
    for (int ee = 0; ee < 4; ++ee) { const int e = REV ? 3 - ee : ee; const int r = 4 * q + e; Bq = a[r] * Bq + bx[r]; Aq *= a[r]; }
    A[q] = Aq; B[q] = Bq; }
}
template <bool REV> __device__ __forceinline__ float seg_prefix(const float (&loA)[4], const float (&loB)[4], const float (&hiA)[4], const float (&hiB)[4], int hi, float st, float (&start)[4]) {
#pragma unroll
  for (int qq = 0; qq < 4; ++qq) { const int q = REV ? 3 - qq : qq;
    if (!REV) { const float t1 = loA[q] * st + loB[q]; start[q] = hi ? t1 : st; st = hiA[q] * t1 + hiB[q]; }
    else { const float t1 = hiA[q] * st + hiB[q]; start[q] = hi ? st : t1; st = loA[q] * t1 + loB[q]; } }
  return st;
}
template <int PASS>
__device__ __forceinline__ void unit(const Params& p, int chunk, int n, char* lds, float* ssq_l) {
  int tid_ = threadIdx.x; asm volatile("" : "+v"(tid_));
  const int tid = tid_, wid = __builtin_amdgcn_readfirstlane(tid >> 6), lane = tid & 63, j = lane & 31, hi = lane >> 5;
  const int cgp = wid & 3, half = wid >> 2;
  const int row0 = chunk * 256;
  int seq_start, seq_len;
  if (row0 < MP) { seq_start = row0 & ~(SEQP - 1); seq_len = SEQP; } else { seq_start = MP + ((row0 - MP) & ~(SEQS - 1)); seq_len = SEQS; }
  const int cs = (row0 - seq_start) >> 8, nch = seq_len >> 8, cbase = seq_start >> 8;
  const bf16_t* U = (const bf16_t*)(p.ws + WS_U);
  bf16_t* X = (bf16_t*)lds;
  f32x2* agg = (f32x2*)(p.ws + WS_AGG);
  const bf16_t* Wf = (const bf16_t*)(p.ws + WS_BRG) + (size_t)n * 4 * 4 * 8 * 64 * 8;
  { const int cg8 = (tid & 15) * 8, tg = tid >> 4; const int c0 = n * 128 + cg8;
    const float* cw = p.in[10]; const float* cb = p.in[11];
    float w[4][8], bb[8];
#pragma unroll
    for (int t = 0; t < 4; ++t) { const f32x4 a = *(const f32x4*)(cw + t * 1024 + c0), b = *(const f32x4*)(cw + t * 1024 + c0 + 4);
      w[t][0] = a[0]; w[t][1] = a[1]; w[t][2] = a[2]; w[t][3] = a[3]; w[t][4] = b[0]; w[t][5] = b[1]; w[t][6] = b[2]; w[t][7] = b[3]; }
    { const f32x4 a = *(const f32x4*)(cb + c0), b = *(const f32x4*)(cb + c0 + 4); bb[0] = a[0]; bb[1] = a[1]; bb[2] = a[2]; bb[3] = a[3]; bb[4] = b[0]; bb[5] = b[1]; bb[6] = b[2]; bb[7] = b[3]; }
    u32x4 rw[11];
#pragma unroll
    for (int rr = 0; rr < 11; ++rr) { const int grow = row0 + tg * 8 + rr - 1; const bool ok = (grow >= seq_start) && (grow < seq_start + seq_len);
      rw[rr] = ok ? *(const u32x4*)(U + (size_t)grow * LDU + UC_X + c0) : (u32x4){0u, 0u, 0u, 0u}; }
#pragma unroll
    for (int t = 0; t < 8; ++t) { float y[8];
#pragma unroll
      for (int c = 0; c < 8; ++c) y[c] = bb[c];
#pragma unroll
      for (int tp = 0; tp < 4; ++tp) { const u32x4 v = rw[t + tp];
        y[0] += w[tp][0] * bflo(v.x); y[1] += w[tp][1] * bfhi(v.x); y[2] += w[tp][2] * bflo(v.y); y[3] += w[tp][3] * bfhi(v.y);
        y[4] += w[tp][4] * bflo(v.z); y[5] += w[tp][5] * bfhi(v.z); y[6] += w[tp][6] * bflo(v.w); y[7] += w[tp][7] * bfhi(v.w); }
      u32x4 o; o.x = cvt_pk_bf16(y[0], y[1]); o.y = cvt_pk_bf16(y[2], y[3]); o.z = cvt_pk_bf16(y[4], y[5]); o.w = cvt_pk_bf16(y[6], y[7]);
      *(u32x4*)(X + (tg * 8 + t) * XROW + cg8) = o; }
  }
  __syncthreads();
  const int ch = 32 * cgp + j, gch = n * 128 + ch;
  const int hc = 2 * cs + half, nhc = 2 * nch, hbase = 2 * cbase;
  const float* lam = p.in[16];
  bf16_t* mixed = (bf16_t*)(p.ws + WS_XB);
#pragma unroll
  for (int dir = 0; dir < 2; ++dir) {
    bf16x8 wr[8], wi[8];
#pragma unroll
    for (int ks = 0; ks < 8; ++ks) { wr[ks] = *(const bf16x8*)(Wf + ((size_t)(((2 * dir) * 4 + cgp) * 8 + ks) * 64 + lane) * 8);
      wi[ks] = *(const bf16x8*)(Wf + ((size_t)(((2 * dir + 1) * 4 + cgp) * 8 + ks) * 64 + lane) * 8); }
    const float br = p.in[13][(dir * 8 + n) * 128 + ch], bi = p.in[15][(dir * 8 + n) * 128 + ch];
    const float lm = lam[dir * 1024 + gch]; const float c8 = (8.0f * 1.4426950408889634f) * log1pf(__expf(-lm));
    float st = 0.f;
    if (PASS == 2) {
      const int cnt = dir ? nhc - 1 - hc : hc; const int h0 = (cnt + 1) >> 1;
      const int kb = hi ? h0 : 0, ke = hi ? cnt : h0;
      float A = 1.f, B = 0.f;
      for (int k0 = kb; k0 < ke; k0 += 16) { f32x2 ab[16];
#pragma unroll
        for (int i = 0; i < 16; ++i) { const int k = k0 + i; const bool ok = k < ke; const int c = ok ? (dir ? nhc - 1 - k : k) : hc;
          ab[i] = agg[(size_t)(dir * (2 * NCHUNK) + hbase + c) * 1024 + gch]; if (!ok) ab[i] = (f32x2){1.f, 0.f}; }
#pragma unroll
        for (int i = 0; i < 16; ++i) { B = ab[i].x * B + ab[i].y; A *= ab[i].x; } }
      const float pA = __shfl_xor(A, 32), pB = __shfl_xor(B, 32);
      st = hi ? (A * pB + B) : (pA * B + pB);
    }
    float Acum = 1.f, Bcum = 0.f;
    for (int tbi = 0; tbi < 4; ++tbi) {
      const int tb = dir ? 3 - tbi : tbi, trow = 128 * half + 32 * tb;
      bf16_t graw[16], hraw[16];
      if (PASS == 2 && dir == 1) { int rb = row0 + trow + 4 * hi; asm volatile("" : "+v"(rb));
#pragma unroll
        for (int r = 0; r < 16; ++r) { const int row = rb + (r & 3) + 8 * (r >> 2); graw[r] = U[(size_t)row * LDU + UC_G + gch]; hraw[r] = mixed[(size_t)row * DM + 1024 + gch]; } }
      f32x16 accr = f32x16{}, acci = f32x16{};
      const bf16_t* Xw = X + (trow + j) * XROW + 8 * hi;
#pragma unroll
      for (int ks = 0; ks < 8; ++ks) { const bf16x8 xa = *(const bf16x8*)(Xw + 16 * ks);
        accr = __builtin_amdgcn_mfma_f32_32x32x16_bf16(xa, wr[ks], accr, 0, 0, 0);
        acci = __builtin_amdgcn_mfma_f32_32x32x16_bf16(xa, wi[ks], acci, 0, 0, 0); }
      float a[16], bx[16];
#pragma unroll
      for (int r = 0; r < 16; ++r) { const float xv = bf2f(X[(trow + crow(r, hi)) * XROW + ch]);
        const float rg = sigmoidf_(accr[r] + br), ig = sigmoidf_(acci[r] + bi);
        const float av = __builtin_amdgcn_exp2f(-c8 * rg); a[r] = av; bx[r] = __builtin_amdgcn_sqrtf(fmaxf(1.0f - av * av, 0.f)) * ig * xv; }
      float A[4], B[4], loA[4], loB[4], hiA[4], hiB[4], start[4];
      if (dir == 0) seg_comp<false>(a, bx, A, B); else seg_comp<true>(a, bx, A, B);
#pragma unroll
      for (int q = 0; q < 4; ++q) { const float pA = __shfl_xor(A[q], 32), pB = __shfl_xor(B[q], 32);
        loA[q] = hi ? pA : A[q]; loB[q] = hi ? pB : B[q]; hiA[q] = hi ? A[q] : pA; hiB[q] = hi ? B[q] : pB; }
      if (PASS == 1) {
        float Aw = 1.f;
#pragma unroll
        for (int q = 0; q < 4; ++q) Aw *= loA[q] * hiA[q];
        const float Bw = (dir == 0) ? seg_prefix<false>(loA, loB, hiA, hiB, hi, 0.f, start) : seg_prefix<true>(loA, loB, hiA, hiB, hi, 0.f, start);
        Bcum = Aw * Bcum + Bw; Acum *= Aw;
      } else {
        const float stn = (dir == 0) ? seg_prefix<false>(loA, loB, hiA, hiB, hi, st, start) : seg_prefix<true>(loA, loB, hiA, hiB, hi, st, start);
        st = stn;
        float h[16];
#pragma unroll
        for (int q = 0; q < 4; ++q) { float hh = start[q];
#pragma unroll
          for (int ee = 0; ee < 4; ++ee) { const int r = 4 * q + (dir ? 3 - ee : ee); hh = a[r] * hh + bx[r]; h[r] = hh; } }
        int rb2 = row0 + trow + 4 * hi, lane2 = lane; asm volatile("" : "+v"(rb2), "+v"(lane2));
        if (dir == 0) {
#pragma unroll
          for (int r = 0; r < 16; ++r) { const int row = rb2 + (r & 3) + 8 * (r >> 2); mixed[(size_t)row * DM + 1024 + gch] = (bf16_t)(cvt_pk_bf16(h[r], h[r]) & 0xffffu); }
        } else {
#pragma unroll
          for (int r = 0; r < 16; ++r) { const int row = rb2 + (r & 3) + 8 * (r >> 2);
            const float g = bf2f(graw[r]);
            const float u3 = 0.7978845608028654f * (g + 0.044715f * g * g * g);
            const float th = 1.0f - 2.0f * __builtin_amdgcn_rcpf(1.0f + __builtin_amdgcn_exp2f((2.0f * 1.4426950408889634f) * u3));
            const float val = (bf2f(hraw[r]) + h[r]) * (0.5f * g * (1.0f + th));
            const unsigned pk = cvt_pk_bf16(val, val); const bf16_t hv = (bf16_t)(pk & 0xffffu);
            mixed[(size_t)row * DM + 1024 + gch] = hv;
            float q = bf2f(hv); q = q * q;
            q += shflx(q, lane2, 1); q += shflx(q, lane2, 2); q += shflx(q, lane2, 4); q += shflx(q, lane2, 8); q += shflx(q, lane2, 16);
            if ((lane2 & 31) == 0) atomicAdd(ssq_l + row, q); }
        }
      }
    }
    if (PASS == 1 && hi == 0) agg[(size_t)(dir * (2 * NCHUNK) + hbase + hc) * 1024 + gch] = (f32x2){Acum, Bcum};
  }
  __syncthreads();
}
}

__device__ __forceinline__ void tr_item(const float* W, int ldw, int K, int srccol0, const float* gk, bf16_t* dst, int k0, LAS float* scr, int lane) {
  { const int n4 = (lane & 7) * 4; f32x4 v[8];
#pragma unroll
    for (int i = 0; i < 8; ++i) { const int kk = 8 * i + (lane >> 3); v[i] = (f32x4){0.f, 0.f, 0.f, 0.f};
      if (srccol0 >= 0) { v[i] = *(const f32x4*)(W + (size_t)(k0 + kk) * ldw + srccol0 + n4); if (gk) v[i] = v[i] * gk[kk]; } }
#pragma unroll
    for (int i = 0; i < 8; ++i) { const int kk = 8 * i + (lane >> 3); LAS float* d = scr + kk * 33 + n4; d[0] = v[i][0]; d[1] = v[i][1]; d[2] = v[i][2]; d[3] = v[i][3]; } }
  asm volatile("s_waitcnt lgkmcnt(0)" ::: "memory");
  const int c = lane & 7;
#pragma unroll
  for (int jq = 0; jq < 4; ++jq) { const int nn = (lane >> 3) + 8 * jq; const LAS float* s = scr + (8 * c) * 33 + nn;
    u32x4 o; o.x = cvt_pk_bf16(s[0 * 33], s[1 * 33]); o.y = cvt_pk_bf16(s[2 * 33], s[3 * 33]); o.z = cvt_pk_bf16(s[4 * 33], s[5 * 33]); o.w = cvt_pk_bf16(s[6 * 33], s[7 * 33]);
    *(u32x4*)(dst + (size_t)nn * K + k0 + 8 * c) = o; }
  asm volatile("s_waitcnt lgkmcnt(0)" ::: "memory");
}

__device__ __forceinline__ void p0_prologue(const Params& p, LAS unsigned char* lds, int vcu, int G) {
  int tid_ = threadIdx.x; asm volatile("" : "+v"(tid_));
  const int tid = tid_, lane = tid & 63, wave = __builtin_amdgcn_readfirstlane(tid >> 6);
  const int gw = vcu * 8 + wave, NGW = G * 8;
  const size_t gt = (size_t)blockIdx.x * 512 + tid, NGT = (size_t)G * 512;
  unsigned char* ws = p.ws;
  { float* z = (float*)(ws + WS_ZERO); for (size_t i = gt; i < ZERO_BYTES / 4; i += NGT) z[i] = 0.f; }
  { f32x2* rt = (f32x2*)(ws + WS_ROPE);
    for (size_t i = gt; i < (size_t)SEQP * 32; i += NGT) { const int s = (int)(i >> 5), f = (int)(i & 31);
      double rev = (double)s * INV_FREQ[f] * 0.15915494309189535; rev -= __builtin_rint(rev); const float r = (float)rev;
      rt[i] = (f32x2){__builtin_amdgcn_cosf(r), __builtin_amdgcn_sinf(r)}; } }
  { bf16_t* wf = (bf16_t*)(ws + WS_BRG);
    for (size_t ci = gt; ci < 65536; ci += NGT) { const int ln = (int)(ci & 63), ks = (int)((ci >> 6) & 7), cgp = (int)((ci >> 9) & 3), dw = (int)((ci >> 11) & 3), n = (int)(ci >> 13);
      const int jj = ln & 31, kg = ln >> 5, dir = dw >> 1, wh = dw & 1;
      const float* src = (wh ? p.in[14] : p.in[12]) + (size_t)(dir * 8 + n) * 128 * 128 + (size_t)(16 * ks + 8 * kg) * 128 + 32 * cgp + jj;
      u32x4 o; o.x = cvt_pk_bf16(src[0], src[128]); o.y = cvt_pk_bf16(src[256], src[384]); o.z = cvt_pk_bf16(src[512], src[640]); o.w = cvt_pk_bf16(src[768], src[896]);
      *(u32x4*)(wf + ci * 8) = o; } }
  { bf16_t* xb = (bf16_t*)(ws + WS_XB); float* rs1 = (float*)(ws + WS_RS1);
    for (int m0 = gw; m0 < M; m0 += 2 * NGW) {
      const int m1 = (m0 + NGW < M) ? m0 + NGW : m0;
      const float* xr0 = (m0 < MP) ? p.in[0] + (size_t)m0 * DM : p.in[1] + (size_t)(m0 - MP) * DM;
      const float* xr1 = (m1 < MP) ? p.in[0] + (size_t)m1 * DM : p.in[1] + (size_t)(m1 - MP) * DM;
      f32x4 v0[8], v1[8]; float s0 = 0.f, s1 = 0.f;
#pragma unroll
      for (int q = 0; q < 8; ++q) { v0[q] = *(const f32x4*)(xr0 + q * 256 + lane * 4); v1[q] = *(const f32x4*)(xr1 + q * 256 + lane * 4); }
#pragma unroll
      for (int q = 0; q < 8; ++q) { s0 += (v0[q][0] * v0[q][0] + v0[q][1] * v0[q][1]) + (v0[q][2] * v0[q][2] + v0[q][3] * v0[q][3]);
        s1 += (v1[q][0] * v1[q][0] + v1[q][1] * v1[q][1]) + (v1[q][2] * v1[q][2] + v1[q][3] * v1[q][3]); }
      s0 = wave_sum(s0); s1 = wave_sum(s1);
      if (lane == 0) { rs1[m0] = 1.0f / sqrtf(s0 * (1.0f / DM) + EPS); rs1[m1] = 1.0f / sqrtf(s1 * (1.0f / DM) + EPS); }
#pragma unroll
      for (int q = 0; q < 8; ++q) { u32x2 w; w.x = cvt_pk_bf16(v0[q][0], v0[q][1]); w.y = cvt_pk_bf16(v0[q][2], v0[q][3]); *(u32x2*)(xb + (size_t)m0 * DM + q * 256 + lane * 4) = w;
        u32x2 w1; w1.x = cvt_pk_bf16(v1[q][0], v1[q][1]); w1.y = cvt_pk_bf16(v1[q][2], v1[q][3]); *(u32x2*)(xb + (size_t)m1 * DM + q * 256 + lane * 4) = w1; } } }
  LAS float* scr = (LAS float*)(lds + wave * 16384);
  constexpr int I_IN = 96 * 32, I_UQ = 64 * 8, I_UKV = 64 * 4, I_OUT = 64 * 32, I_GU = 352 * 32, I_DN = 64 * 88;
  constexpr int NITEMS = I_IN + I_UQ + I_UKV + I_OUT + I_GU + I_DN;
  for (int it = gw; it < NITEMS; it += NGW) {
    int r = it;
    if (r < I_IN) { const int ng = r >> 5, kb = r & 31, dc = ng * 32; int sc;
      if (dc < 768) sc = dc; else if (dc < 1792) sc = dc - 768 + 832; else if (dc < 2816) sc = dc - 1792 + 1856; else if (dc < 2880) sc = dc - 2816 + 768; else sc = -1;
      tr_item(p.in[3], 2880, 2048, sc, p.in[2] + kb * 64, (bf16_t*)(ws + WS_BIN) + (size_t)dc * 2048, kb * 64, scr, lane); continue; } r -= I_IN;
    if (r < I_UQ) { const int ng = r >> 3, kb = r & 7, h = ng >> 3, t0 = (ng & 7) * 32; int d;
      if (t0 < 96) d = t0; else if (t0 == 96) d = 128; else if (t0 == 128) d = 96; else if (t0 == 224) d = 160; else d = -1;
      tr_item(p.in[5], 1536, 512, d < 0 ? -1 : h * 192 + d, p.in[4] + kb * 64, (bf16_t*)(ws + WS_BUQ) + (size_t)(ng * 32) * 512, kb * 64, scr, lane); continue; } r -= I_UQ;
    if (r < I_UKV) { const int ng = r >> 2, kb = r & 3;
      tr_item(p.in[7], 2048, 256, ng * 32, p.in[6] + kb * 64, (bf16_t*)(ws + WS_BUKV) + (size_t)(ng * 32) * 256, kb * 64, scr, lane); continue; } r -= I_UKV;
    if (r < I_OUT) { const int ng = r >> 5, kb = r & 31; const float* gk = (kb < 16) ? p.in[17] + kb * 64 : p.in[18] + (kb - 16) * 64;
      tr_item(p.in[19], 2048, 2048, ng * 32, gk, (bf16_t*)(ws + WS_BOUT) + (size_t)(ng * 32) * 2048, kb * 64, scr, lane); continue; } r -= I_OUT;
    if (r < I_GU) { const int ng = r >> 5, kb = r & 31, R = ng * 32, pn = R >> 8, within = R & 255, bj = within >> 7, c = within & 127;
      tr_item(bj ? p.in[22] : p.in[21], DFF, 2048, pn * 128 + c, p.in[20] + kb * 64, (bf16_t*)(ws + WS_BGU) + (size_t)R * 2048, kb * 64, scr, lane); continue; } r -= I_GU;
    { const int ng = r / 88, kb = r % 88;
      tr_item(p.in[23], 2048, DFF, ng * 32, nullptr, (bf16_t*)(ws + WS_BDN) + (size_t)(ng * 32) * DFF, kb * 64, scr, lane); }
  }
}

__global__ void __launch_bounds__(512, 2) hymba_fwd(Params p) {
  extern __shared__ __attribute__((aligned(16))) unsigned char lds[];
  cg::grid_group grid = cg::this_grid();
  LAS unsigned char* ldsl = (LAS unsigned char*)lds;
  const int G = gridDim.x, bx = blockIdx.x;
  const int vcu = (G % 8 == 0) ? (bx % 8) * (G / 8) + bx / 8 : bx;
  unsigned char* ws = p.ws;
  float* const dummy = (float*)(ws + WS_DUMMY);
#ifndef PROBE_TA
#define PROBE_TA -1
#define PROBE_TB -1
#endif
  unsigned long long t_a = 0, t_b = 0;
#define STAMP(k) do { if (PROBE_TA >= 0) { if ((k) == PROBE_TA) t_a = __builtin_amdgcn_s_memrealtime(); if ((k) == PROBE_TB) t_b = __builtin_amdgcn_s_memrealtime(); } } while (0)
  STAMP(0);

#ifndef NO_P0
  for (int rep = 0; rep < NREP(0); ++rep) p0_prologue(p, ldsl, vcu, G);
#endif
  grid.sync(); STAMP(1);

  for (int rep = 0; rep < NREP(1); ++rep) { pg8::Gemm g{(const bf16_t*)(ws + WS_XB), (const bf16_t*)(ws + WS_BIN), DM, LDU, DM}; pg8::StaticOrder S; S.init(M, LDU, G, bx);
    pg8::EpiU E{(bf16_t*)(ws + WS_U), (const float*)(ws + WS_RS1), rep ? dummy : (float*)(ws + WS_SSQ_Q), rep ? dummy : (float*)(ws + WS_SSQ_KV), rep ? dummy : (float*)(ws + WS_SSQ_PE)};

#ifndef NO_EPIU
    pg8::gemm_phase<pg8::EpiU>(ldsl, g, S, E);
#endif
  }
  grid.sync(); STAMP(2);

  for (int rep = 0; rep < NREP(2); ++rep) {
  { pg8::Gemm g{(const bf16_t*)(ws + WS_U) + UC_Q, (const bf16_t*)(ws + WS_BUQ), LDU, 2048, 512}; pg8::StaticOrder S; S.init(M, 2048, G, bx);
    pg8::EpiQ E{(bf16_t*)(ws + WS_Q), (const float*)(ws + WS_SSQ_Q), p.in[8], (const f32x2*)(ws + WS_ROPE), (LAS float*)(ldsl + XCH_OFF)};

#ifndef NO_EPIQ
    pg8::gemm_phase<pg8::EpiQ>(ldsl, g, S, E);
#endif
  }
  { pg8::Gemm g{(const bf16_t*)(ws + WS_U) + UC_KV, (const bf16_t*)(ws + WS_BUKV), LDU, 2048, 256}; pg8::StaticOrder S; S.init(M, 2048, G, bx);
    pg8::EpiKV E{(bf16_t*)(ws + WS_K), (bf16_t*)(ws + WS_V), (const bf16_t*)(ws + WS_U), (const float*)(ws + WS_SSQ_KV), (const float*)(ws + WS_SSQ_PE), p.in[9], (const f32x2*)(ws + WS_ROPE), (LAS float*)(ldsl + XCH_OFF)};

#ifndef NO_EPIKV
    pg8::gemm_phase<pg8::EpiKV>(ldsl, g, S, E);
#endif
  }
#ifndef NO_LRU1
  for (int u = vcu; u < NCHUNK * 8; u += G) lru::unit<1>(p, u >> 3, u & 7, (char*)lds, nullptr);
#endif
  }
  grid.sync(); STAMP(3);

#ifndef NO_LRU2
  for (int rep = 0; rep < NREP(3); ++rep)
  for (int u = vcu; u < NCHUNK * 8; u += G) lru::unit<2>(p, u >> 3, u & 7, (char*)lds, rep ? dummy : (float*)(ws + WS_SSQ_L));
#endif
  STAMP(4);

#ifndef NO_ATT
  { const bf16_t* Qt = (const bf16_t*)(ws + WS_Q); const bf16_t* Kt = (const bf16_t*)(ws + WS_K); const bf16_t* Vt = (const bf16_t*)(ws + WS_V);
    bf16_t* mixed = (bf16_t*)(ws + WS_XB); float* ssq_a = (float*)(ws + WS_SSQ_A);
    float kbound; { const int ln = threadIdx.x & 63; float gm = fmaxf(fmaxf(fabsf(p.in[9][ln]), fabsf(p.in[9][64 + ln])), fabsf(p.in[9][128 + ln]));
#pragma unroll
      for (int o = 1; o < 64; o <<= 1) gm = fmaxf(gm, __shfl_xor(gm, o));
      kbound = 13.856406460551018f * 1.02f * gm; }
    const int nrp = (1024 + G - 1) / G, nrs = (256 + G - 1) / G;
    for (int rep = 0; rep < NREP(4); ++rep)
    for (int i = 0; i < nrp + nrs; ++i) { int pl, qb, seq, row0; size_t prow;
      if (i < nrp) { if (G == 256) { pl = 2 * (vcu >> 5) + (i >> 1); qb = (vcu & 31) + 32 * (i & 1); } else { const int uu = i * G + vcu; if (uu >= 1024) continue; pl = uu >> 6; qb = uu & 63; }
        prow = (size_t)pl * SEQP; seq = SEQP; row0 = (pl >> 3) * SEQP + qb * 256; }
      else { const int uu = (i - nrp) * G + vcu; if (uu >= 256) continue; pl = uu >> 3; qb = uu & 7; prow = (size_t)MP * NH + (size_t)pl * SEQS; seq = SEQS; row0 = MP + (pl >> 3) * SEQS + qb * 256; }
      const int h = pl & 7;
      att::attn_unit(Qt + (prow + qb * 256) * DK, Kt + prow * DK, Vt + prow * DV, mixed + (size_t)row0 * DM + h * 128, (rep ? dummy : ssq_a) + row0, seq, kbound, (char*)lds); }
  }
#endif
  grid.sync(); STAMP(5);

  for (int rep = 0; rep < NREP(5); ++rep) { pg8::Gemm g{(const bf16_t*)(ws + WS_XB), (const bf16_t*)(ws + WS_BOUT), DM, DM, DM}; pg8::StaticOrder S; S.init(M, DM, G, bx);
    pg8::EpiOut E{p.in[0], p.in[1], p.out, (bf16_t*)(ws + WS_U), (const float*)(ws + WS_SSQ_A), (const float*)(ws + WS_SSQ_L), rep ? dummy : (float*)(ws + WS_SSQ_2)};

#ifndef NO_EPIOUT
    pg8::gemm_phase<pg8::EpiOut>(ldsl, g, S, E);
#endif
  }
  grid.sync(); STAMP(6);

  for (int rep = 0; rep < NREP(6); ++rep) { pg8::Gemm g{(const bf16_t*)(ws + WS_U), (const bf16_t*)(ws + WS_BGU), DM, 2 * DFF, DM}; pg8::StaticOrder S; S.init(M, 2 * DFF, G, bx);
    pg8::EpiGU E{(bf16_t*)(ws + WS_ACT), (const float*)(ws + WS_SSQ_2)};

#ifndef NO_EPIGU
    pg8::gemm_phase<pg8::EpiGU>(ldsl, g, S, E);
#endif
  }
  grid.sync(); STAMP(7);

  { pg8::Gemm g{(const bf16_t*)(ws + WS_ACT), (const bf16_t*)(ws + WS_BDN), DFF, DM, DFF}; pg8::StaticOrder S; S.init(M, DM, G, bx);
    pg8::EpiDown E{p.out};

#ifndef NO_EPIDOWN
    pg8::gemm_phase<pg8::EpiDown>(ldsl, g, S, E);
#endif
  }
  if (PROBE_TA >= 0) { grid.sync(); STAMP(8); if (bx == 0 && threadIdx.x == 0) p.out[(size_t)MP * DM + 12345] += (float)(t_b - t_a) * 1e-5f; }
}

extern "C" void kernel_launch(void* const* d_in, const int* in_sizes, int n_in, void* d_out, int out_size, void* d_ws, size_t ws_size, hipStream_t stream) {
  static int grid = 0;
  if (grid == 0) {
    if (n_in != 24 || out_size != M * DM || ws_size < WS_END) { fprintf(stderr, "kernel_launch: unexpected shapes: n_in %d out %d ws %zu (need %zu)\n", n_in, out_size, ws_size, (size_t)WS_END); grid = -1; return; }
    int dev = 0, cus = 0, per_cu = 0;
    hipGetDevice(&dev); hipDeviceGetAttribute(&cus, hipDeviceAttributeMultiprocessorCount, dev);
    if (hipFuncSetAttribute((const void*)hymba_fwd, hipFuncAttributeMaxDynamicSharedMemorySize, LDS_BYTES) != hipSuccess) { fprintf(stderr, "kernel_launch: hipFuncSetAttribute failed\n"); grid = -1; return; }
    if (hipOccupancyMaxActiveBlocksPerMultiprocessor(&per_cu, (const void*)hymba_fwd, 512, LDS_BYTES) != hipSuccess || per_cu < 1) { fprintf(stderr, "kernel_launch: occupancy query says %d\n", per_cu); per_cu = 1; }
    (void)hipGetLastError();
    grid = cus * 1;
  }
  if (grid < 0) return;
  Params p{};
  for (int i = 0; i < 24; ++i) p.in[i] = (const float*)d_in[i];
  p.out = (float*)d_out; p.ws = (unsigned char*)d_ws;
  void* args[] = {&p};
  hipError_t e = hipLaunchCooperativeKernel((const void*)hymba_fwd, dim3(grid), dim3(512), args, LDS_BYTES, stream);
  if (e != hipSuccess) fprintf(stderr, "cooperative launch failed: %s (grid %d)\n", hipGetErrorString(e), grid);
}
```

```cpp
#include <hip/hip_runtime.h>
#include <hip/hip_cooperative_groups.h>
#include <cstdio>
#include <cstdint>
namespace cg = cooperative_groups;

#define LAS __attribute__((address_space(3)))
typedef unsigned short bf16_t;
typedef short bf16x8 __attribute__((ext_vector_type(8)));
typedef short s16x4 __attribute__((ext_vector_type(4)));
typedef float f32x4 __attribute__((ext_vector_type(4)));
typedef float f32x2 __attribute__((ext_vector_type(2)));
typedef float f32x16 __attribute__((ext_vector_type(16)));
typedef unsigned u32x4 __attribute__((ext_vector_type(4)));
typedef unsigned u32x2 __attribute__((ext_vector_type(2)));

constexpr int M = 40960, MP = 32768, SEQP = 16384, SEQS = 2048, DM = 2048;
constexpr int LDU = 3072, UC_Q = 0, UC_KV = 512, UC_X = 768, UC_G = 1792, UC_PE = 2816;
constexpr int NH = 8, DK = 192, DV = 128, DFF = 5632;
constexpr float EPS = 1e-6f;
constexpr int NCHUNK = M / 256;

constexpr size_t MiB = 1u << 20, KiB = 1024;
constexpr size_t WS_RS1 = 0;
constexpr size_t WS_ZERO = 256 * KiB;
constexpr size_t WS_SSQ_Q = WS_ZERO, WS_SSQ_KV = WS_ZERO + 256 * KiB, WS_SSQ_PE = WS_ZERO + 512 * KiB, WS_SSQ_A = WS_ZERO + 768 * KiB,
                 WS_SSQ_L = WS_ZERO + 1024 * KiB, WS_SSQ_2 = WS_ZERO + 1280 * KiB;
constexpr size_t ZERO_BYTES = 1536 * KiB;
constexpr size_t WS_ROPE = 2 * MiB;
constexpr size_t WS_AGG = 6 * MiB;
constexpr size_t WS_DUMMY = 9 * MiB;
constexpr size_t WS_BIN = 16 * MiB, WS_BUQ = 28 * MiB, WS_BUKV = 30 * MiB, WS_BRG = 31 * MiB, WS_BOUT = 32 * MiB, WS_BGU = 40 * MiB, WS_BDN = 84 * MiB;
constexpr size_t WS_XB = 112 * MiB;
constexpr size_t WS_U = 272 * MiB;
constexpr size_t WS_Q = 512 * MiB, WS_K = 632 * MiB, WS_V = 752 * MiB;
constexpr size_t WS_ACT = 512 * MiB;
constexpr size_t WS_END = 952 * MiB;

constexpr int RING_BYTES = 131072, XCH_OFF = 131072, LDS_BYTES = 147456;

#ifndef PROBE_REPEAT
#define PROBE_REPEAT 0
#endif
#define NREP(bit) ((PROBE_REPEAT >> (bit)) & 1 ? 2 : 1)
struct Params {
  const float* in[24];
  float* out;
  unsigned char* ws;
};

__device__ const double INV_FREQ[32] = {1.0, 0.7498942093324559, 0.5623413251903491, 0.4216965034285822, 0.31622776601683794, 0.23713737056616552, 0.1778279410038923, 0.1333521432163324, 0.1, 0.07498942093324558, 0.05623413251903491, 0.042169650342858224, 0.03162277660168379, 0.023713737056616554, 0.01778279410038923, 0.01333521432163324, 0.01, 0.007498942093324558, 0.005623413251903491, 0.004216965034285823, 0.0031622776601683794, 0.0023713737056616554, 0.0017782794100389228, 0.001333521432163324, 0.001, 0.0007498942093324559, 0.0005623413251903491, 0.00042169650342858224, 0.00031622776601683794, 0.00023713737056616554, 0.00017782794100389227, 0.0001333521432163324};

__device__ __forceinline__ unsigned cvt_pk_bf16(float lo, float hi) { unsigned r; asm volatile("v_cvt_pk_bf16_f32 %0, %1, %2" : "=v"(r) : "v"(lo), "v"(hi)); return r; }
__device__ __forceinline__ float bf2f(bf16_t v) { return __uint_as_float(((unsigned)v) << 16); }
__device__ __forceinline__ float bflo(unsigned w) { return __uint_as_float(w << 16); }
__device__ __forceinline__ float bfhi(unsigned w) { return __uint_as_float(w & 0xffff0000u); }
__device__ __forceinline__ float wave_sum(float v) {
#pragma unroll
  for (int o = 1; o < 64; o <<= 1) v += __shfl_xor(v, o);
  return v;
}
__device__ __forceinline__ float shflx(float v, int lane, int mask) { return __int_as_float(__builtin_amdgcn_ds_bpermute((lane ^ mask) << 2, __float_as_int(v))); }
__device__ __forceinline__ float sigmoidf_(float x) { return __builtin_amdgcn_rcpf(1.0f + __builtin_amdgcn_exp2f(x * -1.4426950408889634f)); }
__device__ __forceinline__ int crow(int r, int hi) { return (r & 3) + 8 * (r >> 2) + 4 * hi; }
__device__ __forceinline__ size_t plane_row(int m, int h) {
  if (m < MP) { const int b = m >> 14, s = m & (SEQP - 1); return ((size_t)(b * NH + h) * SEQP + s); }
  const int mm = m - MP, b = mm >> 11, s = mm & (SEQS - 1); return (size_t)MP * NH + ((size_t)(b * NH + h) * SEQS + s);
}
__device__ __forceinline__ int seq_pos(int m) { return m < MP ? (m & (SEQP - 1)) : ((m - MP) & (SEQS - 1)); }

namespace pg8 {
constexpr int BM = 256, BK = 64, HALF = 128, HTB = HALF * BK * 2, STAGE_BYTES = 8 * HTB, NXCD = 8, WGM = 8;
__host__ __device__ __forceinline__ int lds_byte(int r, int c) { const int st = (r >> 4) * 2 + (c >> 5), rr = r & 15, cc = c & 31, ob = rr * 64 + cc * 2; return st * 1024 + (ob ^ (((ob >> 9) & 1) << 5)); }
__host__ __device__ __forceinline__ void stage_rc(int b, int& R, int& C) { const int st = b / 1024, sb = b % 1024, swz = sb ^ (((sb >> 9) & 1) << 5); R = (st >> 1) * 16 + swz / 64; C = (st & 1) * 32 + (swz % 64) / 2; }
__host__ __device__ __forceinline__ int perm32(int rho) { const int n = rho >> 4, i = rho & 15; return 8 * (i >> 2) + 4 * n + (i & 3); }
struct Unit { int pm, pn; };
struct Gemm { const bf16_t* A; const bf16_t* Bt; int lda, N, K; };
struct StaticOrder {
  int nM, nN, nwg, G, c;
  __device__ void init(int Mr, int N, int G_, int c_) { nM = Mr / BM; nN = N / BM; nwg = nM * nN; G = G_; c = c_; }
  __device__ bool next(int i, Unit& u) const {
    const long L = (long)i * G + c; if (L >= nwg) return false;
    int wgid = (int)L; { const int q = nwg / NXCD, r = nwg % NXCD, xcd = wgid % NXCD, off = wgid / NXCD; wgid = (xcd < r ? xcd * (q + 1) : r * (q + 1) + (xcd - r) * q) + off; }
    const int nig = WGM * nN, gid = wgid / nig, fm = gid * WGM, gsz = (nM - fm) < WGM ? (nM - fm) : WGM;
    u.pm = fm + ((wgid % nig) % gsz); u.pn = (wgid % nig) / gsz; return true;
  }
};
template <class Epi>
__device__ __forceinline__ void gemm_phase(LAS unsigned char* lds, const Gemm g, const StaticOrder& S, const Epi& E) {
  int tid_ = threadIdx.x; asm volatile("" : "+v"(tid_));
  const int tid = tid_, wid = __builtin_amdgcn_readfirstlane(tid >> 6), lane = tid & 63, wr = wid >> 2, wc = wid & 3, fr = lane & 15, fq = lane >> 4;
  const int K = g.K, nt = K / BK, lda = g.lda;
  unsigned voffA[2], voffB[2];
#pragma unroll
  for (int i = 0; i < 2; ++i) { int R, C; stage_rc(tid * 16 + i * 8192, R, C); const int Rb = Epi::PERM ? ((R & ~31) + perm32(R & 31)) : R;
    voffA[i] = (unsigned)(R * lda + C) * 2u; voffB[i] = (unsigned)(Rb * K + C) * 2u; }
  const size_t kstep = (size_t)(BK * 2);
  const size_t hstepA = (size_t)HALF * lda * 2, hstepB = (size_t)HALF * K * 2;
  const size_t tstepA = 2 * hstepA, tstepB = 2 * hstepB;
  const unsigned ldsw = (unsigned)wid * 1024u;
  const int aoff = lds_byte(wr * 64 + fr, fq * 8), boff = lds_byte(wc * 32 + fr, fq * 8);
#define PG8_SA(b, h) (((b) * 2 + (h)) * HTB)
#define PG8_SB(b, h) ((4 + (b) * 2 + (h)) * HTB)
#define PG8_STAGE(bufoff, gbase, voff) do { _Pragma("unroll") for (int _i = 0; _i < 2; ++_i) \
    __builtin_amdgcn_global_load_lds((const unsigned*)((const char*)(gbase) + (voff)[_i]), (LAS unsigned*)(lds + (bufoff) + ldsw + _i * 8192), 16, 0, 0); } while (0)
#define PG8_LDA(dst, b, h) do { _Pragma("unroll") for (int m = 0; m < 4; ++m) _Pragma("unroll") for (int k = 0; k < 2; ++k) dst[m][k] = *(const LAS bf16x8*)(lds + PG8_SA(b, h) + aoff + m * 2048 + k * 1024); } while (0)
#define PG8_LDB(dst, b, h) do { _Pragma("unroll") for (int n = 0; n < 2; ++n) _Pragma("unroll") for (int k = 0; k < 2; ++k) dst[n][k] = *(const LAS bf16x8*)(lds + PG8_SB(b, h) + boff + n * 2048 + k * 1024); } while (0)
#define PG8_MMA(ai, bj, At, Bt) do { __builtin_amdgcn_s_setprio(1); _Pragma("unroll") for (int m = 0; m < 4; ++m) _Pragma("unroll") for (int n = 0; n < 2; ++n) _Pragma("unroll") for (int k = 0; k < 2; ++k) \
    acc[ai][bj][m][n] = __builtin_amdgcn_mfma_f32_16x16x32_bf16(Bt[n][k], At[m][k], acc[ai][bj][m][n], 0, 0, 0); __builtin_amdgcn_s_setprio(0); } while (0)
#define PG8_WAIT_V(n) asm volatile("s_waitcnt vmcnt(" #n ")" ::: "memory")
#define PG8_WAIT_L(n) asm volatile("s_waitcnt lgkmcnt(" #n ")" ::: "memory")
#define PG8_BAR __builtin_amdgcn_s_barrier()
#define PG8_SCHED __builtin_amdgcn_sched_barrier(0)
  Unit cur, nxt; int ui = 0;
  if (!S.next(0, cur)) return;
  f32x4 acc[2][2][4][2];
#pragma unroll
  for (int a = 0; a < 2; ++a)
#pragma unroll
    for (int b = 0; b < 2; ++b)
#pragma unroll
      for (int m = 0; m < 4; ++m)
#pragma unroll
        for (int n = 0; n < 2; ++n) acc[a][b][m][n] = (f32x4){0.f, 0.f, 0.f, 0.f};
  bf16x8 At[4][2], B0[2][2], B1[2][2];
  const char* cA = (const char*)g.A + (size_t)cur.pm * tstepA; const char* cB = (const char*)g.Bt + (size_t)cur.pn * tstepB;
  PG8_STAGE(PG8_SB(0, 0), cB, voffB); PG8_STAGE(PG8_SB(0, 1), cB + hstepB, voffB); PG8_STAGE(PG8_SA(0, 0), cA, voffA); PG8_STAGE(PG8_SA(0, 1), cA + hstepA, voffA);
  if (wr == 1) PG8_BAR;
  PG8_WAIT_V(2); PG8_BAR;
  PG8_STAGE(PG8_SB(1, 0), cB + kstep, voffB); PG8_STAGE(PG8_SA(1, 0), cA + kstep, voffA); PG8_STAGE(PG8_SB(1, 1), cB + hstepB + kstep, voffB);
  PG8_WAIT_V(6); PG8_BAR;
  for (;;) {
    const bool has_next = S.next(ui + 1, nxt);
    const char* nA = has_next ? (const char*)g.A + (size_t)nxt.pm * tstepA : cA; const char* nB = has_next ? (const char*)g.Bt + (size_t)nxt.pn * tstepB : cB;
    for (int t = 0; t < nt; t += 2) {
      const bool last = (t == nt - 2);
      const char* a1 = cA + (size_t)(t + 1) * kstep;
      const char* a2 = last ? nA : cA + (size_t)(t + 2) * kstep; const char* b2 = last ? nB : cB + (size_t)(t + 2) * kstep;
      const char* a3 = a2 + kstep; const char* b3 = b2 + kstep;
      if constexpr (Epi::MIDK) { if (t == (nt >> 1)) E.mid(acc, cur, wr, fr); }
      PG8_LDB(B0, 0, 0); PG8_LDB(B1, 0, 1); PG8_SCHED; PG8_LDA(At, 0, 0); PG8_STAGE(PG8_SA(1, 1), a1 + hstepA, voffA);
      PG8_WAIT_V(8); PG8_WAIT_L(0); PG8_BAR; PG8_MMA(0, 0, At, B0); PG8_MMA(0, 1, At, B1); PG8_BAR; PG8_SCHED;
      PG8_LDA(At, 0, 1); PG8_STAGE(PG8_SB(0, 0), b2, voffB); PG8_STAGE(PG8_SB(0, 1), b2 + hstepB, voffB); PG8_STAGE(PG8_SA(0, 0), a2, voffA);
      PG8_WAIT_V(8); PG8_WAIT_L(0); PG8_BAR; PG8_MMA(1, 0, At, B0); PG8_MMA(1, 1, At, B1); PG8_BAR; PG8_SCHED;
      PG8_LDB(B0, 1, 0); PG8_LDB(B1, 1, 1); PG8_SCHED; PG8_LDA(At, 1, 0); PG8_STAGE(PG8_SA(0, 1), a2 + hstepA, voffA);
      PG8_WAIT_V(8); PG8_WAIT_L(0); PG8_BAR; PG8_MMA(0, 0, At, B0); PG8_MMA(0, 1, At, B1); PG8_BAR; PG8_SCHED;
      PG8_LDA(At, 1, 1); PG8_STAGE(PG8_SB(1, 0), b3, voffB); PG8_STAGE(PG8_SB(1, 1), b3 + hstepB, voffB); PG8_STAGE(PG8_SA(1, 0), a3, voffA);
      PG8_WAIT_V(8); PG8_WAIT_L(0); PG8_BAR; PG8_MMA(1, 0, At, B0); PG8_MMA(1, 1, At, B1); PG8_BAR; PG8_SCHED;
    }
    if (wr == 0) PG8_BAR;
    E(acc, cur, wr, wc, fr, fq);
    if (!has_next) break;
#pragma unroll
    for (int a = 0; a < 2; ++a)
#pragma unroll
      for (int b = 0; b < 2; ++b)
#pragma unroll
        for (int m = 0; m < 4; ++m)
#pragma unroll
          for (int n = 0; n < 2; ++n) acc[a][b][m][n] = (f32x4){0.f, 0.f, 0.f, 0.f};
    cur = nxt; cA = nA; cB = nB; ++ui;
    if (wr == 1) PG8_BAR;
  }
  PG8_WAIT_V(0);
  PG8_BAR;
#undef PG8_SA
#undef PG8_SB
#undef PG8_STAGE
#undef PG8_LDA
#undef PG8_LDB
#undef PG8_MMA
}

struct EpiU {
  static constexpr bool PERM = true, MIDK = false;
  bf16_t* U; const float* rs1; float* ssq_q; float* ssq_kv; float* ssq_pe;
  __device__ __forceinline__ void operator()(const f32x4 (&acc)[2][2][4][2], const Unit& u, int wr, int wc, int fr_, int fq_) const {
    int fr = fr_, fq = fq_; asm volatile("" : "+v"(fr), "+v"(fq));
    float* ssq = (u.pn < 2) ? ssq_q : (u.pn == 2 ? ssq_kv : (u.pn == 11 ? ssq_pe : (float*)nullptr));
    const int col0 = u.pn * BM + wc * 32 + 8 * fq;
#pragma unroll
    for (int ai = 0; ai < 2; ++ai)
#pragma unroll
      for (int m = 0; m < 4; ++m) {
        const int row = u.pm * BM + ai * HALF + wr * 64 + m * 16 + fr; const float s = rs1[row]; float q = 0.f;
        bf16_t* rowp = U + (size_t)row * LDU + col0;
#pragma unroll
        for (int bj = 0; bj < 2; ++bj) { const f32x4 v0 = acc[ai][bj][m][0] * s, v1 = acc[ai][bj][m][1] * s;
          q += (v0[0] * v0[0] + v0[1] * v0[1]) + (v0[2] * v0[2] + v0[3] * v0[3]) + (v1[0] * v1[0] + v1[1] * v1[1]) + (v1[2] * v1[2] + v1[3] * v1[3]);
          u32x4 w; w.x = cvt_pk_bf16(v0[0], v0[1]); w.y = cvt_pk_bf16(v0[2], v0[3]); w.z = cvt_pk_bf16(v1[0], v1[1]); w.w = cvt_pk_bf16(v1[2], v1[3]);
          *(u32x4*)(rowp + bj * HALF) = w; }
        if (ssq) { q += __shfl_xor(q, 16); q += __shfl_xor(q, 32); if (fq == 0) atomicAdd(ssq + row, q); }
      }
  }
};

struct EpiQ {
  static constexpr bool PERM = false, MIDK = false;
  bf16_t* Q; const float* ssq_q; const float* g_qn; const f32x2* rope; LAS float* xch;
  __device__ __forceinline__ void operator()(const f32x4 (&acc)[2][2][4][2], const Unit& u, int wr, int wc, int fr_, int fq_) const {
    int fr = fr_, fq = fq_; asm volatile("" : "+v"(fr), "+v"(fq));
    float rsq[2][4];
#pragma unroll
    for (int ai = 0; ai < 2; ++ai)
#pragma unroll
      for (int m = 0; m < 4; ++m) {
        const int rl = ai * HALF + wr * 64 + m * 16 + fr; const int row = u.pm * BM + rl;
        const float s = __builtin_amdgcn_rsqf(ssq_q[row] * (1.0f / 512.0f) + EPS); rsq[ai][m] = s; float q = 0.f;
#pragma unroll
        for (int bj = 0; bj < 2; ++bj)
#pragma unroll
          for (int n = 0; n < 2; ++n) { const f32x4 v = acc[ai][bj][m][n] * s; q += (v[0] * v[0] + v[1] * v[1]) + (v[2] * v[2] + v[3] * v[3]); }
        q += __shfl_xor(q, 16); q += __shfl_xor(q, 32);
        if (fq == 0) xch[rl * 4 + wc] = q;
      }
    asm volatile("s_waitcnt lgkmcnt(0)" ::: "memory"); __builtin_amdgcn_s_barrier(); asm volatile("" ::: "memory");
    const int h = u.pn;
#pragma unroll
    for (int ai = 0; ai < 2; ++ai)
#pragma unroll
      for (int m = 0; m < 4; ++m) {
        const int rl = ai * HALF + wr * 64 + m * 16 + fr; const int row = u.pm * BM + rl;
        const f32x4 pq = *(const LAS f32x4*)(xch + rl * 4);
        const float tot = (pq[0] + pq[1]) + (pq[2] + pq[3]);
        const float sc = rsq[ai][m] * __builtin_amdgcn_rsqf(tot * (1.0f / 192.0f) + EPS) * 0.10411754627697264f;
        bf16_t* qrow = Q + (plane_row(row, h)) * DK;
        if (wc == 3) {
          const int s = seq_pos(row);
#pragma unroll
          for (int n = 0; n < 2; ++n) { const int i0 = 16 * n + 4 * fq;
            const f32x4 g1 = *(const f32x4*)(g_qn + 128 + i0), g2 = *(const f32x4*)(g_qn + 160 + i0);
            const f32x4 x1 = acc[ai][0][m][n] * sc * g1, x2 = acc[ai][1][m][n] * sc * g2; float o1[4], o2[4];
#pragma unroll
            for (int j = 0; j < 4; ++j) { const f32x2 cs = rope[(size_t)s * 32 + i0 + j]; o1[j] = x1[j] * cs.x - x2[j] * cs.y; o2[j] = x2[j] * cs.x + x1[j] * cs.y; }
            u32x2 w1, w2; w1.x = cvt_pk_bf16(o1[0], o1[1]); w1.y = cvt_pk_bf16(o1[2], o1[3]); w2.x = cvt_pk_bf16(o2[0], o2[1]); w2.y = cvt_pk_bf16(o2[2], o2[3]);
            *(u32x2*)(qrow + 128 + i0) = w1; *(u32x2*)(qrow + 160 + i0) = w2; }
        } else {
#pragma unroll
          for (int n = 0; n < 2; ++n) { const int d = 32 * wc + 16 * n + 4 * fq;
            const f32x4 gg = *(const f32x4*)(g_qn + d); const f32x4 v = acc[ai][0][m][n] * sc * gg;
            u32x2 w; w.x = cvt_pk_bf16(v[0], v[1]); w.y = cvt_pk_bf16(v[2], v[3]); *(u32x2*)(qrow + d) = w; }
          if (wc == 0) {
#pragma unroll
            for (int n = 0; n < 2; ++n) { const int d = 96 + 16 * n + 4 * fq;
              const f32x4 gg = *(const f32x4*)(g_qn + d); const f32x4 v = acc[ai][1][m][n] * sc * gg;
              u32x2 w; w.x = cvt_pk_bf16(v[0], v[1]); w.y = cvt_pk_bf16(v[2], v[3]); *(u32x2*)(qrow + d) = w; }
          }
        }
      }
  }
};

struct EpiKV {
  static constexpr bool PERM = false, MIDK = false;
  bf16_t* Kt; bf16_t* Vt; const bf16_t* U; const float* ssq_kv; const float* ssq_pe; const float* g_kn; const f32x2* rope; LAS float* xch;
  __device__ __forceinline__ void operator()(const f32x4 (&acc)[2][2][4][2], const Unit& u, int wr, int wc, int fr_, int fq_) const {
    int fr = fr_, fq = fq_; asm volatile("" : "+v"(fr), "+v"(fq));
    float rsq[2][4];
#pragma unroll
    for (int ai = 0; ai < 2; ++ai)
#pragma unroll
      for (int m = 0; m < 4; ++m) {
        const int rl = ai * HALF + wr * 64 + m * 16 + fr; const int row = u.pm * BM + rl;
        const float s = __builtin_amdgcn_rsqf(ssq_kv[row] * (1.0f / 256.0f) + EPS); rsq[ai][m] = s; float q = 0.f;
#pragma unroll
        for (int n = 0; n < 2; ++n) { const f32x4 v = acc[ai][0][m][n] * s; q += (v[0] * v[0] + v[1] * v[1]) + (v[2] * v[2] + v[3] * v[3]); }
        q += __shfl_xor(q, 16); q += __shfl_xor(q, 32);
        if (fq == 0) xch[rl * 4 + wc] = q;
      }
    asm volatile("s_waitcnt lgkmcnt(0)" ::: "memory"); __builtin_amdgcn_s_barrier(); asm volatile("" ::: "memory");
    const int h = u.pn;
#pragma unroll
    for (int ai = 0; ai < 2; ++ai)
#pragma unroll
      for (int m = 0; m < 4; ++m) {
        const int rl = ai * HALF + wr * 64 + m * 16 + fr; const int row = u.pm * BM + rl;
        const f32x4 pq = *(const LAS f32x4*)(xch + rl * 4);
        const float tot = (pq[0] + pq[1]) + (pq[2] + pq[3]) + ssq_pe[row];
        const float rstd = __builtin_amdgcn_rsqf(tot * (1.0f / 192.0f) + EPS);
        const float sc = rsq[ai][m] * rstd;
        const size_t pr = plane_row(row, h);
        bf16_t* krow = Kt + pr * DK; bf16_t* vrow = Vt + pr * DV;
#pragma unroll
        for (int n = 0; n < 2; ++n) { const int d = 32 * wc + 16 * n + 4 * fq;
          const f32x4 gg = *(const f32x4*)(g_kn + d); const f32x4 kv = acc[ai][0][m][n] * sc * gg; const f32x4 vv = acc[ai][1][m][n] * rsq[ai][m];
          u32x2 w; w.x = cvt_pk_bf16(kv[0], kv[1]); w.y = cvt_pk_bf16(kv[2], kv[3]); *(u32x2*)(krow + d) = w;
          u32x2 wv; wv.x = cvt_pk_bf16(vv[0], vv[1]); wv.y = cvt_pk_bf16(vv[2], vv[3]); *(u32x2*)(vrow + d) = wv; }
        { const int i0 = 8 * wc + 2 * fq; const int s = seq_pos(row);
          const unsigned p1 = *(const unsigned*)(U + (size_t)row * LDU + UC_PE + i0), p2 = *(const unsigned*)(U + (size_t)row * LDU + UC_PE + 32 + i0);
          const float x1a = bflo(p1) * rstd * g_kn[128 + i0], x1b = bfhi(p1) * rstd * g_kn[128 + i0 + 1];
          const float x2a = bflo(p2) * rstd * g_kn[160 + i0], x2b = bfhi(p2) * rstd * g_kn[160 + i0 + 1];
          const f32x2 ca = rope[(size_t)s * 32 + i0], cb = rope[(size_t)s * 32 + i0 + 1];
          *(unsigned*)(krow + 128 + i0) = cvt_pk_bf16(x1a * ca.x - x2a * ca.y, x1b * cb.x - x2b * cb.y);
          *(unsigned*)(krow + 160 + i0) = cvt_pk_bf16(x2a * ca.x + x1a * ca.y, x2b * cb.x + x1b * cb.y); }
        asm volatile("" ::: "memory");
      }
  }
};

struct EpiOut {
  static constexpr bool PERM = false, MIDK = true;
  const float* xp; const float* xs; float* out; bf16_t* x1b; const float* ssq_a; const float* ssq_l; float* ssq2;
  __device__ __forceinline__ void mid(f32x4 (&acc)[2][2][4][2], const Unit& u, int wr, int fr_) const {
    int fr = fr_; asm volatile("" : "+v"(fr));
#pragma unroll
    for (int ai = 0; ai < 2; ++ai)
#pragma unroll
      for (int m = 0; m < 4; ++m) { const int row = u.pm * BM + ai * HALF + wr * 64 + m * 16 + fr;
        const float sa = __builtin_amdgcn_rsqf(ssq_a[row] * (1.0f / 1024.0f) + EPS), sl = __builtin_amdgcn_rsqf(ssq_l[row] * (1.0f / 1024.0f) + EPS);
        const float ratio = sa / sl;
#pragma unroll
        for (int bj = 0; bj < 2; ++bj)
#pragma unroll
          for (int n = 0; n < 2; ++n) acc[ai][bj][m][n] *= ratio; }
  }
  __device__ __forceinline__ void operator()(const f32x4 (&acc)[2][2][4][2], const Unit& u, int wr, int wc, int fr_, int fq_) const {
    int fr = fr_, fq = fq_; asm volatile("" : "+v"(fr), "+v"(fq));
    const int col0 = u.pn * BM + wc * 32 + 4 * fq;
#pragma unroll
    for (int ai = 0; ai < 2; ++ai)
#pragma unroll
      for (int m = 0; m < 4; ++m) { const int row = u.pm * BM + ai * HALF + wr * 64 + m * 16 + fr;
        const float sl = __builtin_amdgcn_rsqf(ssq_l[row] * (1.0f / 1024.0f) + EPS);
        const float* xrow = (row < MP) ? xp + (size_t)row * DM : xs + (size_t)(row - MP) * DM; float q = 0.f;
#pragma unroll
        for (int bj = 0; bj < 2; ++bj)
#pragma unroll
          for (int n = 0; n < 2; ++n) { const int c = col0 + bj * HALF + n * 16;
            const f32x4 xv = *(const f32x4*)(xrow + c); const f32x4 o = xv + acc[ai][bj][m][n] * sl;
            *(f32x4*)(out + (size_t)row * DM + c) = o; q += (o[0] * o[0] + o[1] * o[1]) + (o[2] * o[2] + o[3] * o[3]);
            u32x2 w; w.x = cvt_pk_bf16(o[0], o[1]); w.y = cvt_pk_bf16(o[2], o[3]); *(u32x2*)(x1b + (size_t)row * DM + c) = w; }
        q += __shfl_xor(q, 16); q += __shfl_xor(q, 32); if (fq == 0) atomicAdd(ssq2 + row, q); }
  }
};

struct EpiGU {
  static constexpr bool PERM = true, MIDK = false;
  bf16_t* act; const float* ssq2;
  __device__ __forceinline__ void operator()(const f32x4 (&acc)[2][2][4][2], const Unit& u, int wr, int wc, int fr_, int fq_) const {
    int fr = fr_, fq = fq_; asm volatile("" : "+v"(fr), "+v"(fq));
    const int col0 = u.pn * HALF + wc * 32 + 8 * fq;
#pragma unroll
    for (int ai = 0; ai < 2; ++ai)
#pragma unroll
      for (int m = 0; m < 4; ++m) { const int row = u.pm * BM + ai * HALF + wr * 64 + m * 16 + fr;
        const float rs = __builtin_amdgcn_rsqf(ssq2[row] * (1.0f / 2048.0f) + EPS);
        float r[8];
#pragma unroll
        for (int n = 0; n < 2; ++n)
#pragma unroll
          for (int j = 0; j < 4; ++j) { const float gv = acc[ai][0][m][n][j] * rs, uv = acc[ai][1][m][n][j] * rs; r[n * 4 + j] = gv * sigmoidf_(gv) * uv; }
        u32x4 w; w.x = cvt_pk_bf16(r[0], r[1]); w.y = cvt_pk_bf16(r[2], r[3]); w.z = cvt_pk_bf16(r[4], r[5]); w.w = cvt_pk_bf16(r[6], r[7]);
        *(u32x4*)(act + (size_t)row * DFF + col0) = w; }
  }
};

struct EpiDown {
  static constexpr bool PERM = false, MIDK = false;
  float* out;
  __device__ __forceinline__ void operator()(const f32x4 (&acc)[2][2][4][2], const Unit& u, int wr, int wc, int fr_, int fq_) const {
    int fr = fr_, fq = fq_; asm volatile("" : "+v"(fr), "+v"(fq));
    const int col0 = u.pn * BM + wc * 32 + 4 * fq;
#pragma unroll
    for (int ai = 0; ai < 2; ++ai)
#pragma unroll
      for (int m = 0; m < 4; ++m) { const int row = u.pm * BM + ai * HALF + wr * 64 + m * 16 + fr;
#pragma unroll
        for (int bj = 0; bj < 2; ++bj)
#pragma unroll
          for (int n = 0; n < 2; ++n) { float* p = out + (size_t)row * DM + col0 + bj * HALF + n * 16; const f32x4 xv = *(const f32x4*)p; *(f32x4*)p = xv + acc[ai][bj][m][n]; } }
  }
};
}

namespace att {
constexpr int NW = 8, QBLK = 32, KVBLK = 64;
constexpr float QSCALE = 0.10411754627697264f;
constexpr int KROWB = 400;
constexpr int SHM_V = KVBLK * DV * 2, SHM_K = KVBLK * KROWB;
constexpr int QRP = 144;
constexpr int SHM_QR = 2 * SHM_V + 2 * SHM_K + NW * 64 * 4;
constexpr int SHM_ATTN = SHM_QR + NW * 32 * QRP;
#define SBAR() __builtin_amdgcn_sched_barrier(0)
#define SGB(mask, n) __builtin_amdgcn_sched_group_barrier(mask, n, 0)
__device__ __forceinline__ void sched_qk_sm() {
  SGB(0x100, 4);
#pragma unroll
  for (int i = 0; i < 10; ++i) { SGB(0x008, 2); SGB(0x100, 2); SGB(0x402, 8); }
#pragma unroll
  for (int i = 0; i < 2; ++i) { SGB(0x008, 2); SGB(0x402, 8); }
}
typedef __bf16 bf16x2_t __attribute__((ext_vector_type(2)));
__device__ __forceinline__ unsigned cvtpk_s(float lo, float hi) { f32x2 v = {lo, hi}; bf16x2_t b = __builtin_convertvector(v, bf16x2_t); return __builtin_bit_cast(unsigned, b); }
__device__ __forceinline__ void expA(f32x16& p0) {
#pragma unroll
  for (int r = 0; r < 16; ++r) p0[r] = __builtin_amdgcn_exp2f(p0[r]);
}
__device__ __forceinline__ void finishSM(f32x16& p0, f32x16& p1, float& l_reg, bf16x8& pa0, bf16x8& pa1, bf16x8& pa2, bf16x8& pa3) {
#pragma unroll
  for (int r = 0; r < 16; ++r) p1[r] = __builtin_amdgcn_exp2f(p1[r]);
  float ps = 0;
#pragma unroll
  for (int r = 0; r < 16; ++r) ps += p0[r];
#pragma unroll
  for (int r = 0; r < 16; ++r) ps += p1[r];
  l_reg += ps;
#define PK4(P, BASE, OUT) do { unsigned a0 = cvtpk_s(P[BASE + 0], P[BASE + 1]), a1 = cvtpk_s(P[BASE + 2], P[BASE + 3]);   \
    unsigned b0 = cvtpk_s(P[BASE + 4], P[BASE + 5]), b1 = cvtpk_s(P[BASE + 6], P[BASE + 7]);                              \
    auto r0 = __builtin_amdgcn_permlane32_swap(a0, b0, false, false); auto r1 = __builtin_amdgcn_permlane32_swap(a1, b1, false, false); \
    u32x4 w = {r0[0], r1[0], r0[1], r1[1]}; OUT = *reinterpret_cast<bf16x8*>(&w); } while (0)
  PK4(p0, 0, pa0); PK4(p0, 8, pa1); PK4(p1, 0, pa2); PK4(p1, 8, pa3);
#undef PK4
}
__device__ __forceinline__ void qkt(f32x16& p0, f32x16& p1, const char* Ks, const bf16x8* qr, const char* qrl, const f32x16& negm, int r32, int hi) {
  p0 = negm; p1 = negm;
#pragma unroll
  for (int d0 = 0; d0 < 12; ++d0) { const int cb = (d0 * 16 + hi * 8) * 2;
    const bf16x8 b0 = *reinterpret_cast<const bf16x8*>(Ks + r32 * KROWB + cb);
    const bf16x8 b1 = *reinterpret_cast<const bf16x8*>(Ks + (32 + r32) * KROWB + cb);
    const bf16x8 qf = qr[d0];
    p0 = __builtin_amdgcn_mfma_f32_32x32x16_bf16(b0, qf, p0, 0, 0, 0);
    p1 = __builtin_amdgcn_mfma_f32_32x32x16_bf16(b1, qf, p1, 0, 0, 0); }
}
__device__ __forceinline__ int v_st(int k, int c) { const int kk = (k & ~0xC) | ((k & 4) << 1) | ((k & 8) >> 1); return ((kk >> 3) * 4 + (c >> 5)) * 512 + ((kk & 7) * 32 + (c & 31)) * 2; }
__device__ __forceinline__ int v_rd_base(int lane) { return ((lane & 3) << 3) | (((lane >> 2) & 3) << 6) | (((lane >> 4) & 1) << 5) | (((lane >> 5) & 1) << 8); }
constexpr int v_rd_off(int d0, int ks, int half) { return d0 * 512 + ks * 4096 + half * 2048; }
template <int OFF> __device__ __forceinline__ s16x4 tr_read(int vb) {
  s16x4 r; asm volatile("ds_read_b64_tr_b16 %0, %1 offset:%2" : "=&v"(r) : "v"(vb), "i"(OFF) : "memory"); return r;
}
template <int D0> __device__ __forceinline__ void pv_one(f32x16& od, int vb, bf16x8 pa0, bf16x8 pa1, bf16x8 pa2, bf16x8 pa3) {
  const s16x4 l0 = tr_read<v_rd_off(D0, 0, 0)>(vb), h0 = tr_read<v_rd_off(D0, 0, 1)>(vb), l1 = tr_read<v_rd_off(D0, 1, 0)>(vb), h1 = tr_read<v_rd_off(D0, 1, 1)>(vb);
  const s16x4 l2 = tr_read<v_rd_off(D0, 2, 0)>(vb), h2 = tr_read<v_rd_off(D0, 2, 1)>(vb), l3 = tr_read<v_rd_off(D0, 3, 0)>(vb), h3 = tr_read<v_rd_off(D0, 3, 1)>(vb);
  asm volatile("s_waitcnt lgkmcnt(0)" ::: "memory"); SBAR();
#define PK(L, H) (bf16x8){L[0], L[1], L[2], L[3], H[0], H[1], H[2], H[3]}
  od = __builtin_amdgcn_mfma_f32_32x32x16_bf16(pa0, PK(l0, h0), od, 0, 0, 0);
  od = __builtin_amdgcn_mfma_f32_32x32x16_bf16(pa1, PK(l1, h1), od, 0, 0, 0);
  od = __builtin_amdgcn_mfma_f32_32x32x16_bf16(pa2, PK(l2, h2), od, 0, 0, 0);
  od = __builtin_amdgcn_mfma_f32_32x32x16_bf16(pa3, PK(l3, h3), od, 0, 0, 0);
#undef PK
}
__device__ __forceinline__ void pv_d0(f32x16* o, int vb, bf16x8 pa0, bf16x8 pa1, bf16x8 pa2, bf16x8 pa3) {
  pv_one<0>(o[0], vb, pa0, pa1, pa2, pa3); pv_one<1>(o[1], vb, pa0, pa1, pa2, pa3); pv_one<2>(o[2], vb, pa0, pa1, pa2, pa3); pv_one<3>(o[3], vb, pa0, pa1, pa2, pa3);
}
__device__ __forceinline__ void attn_unit(const bf16_t* __restrict__ Qb, const bf16_t* __restrict__ Kh, const bf16_t* __restrict__ Vh, bf16_t* __restrict__ Ob, float* __restrict__ ssq, int seq, float kbound, char* lds) {
  int tid_ = threadIdx.x; asm volatile("" : "+v"(tid_));
  const int tid = tid_, wid = tid >> 6, lane = tid & 63, r32 = lane & 31, hi = lane >> 5;
  char* V_lds = lds; char* K_lds = lds + 2 * SHM_V;
  float* ws = (float*)(lds + 2 * SHM_V + 2 * SHM_K) + wid * 64; float* li_l = ws;
  float l_reg = 0; f32x16 o[4] = {}; bf16x8 qr[12];
  const bf16_t* Qw = Qb + (size_t)(wid * QBLK + r32) * DK + hi * 8;
  float qss = 0.f;
#pragma unroll
  for (int d0 = 0; d0 < 8; ++d0) { qr[d0] = *reinterpret_cast<const bf16x8*>(Qw + d0 * 16);
#pragma unroll
    for (int e = 0; e < 8; ++e) { const float v = bf2f((bf16_t)qr[d0][e]); qss += v * v; } }
  const char* qrl = nullptr;
#pragma unroll
  for (int d0 = 8; d0 < 12; ++d0) { const bf16x8 qv = *reinterpret_cast<const bf16x8*>(Qw + d0 * 16); qr[d0] = qv;
#pragma unroll
    for (int e = 0; e < 8; ++e) { const float v = bf2f((bf16_t)qv[e]); qss += v * v; } }
  { auto rr = __builtin_amdgcn_permlane32_swap(__float_as_uint(qss), __float_as_uint(qss), false, false); qss = __uint_as_float(rr[0]) + __uint_as_float(rr[1]); }
  f32x16 negm; { const float nm = -sqrtf(qss) * kbound;
#pragma unroll
    for (int r = 0; r < 16; ++r) negm[r] = nm; }
  asm volatile("" : "+v"(negm));
  const int sr = tid >> 4, sc = (tid & 15) * 8, vst0 = v_st(sr, sc), vst1 = v_st(32 + sr, sc);
  const int kr = tid >> 3, kc = (tid & 7) * 8;
  const int kst = kr * KROWB + kc * 2;
  const int vb0 = (int)(uintptr_t)V_lds + v_rd_base(lane);
  bf16x8 vs0, vs1, ks0, ks1, ks2;
#define SLOAD(k0) do { vs0 = *reinterpret_cast<const bf16x8*>(&Vh[(size_t)((k0) + sr) * DV + sc]); vs1 = *reinterpret_cast<const bf16x8*>(&Vh[(size_t)((k0) + 32 + sr) * DV + sc]); \
    ks0 = *reinterpret_cast<const bf16x8*>(&Kh[(size_t)((k0) + kr) * DK + kc]); ks1 = *reinterpret_cast<const bf16x8*>(&Kh[(size_t)((k0) + kr) * DK + kc + 64]); \
    ks2 = *reinterpret_cast<const bf16x8*>(&Kh[(size_t)((k0) + kr) * DK + kc + 128]); } while (0)
#define SWRITE(b) do { *(bf16x8*)(V_lds + (b) * SHM_V + vst0) = vs0; *(bf16x8*)(V_lds + (b) * SHM_V + vst1) = vs1; \
    *(bf16x8*)(K_lds + (b) * SHM_K + kst) = ks0; *(bf16x8*)(K_lds + (b) * SHM_K + kst + 128) = ks1; *(bf16x8*)(K_lds + (b) * SHM_K + kst + 256) = ks2; } while (0)
#define SWAIT() asm volatile("s_waitcnt vmcnt(0)" ::: "memory")
  f32x16 pA0, pA1, pB0, pB1; bf16x8 pa0, pa1, pa2, pa3; const int NT = seq / KVBLK;
  SLOAD(0); SWAIT(); SWRITE(0); __syncthreads();
  qkt(pA0, pA1, K_lds, qr, qrl, negm, r32, hi); expA(pA0);
  SLOAD(KVBLK);
  SWAIT(); SWRITE(1); __syncthreads();
  for (int j = 1; j + 1 < NT; j += 2) {
    SBAR(); qkt(pB0, pB1, K_lds + SHM_K, qr, qrl, negm, r32, hi);
    finishSM(pA0, pA1, l_reg, pa0, pa1, pa2, pa3); sched_qk_sm(); SBAR();
    SLOAD((j + 1) * KVBLK); SBAR();
    pv_d0(o, vb0, pa0, pa1, pa2, pa3); expA(pB0);
    __syncthreads(); SWAIT(); SWRITE(0);
    __syncthreads();
    SBAR(); qkt(pA0, pA1, K_lds, qr, qrl, negm, r32, hi);
    finishSM(pB0, pB1, l_reg, pa0, pa1, pa2, pa3); sched_qk_sm(); SBAR();
    SLOAD((j + 2) * KVBLK); SBAR();
    pv_d0(o, vb0 + SHM_V, pa0, pa1, pa2, pa3); expA(pA0);
    __syncthreads(); SWAIT(); SWRITE(1);
    __syncthreads();
  }
  SBAR(); qkt(pB0, pB1, K_lds + SHM_K, qr, qrl, negm, r32, hi);
  finishSM(pA0, pA1, l_reg, pa0, pa1, pa2, pa3); SBAR();
  pv_d0(o, vb0, pa0, pa1, pa2, pa3); expA(pB0);
  finishSM(pB0, pB1, l_reg, pa0, pa1, pa2, pa3); SBAR();
  pv_d0(o, vb0 + SHM_V, pa0, pa1, pa2, pa3);
  { auto rr = __builtin_amdgcn_permlane32_swap(__float_as_uint(l_reg), __float_as_uint(l_reg), false, false); l_reg = __uint_as_float(rr[0]) + __uint_as_float(rr[1]); }
  if (hi == 0) li_l[r32] = l_reg; asm volatile("s_waitcnt lgkmcnt(0)" ::: "memory");
  int lane_e = lane; asm volatile("" : "+v"(lane_e));
  const int r32e = lane_e & 31, hie = lane_e >> 5;
  float rli[16];
#pragma unroll
  for (int r = 0; r < 16; ++r) rli[r] = __builtin_amdgcn_rcpf(li_l[crow(r, hie)]);
  __syncthreads();
  bf16_t* stg = (bf16_t*)(lds + wid * 8192);
#pragma unroll
  for (int r = 0; r < 16; ++r) { const int orow = crow(r, hie);
#pragma unroll
    for (int d0 = 0; d0 < 4; ++d0) { const float v = o[d0][r] * rli[r]; stg[orow * 128 + d0 * 32 + r32e] = (bf16_t)(cvt_pk_bf16(v, v) & 0xffffu); } }
  asm volatile("s_waitcnt lgkmcnt(0)" ::: "memory");
#pragma unroll
  for (int i = 0; i < 8; ++i) { const int row = i * 4 + (lane_e >> 4), ch = lane_e & 15;
    const u32x4 v = *(const u32x4*)(stg + row * 128 + ch * 8);
    *(u32x4*)(Ob + (size_t)(wid * QBLK + row) * DM + ch * 8) = v;
    float q = bflo(v.x) * bflo(v.x) + bfhi(v.x) * bfhi(v.x) + bflo(v.y) * bflo(v.y) + bfhi(v.y) * bfhi(v.y) + bflo(v.z) * bflo(v.z) + bfhi(v.z) * bfhi(v.z) + bflo(v.w) * bflo(v.w) + bfhi(v.w) * bfhi(v.w);
    q += shflx(q, lane_e, 1); q += shflx(q, lane_e, 2); q += shflx(q, lane_e, 4); q += shflx(q, lane_e, 8);
    if (ch == 0) atomicAdd(ssq + wid * QBLK + row, q); }
  __syncthreads();
#undef SLOAD
#undef SWRITE
#undef SWAIT
}
#undef SBAR
}

namespace lru {
constexpr int XROW = 136;
constexpr int X_BYTES = 256 * XROW * 2;
constexpr int COMP_OFF = X_BYTES, COMP_BYTES = 4 * 2 * 8 * 32 * 8;
constexpr int CARRY_OFF = COMP_OFF + COMP_BYTES;
constexpr int PRM_OFF = CARRY_OFF + 1024 + 32768;
constexpr int WB_OFF = CARRY_OFF + 1024;
template <bool REV> __device__ __forceinline__ void seg_comp(const float (&a)[16], const float (&bx)[16], float (&A)[4], float (&B)[4]) {
#pragma unroll
  for (int q = 0; q < 4; ++q) { float Aq = 1.f, Bq = 0.f;
#pragma unroll
    for (int ee = 0; ee < 4; ++ee) { const int e = REV ? 3 - ee : ee; const int r = 4 * q + e; Bq = a[r] * Bq + bx[r]; Aq *= a[r]; }
    A[q] = Aq; B[q] = Bq; }
}
template <bool REV> __device__ __forceinline__ float seg_prefix(const float (&loA)[4], const float (&loB)[4], const float (&hiA)[4], const float (&hiB)[4], int hi, float st, float (&start)[4]) {
#pragma unroll
  for (int qq = 0; qq < 4; ++qq) { const int q = REV ? 3 - qq : qq;
    if (!REV) { const float t1 = loA[q] * st + loB[q]; start[q] = hi ? t1 : st; st = hiA[q] * t1 + hiB[q]; }
    else { const float t1 = hiA[q] * st + hiB[q]; start[q] = hi ? st : t1; st = loA[q] * t1 + loB[q]; } }
  return st;
}
template <int PASS>
__device__ __forceinline__ void unit(const Params& p, int chunk, int n, char* lds, float* ssq_l) {
  int tid_ = threadIdx.x; asm volatile("" : "+v"(tid_));
  const int tid = tid_, wid = __builtin_amdgcn_readfirstlane(tid >> 6), lane = tid & 63, j = lane & 31, hi = lane >> 5;
  const int row0 = chunk * 256;
  int seq_start, seq_len;
  if (row0 < MP) { seq_start = row0 & ~(SEQP - 1); seq_len = SEQP; } else { seq_start = MP + ((row0 - MP) & ~(SEQS - 1)); seq_len = SEQS; }
  const int cs = (row0 - seq_start) >> 8, nch = seq_len >> 8, cbase = seq_start >> 8;
  const bf16_t* U = (const bf16_t*)(p.ws + WS_U);
  bf16_t* X = (bf16_t*)lds;
  f32x2* comp = (f32x2*)(lds + COMP_OFF);
  float* carry = (float*)(lds + CARRY_OFF);
  f32x2* agg = (f32x2*)(p.ws + WS_AGG);
  const bf16_t* Wf = (const bf16_t*)(p.ws + WS_BRG) + (size_t)n * 4 * 4 * 8 * 64 * 8;
  char* WB = lds + WB_OFF;
#define WSRC(cg, d, wh) (Wf + ((size_t)(((2 * (d) + (wh)) * 4 + (cg)) * 8) * 64 + tid) * 8)
  bf16x8 sw0 = *(const bf16x8*)WSRC(0, 0, 0), sw1 = *(const bf16x8*)WSRC(0, 0, 1);
  { const int cg8 = (tid & 15) * 8, tg = tid >> 4; const int c0 = n * 128 + cg8;
    const float* cw = p.in[10]; const float* cb = p.in[11];
    float w[4][8], bb[8];
#pragma unroll
    for (int t = 0; t < 4; ++t) { const f32x4 a = *(const f32x4*)(cw + t * 1024 + c0), b = *(const f32x4*)(cw + t * 1024 + c0 + 4);
      w[t][0] = a[0]; w[t][1] = a[1]; w[t][2] = a[2]; w[t][3] = a[3]; w[t][4] = b[0]; w[t][5] = b[1]; w[t][6] = b[2]; w[t][7] = b[3]; }
    { const f32x4 a = *(const f32x4*)(cb + c0), b = *(const f32x4*)(cb + c0 + 4); bb[0] = a[0]; bb[1] = a[1]; bb[2] = a[2]; bb[3] = a[3]; bb[4] = b[0]; bb[5] = b[1]; bb[6] = b[2]; bb[7] = b[3]; }
    u32x4 rw[11];
#pragma unroll
    for (int rr = 0; rr < 11; ++rr) { const int grow = row0 + tg * 8 + rr - 1; const bool ok = (grow >= seq_start) && (grow < seq_start + seq_len);
      rw[rr] = ok ? *(const u32x4*)(U + (size_t)grow * LDU + UC_X + c0) : (u32x4){0u, 0u, 0u, 0u}; }
#pragma unroll
    for (int t = 0; t < 8; ++t) { float y[8];
#pragma unroll
      for (int c = 0; c < 8; ++c) y[c] = bb[c];
#pragma unroll
      for (int tp = 0; tp < 4; ++tp) { const u32x4 v = rw[t + tp];
        y[0] += w[tp][0] * bflo(v.x); y[1] += w[tp][1] * bfhi(v.x); y[2] += w[tp][2] * bflo(v.y); y[3] += w[tp][3] * bfhi(v.y);
        y[4] += w[tp][4] * bflo(v.z); y[5] += w[tp][5] * bfhi(v.z); y[6] += w[tp][6] * bflo(v.w); y[7] += w[tp][7] * bfhi(v.w); }
      u32x4 o; o.x = cvt_pk_bf16(y[0], y[1]); o.y = cvt_pk_bf16(y[2], y[3]); o.z = cvt_pk_bf16(y[4], y[5]); o.w = cvt_pk_bf16(y[6], y[7]);
      *(u32x4*)(X + (tg * 8 + t) * XROW + cg8) = o; }
  }
  if (PASS == 2 && tid < 256) { const int dir = tid >> 7, ch = tid & 127; float st = 0.f;
    const int cnt = dir ? nch - 1 - cs : cs;
    for (int k0 = 0; k0 < cnt; k0 += 16) { f32x2 ab[16];
#pragma unroll
      for (int i = 0; i < 16; ++i) { const int k = k0 + i; const bool ok = k < cnt; const int c = ok ? (dir ? nch - 1 - k : k) : cs;
        ab[i] = agg[(size_t)(dir * NCHUNK + cbase + c) * 1024 + n * 128 + ch]; if (!ok) ab[i] = (f32x2){1.f, 0.f}; }
#pragma unroll
      for (int i = 0; i < 16; ++i) st = ab[i].x * st + ab[i].y; }
    carry[dir * 128 + ch] = st; }
  *(bf16x8*)(WB + tid * 16) = sw0; *(bf16x8*)(WB + 8192 + tid * 16) = sw1;
  if (tid < 256) { const int dir = tid >> 7, ch = tid & 127;
    const float lm = p.in[16][dir * 1024 + n * 128 + ch];
    *(f32x4*)(lds + PRM_OFF + (dir * 128 + ch) * 16) = (f32x4){p.in[13][(dir * 8 + n) * 128 + ch], p.in[15][(dir * 8 + n) * 128 + ch], (8.0f * 1.4426950408889634f) * log1pf(__expf(-lm)), 0.f}; }
  __syncthreads();
  const float* lam = p.in[16];
  const bf16_t* Xw = X + (32 * wid + j) * XROW + 8 * hi;
  for (int cgp = 0; cgp < 4; ++cgp) {
    const int ch = 32 * cgp + j, gch = n * 128 + ch;
    float sum[16];
    bf16_t graw[16];
    if (PASS == 2) { int rb = row0 + 32 * wid + 4 * hi; asm volatile("" : "+v"(rb));
#pragma unroll
      for (int r = 0; r < 16; ++r) graw[r] = U[(size_t)(rb + (r & 3) + 8 * (r >> 2)) * LDU + UC_G + gch];
    }
#pragma unroll
    for (int dir = 0; dir < 2; ++dir) {
      const bool has_next = !(cgp == 3 && dir == 1);
      if (has_next) { const int ncg = dir ? cgp + 1 : cgp; sw0 = *(const bf16x8*)WSRC(ncg, dir ^ 1, 0); sw1 = *(const bf16x8*)WSRC(ncg, dir ^ 1, 1); }
      f32x16 accr = f32x16{}, acci = f32x16{};
#pragma unroll
      for (int ks = 0; ks < 8; ++ks) { const bf16x8 xa = *(const bf16x8*)(Xw + 16 * ks);
        const bf16x8 bfr = *(const bf16x8*)(WB + dir * 16384 + ks * 1024 + lane * 16);
        const bf16x8 bfi = *(const bf16x8*)(WB + dir * 16384 + 8192 + ks * 1024 + lane * 16);
        accr = __builtin_amdgcn_mfma_f32_32x32x16_bf16(xa, bfr, accr, 0, 0, 0);
        acci = __builtin_amdgcn_mfma_f32_32x32x16_bf16(xa, bfi, acci, 0, 0, 0);
        if ((ks & 3) == 3) __builtin_amdgcn_sched_barrier(0); }
      const f32x4 prm = *(const f32x4*)(lds + PRM_OFF + (dir * 128 + ch) * 16);
      const float br = prm[0], bi = prm[1], c8 = prm[2];
      float a[16], bx[16];
#pragma unroll
      for (int r = 0; r < 16; ++r) { const float xv = bf2f(X[(32 * wid + crow(r, hi)) * XROW + ch]);
        const float rg = sigmoidf_(accr[r] + br), ig = sigmoidf_(acci[r] + bi);
        const float av = __builtin_amdgcn_exp2f(-c8 * rg); a[r] = av; bx[r] = __builtin_amdgcn_sqrtf(fmaxf(1.0f - av * av, 0.f)) * ig * xv; }
      float A[4], B[4], loA[4], loB[4], hiA[4], hiB[4], start[4];
      if (dir == 0) seg_comp<false>(a, bx, A, B); else seg_comp<true>(a, bx, A, B);
#pragma unroll
      for (int q = 0; q < 4; ++q) { const float pA = __shfl_xor(A[q], 32), pB = __shfl_xor(B[q], 32);
        loA[q] = hi ? pA : A[q]; loB[q] = hi ? pB : B[q]; hiA[q] = hi ? A[q] : pA; hiB[q] = hi ? B[q] : pB; }
      float Aw = 1.f;
#pragma unroll
      for (int q = 0; q < 4; ++q) Aw *= loA[q] * hiA[q];
      const float Bw = (dir == 0) ? seg_prefix<false>(loA, loB, hiA, hiB, hi, 0.f, start) : seg_prefix<true>(loA, loB, hiA, hiB, hi, 0.f, start);
      if (hi == 0) comp[((cgp * 2 + dir) * 8 + wid) * 32 + j] = (f32x2){Aw, Bw};
      if (has_next) { *(bf16x8*)(WB + (dir ^ 1) * 16384 + tid * 16) = sw0; *(bf16x8*)(WB + (dir ^ 1) * 16384 + 8192 + tid * 16) = sw1; }
      __syncthreads();
      if (PASS == 2) {
        float st = carry[dir * 128 + ch];
        if (dir == 0) { for (int w2 = 0; w2 < wid; ++w2) { const f32x2 ab = comp[((cgp * 2 + 0) * 8 + w2) * 32 + j]; st = ab.x * st + ab.y; } }
        else { for (int w2 = 7; w2 > wid; --w2) { const f32x2 ab = comp[((cgp * 2 + 1) * 8 + w2) * 32 + j]; st = ab.x * st + ab.y; } }
        if (dir == 0) { (void)seg_prefix<false>(loA, loB, hiA, hiB, hi, st, start);
#pragma unroll
          for (int q = 0; q < 4; ++q) { float h = start[q];
#pragma unroll
            for (int e = 0; e < 4; ++e) { const int r = 4 * q + e; h = a[r] * h + bx[r]; sum[r] = h; } } }
        else { (void)seg_prefix<true>(loA, loB, hiA, hiB, hi, st, start);
#pragma unroll
          for (int q = 0; q < 4; ++q) { float h = start[q];
#pragma unroll
            for (int ee = 0; ee < 4; ++ee) { const int r = 4 * q + 3 - ee; h = a[r] * h + bx[r]; sum[r] += h; } } }
      }
    }
    if (PASS == 2) {
      bf16_t* mixed = (bf16_t*)(p.ws + WS_XB);
      int rb2 = row0 + 32 * wid + 4 * hi, lane2 = lane; asm volatile("" : "+v"(rb2), "+v"(lane2));
#pragma unroll
      for (int r = 0; r < 16; ++r) { const int row = rb2 + (r & 3) + 8 * (r >> 2);
        const float g = bf2f(graw[r]);
        const float u3 = 0.7978845608028654f * (g + 0.044715f * g * g * g);
        const float th = 1.0f - 2.0f * __builtin_amdgcn_rcpf(1.0f + __builtin_amdgcn_exp2f((2.0f * 1.4426950408889634f) * u3));
        const float val = sum[r] * (0.5f * g * (1.0f + th));
        const unsigned pk = cvt_pk_bf16(val, val); const bf16_t hv = (bf16_t)(pk & 0xffffu);
        mixed[(size_t)row * DM + 1024 + gch] = hv;
        float q = bf2f(hv); q = q * q;
        q += shflx(q, lane2, 1); q += shflx(q, lane2, 2); q += shflx(q, lane2, 4); q += shflx(q, lane2, 8); q += shflx(q, lane2, 16);
        if ((lane2 & 31) == 0) atomicAdd(ssq_l + row, q); }
    }
  }
  if (PASS == 1) {
    __syncthreads();
    if (tid < 256) { const int dir = tid >> 7, ch = tid & 127, cgp = ch >> 5, jj = ch & 31; float A = 1.f, B = 0.f;
      if (dir == 0) { for (int w2 = 0; w2 < 8; ++w2) { const f32x2 ab = comp[((cgp * 2 + 0) * 8 + w2) * 32 + jj]; B = ab.x * B + ab.y; A *= ab.x; } }
      else { for (int w2 = 7; w2 >= 0; --w2) { const f32x2 ab = comp[((cgp * 2 + 1) * 8 + w2) * 32 + jj]; B = ab.x * B + ab.y; A *= ab.x; } }
      agg[(size_t)(dir * NCHUNK + chunk) * 1024 + n * 128 + ch] = (f32x2){A, B}; }
  }
  __syncthreads();
#undef WSRC
}
}

__device__ __forceinline__ void tr_item(const float* W, int ldw, int K, int srccol0, const float* gk, bf16_t* dst, int k0, LAS float* scr, int lane) {
  { const int n4 = (lane & 7) * 4; f32x4 v[8];
#pragma unroll
    for (int i = 0; i < 8; ++i) { const int kk = 8 * i + (lane >> 3); v[i] = (f32x4){0.f, 0.f, 0.f, 0.f};
      if (srccol0 >= 0) { v[i] = *(const f32x4*)(W + (size_t)(k0 + kk) * ldw + srccol0 + n4); if (gk) v[i] = v[i] * gk[kk]; } }
#pragma unroll
    for (int i = 0; i < 8; ++i) { const int kk = 8 * i + (lane >> 3); LAS float* d = scr + kk * 33 + n4; d[0] = v[i][0]; d[1] = v[i][1]; d[2] = v[i][2]; d[3] = v[i][3]; } }
  asm volatile("s_waitcnt lgkmcnt(0)" ::: "memory");
  const int c = lane & 7;
#pragma unroll
  for (int jq = 0; jq < 4; ++jq) { const int nn = (lane >> 3) + 8 * jq; const LAS float* s = scr + (8 * c) * 33 + nn;
    u32x4 o; o.x = cvt_pk_bf16(s[0 * 33], s[1 * 33]); o.y = cvt_pk_bf16(s[2 * 33], s[3 * 33]); o.z = cvt_pk_bf16(s[4 * 33], s[5 * 33]); o.w = cvt_pk_bf16(s[6 * 33], s[7 * 33]);
    *(u32x4*)(dst + (size_t)nn * K + k0 + 8 * c) = o; }
  asm volatile("s_waitcnt lgkmcnt(0)" ::: "memory");
}

__device__ __forceinline__ void p0_prologue(const Params& p, LAS unsigned char* lds, int vcu, int G) {
  int tid_ = threadIdx.x; asm volatile("" : "+v"(tid_));
  const int tid = tid_, lane = tid & 63, wave = __builtin_amdgcn_readfirstlane(tid >> 6);
  const int gw = vcu * 8 + wave, NGW = G * 8;
  const size_t gt = (size_t)blockIdx.x * 512 + tid, NGT = (size_t)G * 512;
  unsigned char* ws = p.ws;
  { float* z = (float*)(ws + WS_ZERO); for (size_t i = gt; i < ZERO_BYTES / 4; i += NGT) z[i] = 0.f; }
  { f32x2* rt = (f32x2*)(ws + WS_ROPE);
    for (size_t i = gt; i < (size_t)SEQP * 32; i += NGT) { const int s = (int)(i >> 5), f = (int)(i & 31);
      double rev = (double)s * INV_FREQ[f] * 0.15915494309189535; rev -= __builtin_rint(rev); const float r = (float)rev;
      rt[i] = (f32x2){__builtin_amdgcn_cosf(r), __builtin_amdgcn_sinf(r)}; } }
  { bf16_t* wf = (bf16_t*)(ws + WS_BRG);
    for (size_t ci = gt; ci < 65536; ci += NGT) { const int ln = (int)(ci & 63), ks = (int)((ci >> 6) & 7), cgp = (int)((ci >> 9) & 3), dw = (int)((ci >> 11) & 3), n = (int)(ci >> 13);
      const int jj = ln & 31, kg = ln >> 5, dir = dw >> 1, wh = dw & 1;
      const float* src = (wh ? p.in[14] : p.in[12]) + (size_t)(dir * 8 + n) * 128 * 128 + (size_t)(16 * ks + 8 * kg) * 128 + 32 * cgp + jj;
      u32x4 o; o.x = cvt_pk_bf16(src[0], src[128]); o.y = cvt_pk_bf16(src[256], src[384]); o.z = cvt_pk_bf16(src[512], src[640]); o.w = cvt_pk_bf16(src[768], src[896]);
      *(u32x4*)(wf + ci * 8) = o; } }
  { bf16_t* xb = (bf16_t*)(ws + WS_XB); float* rs1 = (float*)(ws + WS_RS1);
    for (int m0 = gw; m0 < M; m0 += 2 * NGW) {
      const int m1 = (m0 + NGW < M) ? m0 + NGW : m0;
      const float* xr0 = (m0 < MP) ? p.in[0] + (size_t)m0 * DM : p.in[1] + (size_t)(m0 - MP) * DM;
      const float* xr1 = (m1 < MP) ? p.in[0] + (size_t)m1 * DM : p.in[1] + (size_t)(m1 - MP) * DM;
      f32x4 v0[8], v1[8]; float s0 = 0.f, s1 = 0.f;
#pragma unroll
      for (int q = 0; q < 8; ++q) { v0[q] = *(const f32x4*)(xr0 + q * 256 + lane * 4); v1[q] = *(const f32x4*)(xr1 + q * 256 + lane * 4); }
#pragma unroll
      for (int q = 0; q < 8; ++q) { s0 += (v0[q][0] * v0[q][0] + v0[q][1] * v0[q][1]) + (v0[q][2] * v0[q][2] + v0[q][3] * v0[q][3]);
        s1 += (v1[q][0] * v1[q][0] + v1[q][1] * v1[q][1]) + (v1[q][2] * v1[q][2] + v1[q][3] * v1[q][3]); }
      s0 = wave_sum(s0); s1 = wave_sum(s1);
      if (lane == 0) { rs1[m0] = 1.0f / sqrtf(s0 * (1.0f / DM) + EPS); rs1[m1] = 1.0f / sqrtf(s1 * (1.0f / DM) + EPS); }
#pragma unroll
      for (int q = 0; q < 8; ++q) { u32x2 w; w.x = cvt_pk_bf16(v0[q][0], v0[q][1]); w.y = cvt_pk_bf16(v0[q][2], v0[q][3]); *(u32x2*)(xb + (size_t)m0 * DM + q * 256 + lane * 4) = w;
        u32x2 w1; w1.x = cvt_pk_bf16(v1[q][0], v1[q][1]); w1.y = cvt_pk_bf16(v1[q][2], v1[q][3]); *(u32x2*)(xb + (size_t)m1 * DM + q * 256 + lane * 4) = w1; } } }
  LAS float* scr = (LAS float*)(lds + wave * 16384);
  constexpr int I_IN = 96 * 32, I_UQ = 64 * 8, I_UKV = 64 * 4, I_OUT = 64 * 32, I_GU = 352 * 32, I_DN = 64 * 88;
  constexpr int NITEMS = I_IN + I_UQ + I_UKV + I_OUT + I_GU + I_DN;
  for (int it = gw; it < NITEMS; it += NGW) {
    int r = it;
    if (r < I_IN) { const int ng = r >> 5, kb = r & 31, dc = ng * 32; int sc;
      if (dc < 768) sc = dc; else if (dc < 1792) sc = dc - 768 + 832; else if (dc < 2816) sc = dc - 1792 + 1856; else if (dc < 2880) sc = dc - 2816 + 768; else sc = -1;
      tr_item(p.in[3], 2880, 2048, sc, p.in[2] + kb * 64, (bf16_t*)(ws + WS_BIN) + (size_t)dc * 2048, kb * 64, scr, lane); continue; } r -= I_IN;
    if (r < I_UQ) { const int ng = r >> 3, kb = r & 7, h = ng >> 3, t0 = (ng & 7) * 32; int d;
      if (t0 < 96) d = t0; else if (t0 == 96) d = 128; else if (t0 == 128) d = 96; else if (t0 == 224) d = 160; else d = -1;
      tr_item(p.in[5], 1536, 512, d < 0 ? -1 : h * 192 + d, p.in[4] + kb * 64, (bf16_t*)(ws + WS_BUQ) + (size_t)(ng * 32) * 512, kb * 64, scr, lane); continue; } r -= I_UQ;
    if (r < I_UKV) { const int ng = r >> 2, kb = r & 3;
      tr_item(p.in[7], 2048, 256, ng * 32, p.in[6] + kb * 64, (bf16_t*)(ws + WS_BUKV) + (size_t)(ng * 32) * 256, kb * 64, scr, lane); continue; } r -= I_UKV;
    if (r < I_OUT) { const int ng = r >> 5, kb = r & 31; const float* gk = (kb < 16) ? p.in[17] + kb * 64 : p.in[18] + (kb - 16) * 64;
      tr_item(p.in[19], 2048, 2048, ng * 32, gk, (bf16_t*)(ws + WS_BOUT) + (size_t)(ng * 32) * 2048, kb * 64, scr, lane); continue; } r -= I_OUT;
    if (r < I_GU) { const int ng = r >> 5, kb = r & 31, R = ng * 32, pn = R >> 8, within = R & 255, bj = within >> 7, c = within & 127;
      tr_item(bj ? p.in[22] : p.in[21], DFF, 2048, pn * 128 + c, p.in[20] + kb * 64, (bf16_t*)(ws + WS_BGU) + (size_t)R * 2048, kb * 64, scr, lane); continue; } r -= I_GU;
    { const int ng = r / 88, kb = r % 88;
      tr_item(p.in[23], 2048, DFF, ng * 32, nullptr, (bf16_t*)(ws + WS_BDN) + (size_t)(ng * 32) * DFF, kb * 64, scr, lane); }
  }
}

__global__ void __launch_bounds__(512, 2) hymba_fwd(Params p) {
  extern __shared__ __attribute__((aligned(16))) unsigned char lds[];
  cg::grid_group grid = cg::this_grid();
  LAS unsigned char* ldsl = (LAS unsigned char*)lds;
  const int G = gridDim.x, bx = blockIdx.x;
  const int vcu = (G % 8 == 0) ? (bx % 8) * (G / 8) + bx / 8 : bx;
  unsigned char* ws = p.ws;
  float* const dummy = (float*)(ws + WS_DUMMY);
#ifndef PROBE_TA
#define PROBE_TA -1
#define PROBE_TB -1
#endif
  unsigned long long t_a = 0, t_b = 0;
#define STAMP(k) do { if (PROBE_TA >= 0) { if ((k) == PROBE_TA) t_a = __builtin_amdgcn_s_memrealtime(); if ((k) == PROBE_TB) t_b = __builtin_amdgcn_s_memrealtime(); } } while (0)
  STAMP(0);

#ifndef NO_P0
  for (int rep = 0; rep < NREP(0); ++rep) p0_prologue(p, ldsl, vcu, G);
#endif
  grid.sync(); STAMP(1);

  for (int rep = 0; rep < NREP(1); ++rep) { pg8::Gemm g{(const bf16_t*)(ws + WS_XB), (const bf16_t*)(ws + WS_BIN), DM, LDU, DM}; pg8::StaticOrder S; S.init(M, LDU, G, bx);
    pg8::EpiU E{(bf16_t*)(ws + WS_U), (const float*)(ws + WS_RS1), rep ? dummy : (float*)(ws + WS_SSQ_Q), rep ? dummy : (float*)(ws + WS_SSQ_KV), rep ? dummy : (float*)(ws + WS_SSQ_PE)};

#ifndef NO_EPIU
    pg8::gemm_phase<pg8::EpiU>(ldsl, g, S, E);
#endif
  }
  grid.sync(); STAMP(2);

  for (int rep = 0; rep < NREP(2); ++rep) {
  { pg8::Gemm g{(const bf16_t*)(ws + WS_U) + UC_Q, (const bf16_t*)(ws + WS_BUQ), LDU, 2048, 512}; pg8::StaticOrder S; S.init(M, 2048, G, bx);
    pg8::EpiQ E{(bf16_t*)(ws + WS_Q), (const float*)(ws + WS_SSQ_Q), p.in[8], (const f32x2*)(ws + WS_ROPE), (LAS float*)(ldsl + XCH_OFF)};

#ifndef NO_EPIQ
    pg8::gemm_phase<pg8::EpiQ>(ldsl, g, S, E);
#endif
  }
  { pg8::Gemm g{(const bf16_t*)(ws + WS_U) + UC_KV, (const bf16_t*)(ws + WS_BUKV), LDU, 2048, 256}; pg8::StaticOrder S; S.init(M, 2048, G, bx);
    pg8::EpiKV E{(bf16_t*)(ws + WS_K), (bf16_t*)(ws + WS_V), (const bf16_t*)(ws + WS_U), (const float*)(ws + WS_SSQ_KV), (const float*)(ws + WS_SSQ_PE), p.in[9], (const f32x2*)(ws + WS_ROPE), (LAS float*)(ldsl + XCH_OFF)};

#ifndef NO_EPIKV
    pg8::gemm_phase<pg8::EpiKV>(ldsl, g, S, E);
#endif
  }
#ifndef NO_LRU1
  for (int u = vcu; u < NCHUNK * 8; u += G) lru::unit<1>(p, u >> 3, u & 7, (char*)lds, nullptr);
#endif
  }
  grid.sync(); STAMP(3);

#ifndef NO_LRU2
  for (int rep = 0; rep < NREP(3); ++rep)
  for (int u = vcu; u < NCHUNK * 8; u += G) lru::unit<2>(p, u >> 3, u & 7, (char*)lds, rep ? dummy : (float*)(ws + WS_SSQ_L));
#endif
  STAMP(4);

#ifndef NO_ATT
  { const bf16_t* Qt = (const bf16_t*)(ws + WS_Q); const bf16_t* Kt = (const bf16_t*)(ws + WS_K); const bf16_t* Vt = (const bf16_t*)(ws + WS_V);
    bf16_t* mixed = (bf16_t*)(ws + WS_XB); float* ssq_a = (float*)(ws + WS_SSQ_A);
    float kbound; { const int ln = threadIdx.x & 63; float gm = fmaxf(fmaxf(fabsf(p.in[9][ln]), fabsf(p.in[9][64 + ln])), fabsf(p.in[9][128 + ln]));
#pragma unroll
      for (int o = 1; o < 64; o <<= 1) gm = fmaxf(gm, __shfl_xor(gm, o));
      kbound = 13.856406460551018f * 1.02f * gm; }
    const int nrp = (1024 + G - 1) / G, nrs = (256 + G - 1) / G;
    for (int rep = 0; rep < NREP(4); ++rep)
    for (int i = 0; i < nrp + nrs; ++i) { int pl, qb, seq, row0; size_t prow;
      if (i < nrp) { if (G == 256) { pl = 2 * (vcu >> 5) + (i >> 1); qb = (vcu & 31) + 32 * (i & 1); } else { const int uu = i * G + vcu; if (uu >= 1024) continue; pl = uu >> 6; qb = uu & 63; }
        prow = (size_t)pl * SEQP; seq = SEQP; row0 = (pl >> 3) * SEQP + qb * 256; }
      else { const int uu = (i - nrp) * G + vcu; if (uu >= 256) continue; pl = uu >> 3; qb = uu & 7; prow = (size_t)MP * NH + (size_t)pl * SEQS; seq = SEQS; row0 = MP + (pl >> 3) * SEQS + qb * 256; }
      const int h = pl & 7;
      att::attn_unit(Qt + (prow + qb * 256) * DK, Kt + prow * DK, Vt + prow * DV, mixed + (size_t)row0 * DM + h * 128, (rep ? dummy : ssq_a) + row0, seq, kbound, (char*)lds); }
  }
#endif
  grid.sync(); STAMP(5);

  for (int rep = 0; rep < NREP(5); ++rep) { pg8::Gemm g{(const bf16_t*)(ws + WS_XB), (const bf16_t*)(ws + WS_BOUT), DM, DM, DM}; pg8::StaticOrder S; S.init(M, DM, G, bx);
    pg8::EpiOut E{p.in[0], p.in[1], p.out, (bf16_t*)(ws + WS_U), (const float*)(ws + WS_SSQ_A), (const float*)(ws + WS_SSQ_L), rep ? dummy : (float*)(ws + WS_SSQ_2)};

#ifndef NO_EPIOUT
    pg8::gemm_phase<pg8::EpiOut>(ldsl, g, S, E);
#endif
  }
  grid.sync(); STAMP(6);

  for (int rep = 0; rep < NREP(6); ++rep) { pg8::Gemm g{(const bf16_t*)(ws + WS_U), (const bf16_t*)(ws + WS_BGU), DM, 2 * DFF, DM}; pg8::StaticOrder S; S.init(M, 2 * DFF, G, bx);
    pg8::EpiGU E{(bf16_t*)(ws + WS_ACT), (const float*)(ws + WS_SSQ_2)};

#ifndef NO_EPIGU
    pg8::gemm_phase<pg8::EpiGU>(ldsl, g, S, E);
#endif
  }
  grid.sync(); STAMP(7);

  { pg8::Gemm g{(const bf16_t*)(ws + WS_ACT), (const bf16_t*)(ws + WS_BDN), DFF, DM, DFF}; pg8::StaticOrder S; S.init(M, DM, G, bx);
    pg8::EpiDown E{p.out};

#ifndef NO_EPIDOWN
    pg8::gemm_phase<pg8::EpiDown>(ldsl, g, S, E);
#endif
  }
  if (PROBE_TA >= 0) { grid.sync(); STAMP(8); if (bx == 0 && threadIdx.x == 0) p.out[(size_t)MP * DM + 12345] += (float)(t_b - t_a) * 1e-5f; }
}

extern "C" void kernel_launch(void* const* d_in, const int* in_sizes, int n_in, void* d_out, int out_size, void* d_ws, size_t ws_size, hipStream_t stream) {
  static int grid = 0;
  if (grid == 0) {
    if (n_in != 24 || out_size != M * DM || ws_size < WS_END) { fprintf(stderr, "kernel_launch: unexpected shapes: n_in %d out %d ws %zu (need %zu)\n", n_in, out_size, ws_size, (size_t)WS_END); grid = -1; return; }
    int dev = 0, cus = 0, per_cu = 0;
    hipGetDevice(&dev); hipDeviceGetAttribute(&cus, hipDeviceAttributeMultiprocessorCount, dev);
    if (hipFuncSetAttribute((const void*)hymba_fwd, hipFuncAttributeMaxDynamicSharedMemorySize, LDS_BYTES) != hipSuccess) { fprintf(stderr, "kernel_launch: hipFuncSetAttribute failed\n"); grid = -1; return; }
    if (hipOccupancyMaxActiveBlocksPerMultiprocessor(&per_cu, (const void*)hymba_fwd, 512, LDS_BYTES) != hipSuccess || per_cu < 1) { fprintf(stderr, "kernel_launch: occupancy query says %d\n", per_cu); per_cu = 1; }
    (void)hipGetLastError();
    grid = cus * 1;
  }
  if (grid < 0) return;
  Params p{};
  for (int i = 0; i < 24; ++i) p.in[i] = (const float*)d_in[i];
  p.out = (float*)d_out; p.ws = (unsigned char*)d_ws;
  void* args[] = {&p};
  hipError_t e = hipLaunchCooperativeKernel((const void*)hymba_fwd, dim3(grid), dim3(512), args, LDS_BYTES, stream);
  if (e != hipSuccess) fprintf(stderr, "cooperative launch failed: %s (grid %d)\n", hipGetErrorString(e), grid);
}
```

```cpp
#include <hip/hip_runtime.h>
#include <hip/hip_cooperative_groups.h>
#include <cstdio>
#include <cstdint>
namespace cg = cooperative_groups;

#define LAS __attribute__((address_space(3)))
typedef unsigned short bf16_t;
typedef short bf16x8 __attribute__((ext_vector_type(8)));
typedef short s16x4 __attribute__((ext_vector_type(4)));
typedef float f32x4 __attribute__((ext_vector_type(4)));
typedef float f32x2 __attribute__((ext_vector_type(2)));
typedef float f32x16 __attribute__((ext_vector_type(16)));
typedef unsigned u32x4 __attribute__((ext_vector_type(4)));
typedef unsigned u32x2 __attribute__((ext_vector_type(2)));

constexpr int M = 40960, MP = 32768, SEQP = 16384, SEQS = 2048, DM = 2048;
constexpr int LDU = 3072, UC_Q = 0, UC_KV = 512, UC_X = 768, UC_G = 1792, UC_PE = 2816;
constexpr int NH = 8, DK = 192, DV = 128, DFF = 5632;
constexpr float EPS = 1e-6f;
constexpr int NCHUNK = M / 256;

constexpr size_t MiB = 1u << 20, KiB = 1024;
constexpr size_t WS_RS1 = 0;
constexpr size_t WS_ZERO = 256 * KiB;
constexpr size_t WS_SSQ_Q = WS_ZERO, WS_SSQ_KV = WS_ZERO + 256 * KiB, WS_SSQ_PE = WS_ZERO + 512 * KiB, WS_SSQ_A = WS_ZERO + 768 * KiB,
                 WS_SSQ_L = WS_ZERO + 1024 * KiB, WS_SSQ_2 = WS_ZERO + 1280 * KiB;
constexpr size_t ZERO_BYTES = 1536 * KiB;
constexpr size_t WS_ROPE = 2 * MiB;
constexpr size_t WS_AGG = 6 * MiB;
constexpr size_t WS_DUMMY = 9 * MiB;
constexpr size_t WS_BIN = 16 * MiB, WS_BUQ = 28 * MiB, WS_BUKV = 30 * MiB, WS_BRG = 31 * MiB, WS_BOUT = 32 * MiB, WS_BGU = 40 * MiB, WS_BDN = 84 * MiB;
constexpr size_t WS_XB = 112 * MiB;
constexpr size_t WS_U = 272 * MiB;
constexpr size_t WS_Q = 512 * MiB, WS_K = 632 * MiB, WS_V = 752 * MiB;
constexpr size_t WS_ACT = 512 * MiB;
constexpr size_t WS_END = 952 * MiB;

constexpr int RING_BYTES = 131072, XCH_OFF = 131072, LDS_BYTES = 147456;

#ifndef PROBE_REPEAT
#define PROBE_REPEAT 0
#endif
#define NREP(bit) ((PROBE_REPEAT >> (bit)) & 1 ? 2 : 1)
struct Params {
  const float* in[24];
  float* out;
  unsigned char* ws;
};

__device__ const double INV_FREQ[32] = {1.0, 0.7498942093324559, 0.5623413251903491, 0.4216965034285822, 0.31622776601683794, 0.23713737056616552, 0.1778279410038923, 0.1333521432163324, 0.1, 0.07498942093324558, 0.05623413251903491, 0.042169650342858224, 0.03162277660168379, 0.023713737056616554, 0.01778279410038923, 0.01333521432163324, 0.01, 0.007498942093324558, 0.005623413251903491, 0.004216965034285823, 0.0031622776601683794, 0.0023713737056616554, 0.0017782794100389228, 0.001333521432163324, 0.001, 0.0007498942093324559, 0.0005623413251903491, 0.00042169650342858224, 0.00031622776601683794, 0.00023713737056616554, 0.00017782794100389227, 0.0001333521432163324};

__device__ __forceinline__ unsigned cvt_pk_bf16(float lo, float hi) { unsigned r; asm volatile("v_cvt_pk_bf16_f32 %0, %1, %2" : "=v"(r) : "v"(lo), "v"(hi)); return r; }
__device__ __forceinline__ float bf2f(bf16_t v) { return __uint_as_float(((unsigned)v) << 16); }
__device__ __forceinline__ float bflo(unsigned w) { return __uint_as_float(w << 16); }
__device__ __forceinline__ float bfhi(unsigned w) { return __uint_as_float(w & 0xffff0000u); }
__device__ __forceinline__ float wave_sum(float v) {
#pragma unroll
  for (int o = 1; o < 64; o <<= 1) v += __shfl_xor(v, o);
  return v;
}
__device__ __forceinline__ float shflx(float v, int lane, int mask) { return __int_as_float(__builtin_amdgcn_ds_bpermute((lane ^ mask) << 2, __float_as_int(v))); }
__device__ __forceinline__ float sigmoidf_(float x) { return __builtin_amdgcn_rcpf(1.0f + __builtin_amdgcn_exp2f(x * -1.4426950408889634f)); }
__device__ __forceinline__ int crow(int r, int hi) { return (r & 3) + 8 * (r >> 2) + 4 * hi; }
__device__ __forceinline__ size_t plane_row(int m, int h) {
  if (m < MP) { const int b = m >> 14, s = m & (SEQP - 1); return ((size_t)(b * NH + h) * SEQP + s); }
  const int mm = m - MP, b = mm >> 11, s = mm & (SEQS - 1); return (size_t)MP * NH + ((size_t)(b * NH + h) * SEQS + s);
}
__device__ __forceinline__ int seq_pos(int m) { return m < MP ? (m & (SEQP - 1)) : ((m - MP) & (SEQS - 1)); }

namespace pg8 {
constexpr int BM = 256, BK = 64, HALF = 128, HTB = HALF * BK * 2, STAGE_BYTES = 8 * HTB, NXCD = 8, WGM = 8;
__host__ __device__ __forceinline__ int lds_byte(int r, int c) { const int st = (r >> 4) * 2 + (c >> 5), rr = r & 15, cc = c & 31, ob = rr * 64 + cc * 2; return st * 1024 + (ob ^ (((ob >> 9) & 1) << 5)); }
__host__ __device__ __forceinline__ void stage_rc(int b, int& R, int& C) { const int st = b / 1024, sb = b % 1024, swz = sb ^ (((sb >> 9) & 1) << 5); R = (st >> 1) * 16 + swz / 64; C = (st & 1) * 32 + (swz % 64) / 2; }
__host__ __device__ __forceinline__ int perm32(int rho) { const int n = rho >> 4, i = rho & 15; return 8 * (i >> 2) + 4 * n + (i & 3); }
struct Unit { int pm, pn; };
struct Gemm { const bf16_t* A; const bf16_t* Bt; int lda, N, K; };
struct StaticOrder {
  int nM, nN, nwg, G, c;
  __device__ void init(int Mr, int N, int G_, int c_) { nM = Mr / BM; nN = N / BM; nwg = nM * nN; G = G_; c = c_; }
  __device__ bool next(int i, Unit& u) const {
    const long L = (long)i * G + c; if (L >= nwg) return false;
    int wgid = (int)L; { const int q = nwg / NXCD, r = nwg % NXCD, xcd = wgid % NXCD, off = wgid / NXCD; wgid = (xcd < r ? xcd * (q + 1) : r * (q + 1) + (xcd - r) * q) + off; }
    const int nig = WGM * nN, gid = wgid / nig, fm = gid * WGM, gsz = (nM - fm) < WGM ? (nM - fm) : WGM;
    u.pm = fm + ((wgid % nig) % gsz); u.pn = (wgid % nig) / gsz; return true;
  }
};
template <class Epi>
__device__ __forceinline__ void gemm_phase(LAS unsigned char* lds, const Gemm g, const StaticOrder& S, const Epi& E) {
  int tid_ = threadIdx.x; asm volatile("" : "+v"(tid_));
  const int tid = tid_, wid = __builtin_amdgcn_readfirstlane(tid >> 6), lane = tid & 63, wr = wid >> 2, wc = wid & 3, fr = lane & 15, fq = lane >> 4;
  const int K = g.K, nt = K / BK, lda = g.lda;
  unsigned voffA[2], voffB[2];
#pragma unroll
  for (int i = 0; i < 2; ++i) { int R, C; stage_rc(tid * 16 + i * 8192, R, C); const int Rb = Epi::PERM ? ((R & ~31) + perm32(R & 31)) : R;
    voffA[i] = (unsigned)(R * lda + C) * 2u; voffB[i] = (unsigned)(Rb * K + C) * 2u; }
  const size_t kstep = (size_t)(BK * 2);
  const size_t hstepA = (size_t)HALF * lda * 2, hstepB = (size_t)HALF * K * 2;
  const size_t tstepA = 2 * hstepA, tstepB = 2 * hstepB;
  const unsigned ldsw = (unsigned)wid * 1024u;
  const int aoff = lds_byte(wr * 64 + fr, fq * 8), boff = lds_byte(wc * 32 + fr, fq * 8);
#define PG8_SA(b, h) (((b) * 2 + (h)) * HTB)
#define PG8_SB(b, h) ((4 + (b) * 2 + (h)) * HTB)
#define PG8_STAGE(bufoff, gbase, voff) do { _Pragma("unroll") for (int _i = 0; _i < 2; ++_i) \
    __builtin_amdgcn_global_load_lds((const unsigned*)((const char*)(gbase) + (voff)[_i]), (LAS unsigned*)(lds + (bufoff) + ldsw + _i * 8192), 16, 0, 0); } while (0)
#define PG8_LDA(dst, b, h) do { _Pragma("unroll") for (int m = 0; m < 4; ++m) _Pragma("unroll") for (int k = 0; k < 2; ++k) dst[m][k] = *(const LAS bf16x8*)(lds + PG8_SA(b, h) + aoff + m * 2048 + k * 1024); } while (0)
#define PG8_LDB(dst, b, h) do { _Pragma("unroll") for (int n = 0; n < 2; ++n) _Pragma("unroll") for (int k = 0; k < 2; ++k) dst[n][k] = *(const LAS bf16x8*)(lds + PG8_SB(b, h) + boff + n * 2048 + k * 1024); } while (0)
#define PG8_MMA(ai, bj, At, Bt) do { __builtin_amdgcn_s_setprio(1); _Pragma("unroll") for (int m = 0; m < 4; ++m) _Pragma("unroll") for (int n = 0; n < 2; ++n) _Pragma("unroll") for (int k = 0; k < 2; ++k) \
    acc[ai][bj][m][n] = __builtin_amdgcn_mfma_f32_16x16x32_bf16(Bt[n][k], At[m][k], acc[ai][bj][m][n], 0, 0, 0); __builtin_amdgcn_s_setprio(0); } while (0)
#define PG8_WAIT_V(n) asm volatile("s_waitcnt vmcnt(" #n ")" ::: "memory")
#define PG8_WAIT_L(n) asm volatile("s_waitcnt lgkmcnt(" #n ")" ::: "memory")
#define PG8_BAR __builtin_amdgcn_s_barrier()
#define PG8_SCHED __builtin_amdgcn_sched_barrier(0)
  Unit cur, nxt; int ui = 0;
  if (!S.next(0, cur)) return;
  f32x4 acc[2][2][4][2];
#pragma unroll
  for (int a = 0; a < 2; ++a)
#pragma unroll
    for (int b = 0; b < 2; ++b)
#pragma unroll
      for (int m = 0; m < 4; ++m)
#pragma unroll
        for (int n = 0; n < 2; ++n) acc[a][b][m][n] = (f32x4){0.f, 0.f, 0.f, 0.f};
  bf16x8 At[4][2], B0[2][2], B1[2][2];
  const char* cA = (const char*)g.A + (size_t)cur.pm * tstepA; const char* cB = (const char*)g.Bt + (size_t)cur.pn * tstepB;
  PG8_STAGE(PG8_SB(0, 0), cB, voffB); PG8_STAGE(PG8_SB(0, 1), cB + hstepB, voffB); PG8_STAGE(PG8_SA(0, 0), cA, voffA); PG8_STAGE(PG8_SA(0, 1), cA + hstepA, voffA);
  if (wr == 1) PG8_BAR;
  PG8_WAIT_V(2); PG8_BAR;
  PG8_STAGE(PG8_SB(1, 0), cB + kstep, voffB); PG8_STAGE(PG8_SA(1, 0), cA + kstep, voffA); PG8_STAGE(PG8_SB(1, 1), cB + hstepB + kstep, voffB);
  PG8_WAIT_V(6); PG8_BAR;
  for (;;) {
    const bool has_next = S.next(ui + 1, nxt);
    const char* nA = has_next ? (const char*)g.A + (size_t)nxt.pm * tstepA : cA; const char* nB = has_next ? (const char*)g.Bt + (size_t)nxt.pn * tstepB : cB;
    for (int t = 0; t < nt; t += 2) {
      const bool last = (t == nt - 2);
      const char* a1 = cA + (size_t)(t + 1) * kstep;
      const char* a2 = last ? nA : cA + (size_t)(t + 2) * kstep; const char* b2 = last ? nB : cB + (size_t)(t + 2) * kstep;
      const char* a3 = a2 + kstep; const char* b3 = b2 + kstep;
      if constexpr (Epi::MIDK) { if (t == (nt >> 1)) E.mid(acc, cur, wr, fr); }
      PG8_LDB(B0, 0, 0); PG8_LDB(B1, 0, 1); PG8_SCHED; PG8_LDA(At, 0, 0); PG8_STAGE(PG8_SA(1, 1), a1 + hstepA, voffA);
      PG8_WAIT_V(8); PG8_WAIT_L(0); PG8_BAR; PG8_MMA(0, 0, At, B0); PG8_MMA(0, 1, At, B1); PG8_BAR; PG8_SCHED;
      PG8_LDA(At, 0, 1); PG8_STAGE(PG8_SB(0, 0), b2, voffB); PG8_STAGE(PG8_SB(0, 1), b2 + hstepB, voffB); PG8_STAGE(PG8_SA(0, 0), a2, voffA);
      PG8_WAIT_V(8); PG8_WAIT_L(0); PG8_BAR; PG8_MMA(1, 0, At, B0); PG8_MMA(1, 1, At, B1); PG8_BAR; PG8_SCHED;
      PG8_LDB(B0, 1, 0); PG8_LDB(B1, 1, 1); PG8_SCHED; PG8_LDA(At, 1, 0); PG8_STAGE(PG8_SA(0, 1), a2 + hstepA, voffA);
      PG8_WAIT_V(8); PG8_WAIT_L(0); PG8_BAR; PG8_MMA(0, 0, At, B0); PG8_MMA(0, 1, At, B1); PG8_BAR; PG8_SCHED;
      PG8_LDA(At, 1, 1); PG8_STAGE(PG8_SB(1, 0), b3, voffB); PG8_STAGE(PG8_SB(1, 1), b3 + hstepB, voffB); PG8_STAGE(PG8_SA(1, 0), a3, voffA);
      PG8_WAIT_V(8); PG8_WAIT_L(0); PG8_BAR; PG8_MMA(1, 0, At, B0); PG8_MMA(1, 1, At, B1); PG8_BAR; PG8_SCHED;
    }
    if (wr == 0) PG8_BAR;
    E(acc, cur, wr, wc, fr, fq);
    if (!has_next) break;
#pragma unroll
    for (int a = 0; a < 2; ++a)
#pragma unroll
      for (int b = 0; b < 2; ++b)
#pragma unroll
        for (int m = 0; m < 4; ++m)
#pragma unroll
          for (int n = 0; n < 2; ++n) acc[a][b][m][n] = (f32x4){0.f, 0.f, 0.f, 0.f};
    cur = nxt; cA = nA; cB = nB; ++ui;
    if (wr == 1) PG8_BAR;
  }
  PG8_WAIT_V(0);
  PG8_BAR;
#undef PG8_SA
#undef PG8_SB
#undef PG8_STAGE
#undef PG8_LDA
#undef PG8_LDB
#undef PG8_MMA
}

struct EpiU {
  static constexpr bool PERM = true, MIDK = false;
  bf16_t* U; const float* rs1; float* ssq_q; float* ssq_kv; float* ssq_pe;
  __device__ __forceinline__ void operator()(const f32x4 (&acc)[2][2][4][2], const Unit& u, int wr, int wc, int fr_, int fq_) const {
    int fr = fr_, fq = fq_; asm volatile("" : "+v"(fr), "+v"(fq));
    float* ssq = (u.pn < 2) ? ssq_q : (u.pn == 2 ? ssq_kv : (u.pn == 11 ? ssq_pe : (float*)nullptr));
    const int col0 = u.pn * BM + wc * 32 + 8 * fq;
#pragma unroll
    for (int ai = 0; ai < 2; ++ai)
#pragma unroll
      for (int m = 0; m < 4; ++m) {
        const int row = u.pm * BM + ai * HALF + wr * 64 + m * 16 + fr; const float s = rs1[row]; float q = 0.f;
        bf16_t* rowp = U + (size_t)row * LDU + col0;
#pragma unroll
        for (int bj = 0; bj < 2; ++bj) { const f32x4 v0 = acc[ai][bj][m][0] * s, v1 = acc[ai][bj][m][1] * s;
          q += (v0[0] * v0[0] + v0[1] * v0[1]) + (v0[2] * v0[2] + v0[3] * v0[3]) + (v1[0] * v1[0] + v1[1] * v1[1]) + (v1[2] * v1[2] + v1[3] * v1[3]);
          u32x4 w; w.x = cvt_pk_bf16(v0[0], v0[1]); w.y = cvt_pk_bf16(v0[2], v0[3]); w.z = cvt_pk_bf16(v1[0], v1[1]); w.w = cvt_pk_bf16(v1[2], v1[3]);
          *(u32x4*)(rowp + bj * HALF) = w; }
        if (ssq) { q += __shfl_xor(q, 16); q += __shfl_xor(q, 32); if (fq == 0) atomicAdd(ssq + row, q); }
      }
  }
};

struct EpiQ {
  static constexpr bool PERM = false, MIDK = false;
  bf16_t* Q; const float* ssq_q; const float* g_qn; const f32x2* rope; LAS float* xch;
  __device__ __forceinline__ void operator()(const f32x4 (&acc)[2][2][4][2], const Unit& u, int wr, int wc, int fr_, int fq_) const {
    int fr = fr_, fq = fq_; asm volatile("" : "+v"(fr), "+v"(fq));
    float rsq[2][4];
#pragma unroll
    for (int ai = 0; ai < 2; ++ai)
#pragma unroll
      for (int m = 0; m < 4; ++m) {
        const int rl = ai * HALF + wr * 64 + m * 16 + fr; const int row = u.pm * BM + rl;
        const float s = __builtin_amdgcn_rsqf(ssq_q[row] * (1.0f / 512.0f) + EPS); rsq[ai][m] = s; float q = 0.f;
#pragma unroll
        for (int bj = 0; bj < 2; ++bj)
#pragma unroll
          for (int n = 0; n < 2; ++n) { const f32x4 v = acc[ai][bj][m][n] * s; q += (v[0] * v[0] + v[1] * v[1]) + (v[2] * v[2] + v[3] * v[3]); }
        q += __shfl_xor(q, 16); q += __shfl_xor(q, 32);
        if (fq == 0) xch[rl * 4 + wc] = q;
      }
    asm volatile("s_waitcnt lgkmcnt(0)" ::: "memory"); __builtin_amdgcn_s_barrier(); asm volatile("" ::: "memory");
    const int h = u.pn;
#pragma unroll
    for (int ai = 0; ai < 2; ++ai)
#pragma unroll
      for (int m = 0; m < 4; ++m) {
        const int rl = ai * HALF + wr * 64 + m * 16 + fr; const int row = u.pm * BM + rl;
        const f32x4 pq = *(const LAS f32x4*)(xch + rl * 4);
        const float tot = (pq[0] + pq[1]) + (pq[2] + pq[3]);
        const float sc = rsq[ai][m] * __builtin_amdgcn_rsqf(tot * (1.0f / 192.0f) + EPS) * 0.10411754627697264f;
        bf16_t* qrow = Q + (plane_row(row, h)) * DK;
        if (wc == 3) {
          const int s = seq_pos(row);
#pragma unroll
          for (int n = 0; n < 2; ++n) { const int i0 = 16 * n + 4 * fq;
            const f32x4 g1 = *(const f32x4*)(g_qn + 128 + i0), g2 = *(const f32x4*)(g_qn + 160 + i0);
            const f32x4 x1 = acc[ai][0][m][n] * sc * g1, x2 = acc[ai][1][m][n] * sc * g2; float o1[4], o2[4];
#pragma unroll
            for (int j = 0; j < 4; ++j) { const f32x2 cs = rope[(size_t)s * 32 + i0 + j]; o1[j] = x1[j] * cs.x - x2[j] * cs.y; o2[j] = x2[j] * cs.x + x1[j] * cs.y; }
            u32x2 w1, w2; w1.x = cvt_pk_bf16(o1[0], o1[1]); w1.y = cvt_pk_bf16(o1[2], o1[3]); w2.x = cvt_pk_bf16(o2[0], o2[1]); w2.y = cvt_pk_bf16(o2[2], o2[3]);
            *(u32x2*)(qrow + 128 + i0) = w1; *(u32x2*)(qrow + 160 + i0) = w2; }
        } else {
#pragma unroll
          for (int n = 0; n < 2; ++n) { const int d = 32 * wc + 16 * n + 4 * fq;
            const f32x4 gg = *(const f32x4*)(g_qn + d); const f32x4 v = acc[ai][0][m][n] * sc * gg;
            u32x2 w; w.x = cvt_pk_bf16(v[0], v[1]); w.y = cvt_pk_bf16(v[2], v[3]); *(u32x2*)(qrow + d) = w; }
          if (wc == 0) {
#pragma unroll
            for (int n = 0; n < 2; ++n) { const int d = 96 + 16 * n + 4 * fq;
              const f32x4 gg = *(const f32x4*)(g_qn + d); const f32x4 v = acc[ai][1][m][n] * sc * gg;
              u32x2 w; w.x = cvt_pk_bf16(v[0], v[1]); w.y = cvt_pk_bf16(v[2], v[3]); *(u32x2*)(qrow + d) = w; }
          }
        }
      }
  }
};

struct EpiKV {
  static constexpr bool PERM = false, MIDK = false;
  bf16_t* Kt; bf16_t* Vt; const bf16_t* U; const float* ssq_kv; const float* ssq_pe; const float* g_kn; const f32x2* rope; LAS float* xch;
  __device__ __forceinline__ void operator()(const f32x4 (&acc)[2][2][4][2], const Unit& u, int wr, int wc, int fr_, int fq_) const {
    int fr = fr_, fq = fq_; asm volatile("" : "+v"(fr), "+v"(fq));
    float rsq[2][4];
#pragma unroll
    for (int ai = 0; ai < 2; ++ai)
#pragma unroll
      for (int m = 0; m < 4; ++m) {
        const int rl = ai * HALF + wr * 64 + m * 16 + fr; const int row = u.pm * BM + rl;
        const float s = __builtin_amdgcn_rsqf(ssq_kv[row] * (1.0f / 256.0f) + EPS); rsq[ai][m] = s; float q = 0.f;
#pragma unroll
        for (int n = 0; n < 2; ++n) { const f32x4 v = acc[ai][0][m][n] * s; q += (v[0] * v[0] + v[1] * v[1]) + (v[2] * v[2] + v[3] * v[3]); }
        q += __shfl_xor(q, 16); q += __shfl_xor(q, 32);
        if (fq == 0) xch[rl * 4 + wc] = q;
      }
    asm volatile("s_waitcnt lgkmcnt(0)" ::: "memory"); __builtin_amdgcn_s_barrier(); asm volatile("" ::: "memory");
    const int h = u.pn;
#pragma unroll
    for (int ai = 0; ai < 2; ++ai)
#pragma unroll
      for (int m = 0; m < 4; ++m) {
        const int rl = ai * HALF + wr * 64 + m * 16 + fr; const int row = u.pm * BM + rl;
        const f32x4 pq = *(const LAS f32x4*)(xch + rl * 4);
        const float tot = (pq[0] + pq[1]) + (pq[2] + pq[3]) + ssq_pe[row];
        const float rstd = __builtin_amdgcn_rsqf(tot * (1.0f / 192.0f) + EPS);
        const float sc = rsq[ai][m] * rstd;
        const size_t pr = plane_row(row, h);
        bf16_t* krow = Kt + pr * DK; bf16_t* vrow = Vt + pr * DV;
#pragma unroll
        for (int n = 0; n < 2; ++n) { const int d = 32 * wc + 16 * n + 4 * fq;
          const f32x4 gg = *(const f32x4*)(g_kn + d); const f32x4 kv = acc[ai][0][m][n] * sc * gg; const f32x4 vv = acc[ai][1][m][n] * rsq[ai][m];
          u32x2 w; w.x = cvt_pk_bf16(kv[0], kv[1]); w.y = cvt_pk_bf16(kv[2], kv[3]); *(u32x2*)(krow + d) = w;
          u32x2 wv; wv.x = cvt_pk_bf16(vv[0], vv[1]); wv.y = cvt_pk_bf16(vv[2], vv[3]); *(u32x2*)(vrow + d) = wv; }
        { const int i0 = 8 * wc + 2 * fq; const int s = seq_pos(row);
          const unsigned p1 = *(const unsigned*)(U + (size_t)row * LDU + UC_PE + i0), p2 = *(const unsigned*)(U + (size_t)row * LDU + UC_PE + 32 + i0);
          const float x1a = bflo(p1) * rstd * g_kn[128 + i0], x1b = bfhi(p1) * rstd * g_kn[128 + i0 + 1];
          const float x2a = bflo(p2) * rstd * g_kn[160 + i0], x2b = bfhi(p2) * rstd * g_kn[160 + i0 + 1];
          const f32x2 ca = rope[(size_t)s * 32 + i0], cb = rope[(size_t)s * 32 + i0 + 1];
          *(unsigned*)(krow + 128 + i0) = cvt_pk_bf16(x1a * ca.x - x2a * ca.y, x1b * cb.x - x2b * cb.y);
          *(unsigned*)(krow + 160 + i0) = cvt_pk_bf16(x2a * ca.x + x1a * ca.y, x2b * cb.x + x1b * cb.y); }
        asm volatile("" ::: "memory");
      }
  }
};

struct EpiOut {
  static constexpr bool PERM = false, MIDK = true;
  const float* xp; const float* xs; float* out; bf16_t* x1b; const float* ssq_a; const float* ssq_l; float* ssq2;
  __device__ __forceinline__ void mid(f32x4 (&acc)[2][2][4][2], const Unit& u, int wr, int fr_) const {
    int fr = fr_; asm volatile("" : "+v"(fr));
#pragma unroll
    for (int ai = 0; ai < 2; ++ai)
#pragma unroll
      for (int m = 0; m < 4; ++m) { const int row = u.pm * BM + ai * HALF + wr * 64 + m * 16 + fr;
        const float sa = __builtin_amdgcn_rsqf(ssq_a[row] * (1.0f / 1024.0f) + EPS), sl = __builtin_amdgcn_rsqf(ssq_l[row] * (1.0f / 1024.0f) + EPS);
        const float ratio = sa / sl;
#pragma unroll
        for (int bj = 0; bj < 2; ++bj)
#pragma unroll
          for (int n = 0; n < 2; ++n) acc[ai][bj][m][n] *= ratio; }
  }
  __device__ __forceinline__ void operator()(const f32x4 (&acc)[2][2][4][2], const Unit& u, int wr, int wc, int fr_, int fq_) const {
    int fr = fr_, fq = fq_; asm volatile("" : "+v"(fr), "+v"(fq));
    const int col0 = u.pn * BM + wc * 32 + 4 * fq;
#pragma unroll
    for (int ai = 0; ai < 2; ++ai)
#pragma unroll
      for (int m = 0; m < 4; ++m) { const int row = u.pm * BM + ai * HALF + wr * 64 + m * 16 + fr;
        const float sl = __builtin_amdgcn_rsqf(ssq_l[row] * (1.0f / 1024.0f) + EPS);
        const float* xrow = (row < MP) ? xp + (size_t)row * DM : xs + (size_t)(row - MP) * DM; float q = 0.f;
#pragma unroll
        for (int bj = 0; bj < 2; ++bj)
#pragma unroll
          for (int n = 0; n < 2; ++n) { const int c = col0 + bj * HALF + n * 16;
            const f32x4 xv = *(const f32x4*)(xrow + c); const f32x4 o = xv + acc[ai][bj][m][n] * sl;
            *(f32x4*)(out + (size_t)row * DM + c) = o; q += (o[0] * o[0] + o[1] * o[1]) + (o[2] * o[2] + o[3] * o[3]);
            u32x2 w; w.x = cvt_pk_bf16(o[0], o[1]); w.y = cvt_pk_bf16(o[2], o[3]); *(u32x2*)(x1b + (size_t)row * DM + c) = w; }
        q += __shfl_xor(q, 16); q += __shfl_xor(q, 32); if (fq == 0) atomicAdd(ssq2 + row, q); }
  }
};

struct EpiGU {
  static constexpr bool PERM = true, MIDK = false;
  bf16_t* act; const float* ssq2;
  __device__ __forceinline__ void operator()(const f32x4 (&acc)[2][2][4][2], const Unit& u, int wr, int wc, int fr_, int fq_) const {
    int fr = fr_, fq = fq_; asm volatile("" : "+v"(fr), "+v"(fq));
    const int col0 = u.pn * HALF + wc * 32 + 8 * fq;
#pragma unroll
    for (int ai = 0; ai < 2; ++ai)
#pragma unroll
      for (int m = 0; m < 4; ++m) { const int row = u.pm * BM + ai * HALF + wr * 64 + m * 16 + fr;
        const float rs = __builtin_amdgcn_rsqf(ssq2[row] * (1.0f / 2048.0f) + EPS);
        float r[8];
#pragma unroll
        for (int n = 0; n < 2; ++n)
#pragma unroll
          for (int j = 0; j < 4; ++j) { const float gv = acc[ai][0][m][n][j] * rs, uv = acc[ai][1][m][n][j] * rs; r[n * 4 + j] = gv * sigmoidf_(gv) * uv; }
        u32x4 w; w.x = cvt_pk_bf16(r[0], r[1]); w.y = cvt_pk_bf16(r[2], r[3]); w.z = cvt_pk_bf16(r[4], r[5]); w.w = cvt_pk_bf16(r[6], r[7]);
        *(u32x4*)(act + (size_t)row * DFF + col0) = w; }
  }
};

struct EpiDown {
  static constexpr bool PERM = false, MIDK = false;
  float* out;
  __device__ __forceinline__ void operator()(const f32x4 (&acc)[2][2][4][2], const Unit& u, int wr, int wc, int fr_, int fq_) const {
    int fr = fr_, fq = fq_; asm volatile("" : "+v"(fr), "+v"(fq));
    const int col0 = u.pn * BM + wc * 32 + 4 * fq;
#pragma unroll
    for (int ai = 0; ai < 2; ++ai)
#pragma unroll
      for (int m = 0; m < 4; ++m) { const int row = u.pm * BM + ai * HALF + wr * 64 + m * 16 + fr;
#pragma unroll
        for (int bj = 0; bj < 2; ++bj)
#pragma unroll
          for (int n = 0; n < 2; ++n) { float* p = out + (size_t)row * DM + col0 + bj * HALF + n * 16; const f32x4 xv = *(const f32x4*)p; *(f32x4*)p = xv + acc[ai][bj][m][n]; } }
  }
};
}

namespace att {
constexpr int NW = 8, QBLK = 32, KVBLK = 64;
constexpr float QSCALE = 0.10411754627697264f;
constexpr int KROWB = 400;
constexpr int SHM_V = KVBLK * DV * 2, SHM_K = KVBLK * KROWB;
constexpr int QRP = 144;
constexpr int SHM_WS = 3 * SHM_V + 2 * SHM_K, SHM_QR = SHM_WS + NW * 64 * 4, SHM_ATTN = SHM_QR + NW * 32 * QRP;
static_assert(SHM_ATTN <= LDS_BYTES, "attention LDS");
#define SBAR() __builtin_amdgcn_sched_barrier(0)
#define SGB(mask, n) __builtin_amdgcn_sched_group_barrier(mask, n, 0)
__device__ __forceinline__ void sched_qk_sm() {
  SGB(0x100, 4);
#pragma unroll
  for (int i = 0; i < 10; ++i) { SGB(0x008, 2); SGB(0x100, 2); SGB(0x402, 8); }
#pragma unroll
  for (int i = 0; i < 2; ++i) { SGB(0x008, 2); SGB(0x402, 8); }
}
typedef __bf16 bf16x2_t __attribute__((ext_vector_type(2)));
__device__ __forceinline__ unsigned cvtpk_s(float lo, float hi) { f32x2 v = {lo, hi}; bf16x2_t b = __builtin_convertvector(v, bf16x2_t); return __builtin_bit_cast(unsigned, b); }
__device__ __forceinline__ void expA(f32x16& p0) {
#pragma unroll
  for (int r = 0; r < 16; ++r) p0[r] = __builtin_amdgcn_exp2f(p0[r]);
}
__device__ __forceinline__ void finishSM(f32x16& p0, f32x16& p1, float& l_reg, bf16x8& pa0, bf16x8& pa1, bf16x8& pa2, bf16x8& pa3) {
#pragma unroll
  for (int r = 0; r < 16; ++r) p1[r] = __builtin_amdgcn_exp2f(p1[r]);
  float ps = 0;
#pragma unroll
  for (int r = 0; r < 16; ++r) ps += p0[r];
#pragma unroll
  for (int r = 0; r < 16; ++r) ps += p1[r];
  l_reg += ps;
#define PK4(P, BASE, OUT) do { unsigned a0 = cvtpk_s(P[BASE + 0], P[BASE + 1]), a1 = cvtpk_s(P[BASE + 2], P[BASE + 3]);   \
    unsigned b0 = cvtpk_s(P[BASE + 4], P[BASE + 5]), b1 = cvtpk_s(P[BASE + 6], P[BASE + 7]);                              \
    auto r0 = __builtin_amdgcn_permlane32_swap(a0, b0, false, false); auto r1 = __builtin_amdgcn_permlane32_swap(a1, b1, false, false); \
    u32x4 w = {r0[0], r1[0], r0[1], r1[1]}; OUT = *reinterpret_cast<bf16x8*>(&w); } while (0)
  PK4(p0, 0, pa0); PK4(p0, 8, pa1); PK4(p1, 0, pa2); PK4(p1, 8, pa3);
#undef PK4
}
__device__ __forceinline__ void qkt(f32x16& p0, f32x16& p1, const char* Ks, const bf16x8* qr, const char* qrl, const f32x16& negm, int r32, int hi) {
  p0 = negm; p1 = negm;
#pragma unroll
  for (int d0 = 0; d0 < 12; ++d0) { const int cb = (d0 * 16 + hi * 8) * 2;
    const bf16x8 b0 = *reinterpret_cast<const bf16x8*>(Ks + r32 * KROWB + cb);
    const bf16x8 b1 = *reinterpret_cast<const bf16x8*>(Ks + (32 + r32) * KROWB + cb);
    const bf16x8 qf = qr[d0];
    p0 = __builtin_amdgcn_mfma_f32_32x32x16_bf16(b0, qf, p0, 0, 0, 0);
    p1 = __builtin_amdgcn_mfma_f32_32x32x16_bf16(b1, qf, p1, 0, 0, 0); }
}
__device__ __forceinline__ int v_st(int k, int c) { const int kk = (k & ~0xC) | ((k & 4) << 1) | ((k & 8) >> 1); return ((kk >> 3) * 4 + (c >> 5)) * 512 + ((kk & 7) * 32 + (c & 31)) * 2; }
__device__ __forceinline__ int v_rd_base(int lane) { return ((lane & 3) << 3) | (((lane >> 2) & 3) << 6) | (((lane >> 4) & 1) << 5) | (((lane >> 5) & 1) << 8); }
constexpr int v_rd_off(int d0, int ks, int half) { return d0 * 512 + ks * 4096 + half * 2048; }
template <int OFF> __device__ __forceinline__ s16x4 tr_read(int vb) {
  s16x4 r; asm volatile("ds_read_b64_tr_b16 %0, %1 offset:%2" : "=&v"(r) : "v"(vb), "i"(OFF) : "memory"); return r;
}
template <int D0> __device__ __forceinline__ void pv_one(f32x16& od, int vb, bf16x8 pa0, bf16x8 pa1, bf16x8 pa2, bf16x8 pa3) {
  const s16x4 l0 = tr_read<v_rd_off(D0, 0, 0)>(vb), h0 = tr_read<v_rd_off(D0, 0, 1)>(vb), l1 = tr_read<v_rd_off(D0, 1, 0)>(vb), h1 = tr_read<v_rd_off(D0, 1, 1)>(vb);
  const s16x4 l2 = tr_read<v_rd_off(D0, 2, 0)>(vb), h2 = tr_read<v_rd_off(D0, 2, 1)>(vb), l3 = tr_read<v_rd_off(D0, 3, 0)>(vb), h3 = tr_read<v_rd_off(D0, 3, 1)>(vb);
  asm volatile("s_waitcnt lgkmcnt(0)" ::: "memory"); SBAR();
#define PK(L, H) (bf16x8){L[0], L[1], L[2], L[3], H[0], H[1], H[2], H[3]}
  od = __builtin_amdgcn_mfma_f32_32x32x16_bf16(pa0, PK(l0, h0), od, 0, 0, 0);
  od = __builtin_amdgcn_mfma_f32_32x32x16_bf16(pa1, PK(l1, h1), od, 0, 0, 0);
  od = __builtin_amdgcn_mfma_f32_32x32x16_bf16(pa2, PK(l2, h2), od, 0, 0, 0);
  od = __builtin_amdgcn_mfma_f32_32x32x16_bf16(pa3, PK(l3, h3), od, 0, 0, 0);
#undef PK
}
__device__ __forceinline__ void pv_d0(f32x16* o, int vb, bf16x8 pa0, bf16x8 pa1, bf16x8 pa2, bf16x8 pa3) {
  pv_one<0>(o[0], vb, pa0, pa1, pa2, pa3); pv_one<1>(o[1], vb, pa0, pa1, pa2, pa3); pv_one<2>(o[2], vb, pa0, pa1, pa2, pa3); pv_one<3>(o[3], vb, pa0, pa1, pa2, pa3);
}
__device__ __forceinline__ void attn_unit(const bf16_t* __restrict__ Qb, const bf16_t* __restrict__ Kh, const bf16_t* __restrict__ Vh, bf16_t* __restrict__ Ob, float* __restrict__ ssq, int seq, float kbound, char* lds, LAS unsigned char* ldsl) {
  int tid_ = threadIdx.x; asm volatile("" : "+v"(tid_));
  const int tid = tid_, wid = tid >> 6, lane = tid & 63, r32 = lane & 31, hi = lane >> 5;
  char* V_lds = lds; char* K_lds = lds + 3 * SHM_V;
  float* ws = (float*)(lds + SHM_WS) + wid * 64; float* li_l = ws;
  float l_reg = 0; f32x16 o[4] = {}; bf16x8 qr[12];
  const bf16_t* Qw = Qb + (size_t)(wid * QBLK + r32) * DK + hi * 8;
  float qss = 0.f;
#pragma unroll
  for (int d0 = 0; d0 < 8; ++d0) { qr[d0] = *reinterpret_cast<const bf16x8*>(Qw + d0 * 16);
#pragma unroll
    for (int e = 0; e < 8; ++e) { const float v = bf2f((bf16_t)qr[d0][e]); qss += v * v; } }
  const char* qrl = nullptr;
#pragma unroll
  for (int d0 = 8; d0 < 12; ++d0) { const bf16x8 qv = *reinterpret_cast<const bf16x8*>(Qw + d0 * 16); qr[d0] = qv;
#pragma unroll
    for (int e = 0; e < 8; ++e) { const float v = bf2f((bf16_t)qv[e]); qss += v * v; } }
  { auto rr = __builtin_amdgcn_permlane32_swap(__float_as_uint(qss), __float_as_uint(qss), false, false); qss = __uint_as_float(rr[0]) + __uint_as_float(rr[1]); }
  f32x16 negm; { const float nm = -__builtin_amdgcn_sqrtf(qss) * kbound;
#pragma unroll
    for (int r = 0; r < 16; ++r) negm[r] = nm; }
  asm volatile("" : "+v"(negm));
  const int vb0 = (int)(uintptr_t)V_lds + v_rd_base(lane);
  const int uw = __builtin_amdgcn_readfirstlane(wid);
  unsigned koff[4], voff[2];
#pragma unroll
  for (int i = 0; i < 4; ++i) { const int c = (uw + 8 * i) * 64 + lane, row = c / 25, cc = c - row * 25; koff[i] = (unsigned)(row * 384 + (cc < 24 ? cc : 23) * 16); }
#pragma unroll
  for (int i = 0; i < 2; ++i) { const int P = (uw + 8 * i) * 64 + lane, sub = P >> 5, within = P & 31, kk = (sub >> 2) * 8 + (within >> 2), c = (sub & 3) * 32 + (within & 3) * 8;
    const int k = (kk & ~0xC) | ((kk & 4) << 1) | ((kk & 8) >> 1); voff[i] = (unsigned)(k * 256 + c * 2); }
  LAS unsigned char* Vl = ldsl; LAS unsigned char* Kl = ldsl + 3 * SHM_V;
#define DMA_TILE(t, kbuf, vbuf) do { const char* kt_ = (const char*)Kh + (size_t)(t) * (KVBLK * DK * 2); const char* vt_ = (const char*)Vh + (size_t)(t) * (KVBLK * DV * 2); \
    unsigned k0_ = koff[0], k1_ = koff[1], k2_ = koff[2], k3_ = koff[3], v0_ = voff[0], v1_ = voff[1]; \
    asm volatile("" : "+v"(k0_), "+v"(k1_), "+v"(k2_), "+v"(k3_), "+v"(v0_), "+v"(v1_));     \
    __builtin_amdgcn_global_load_lds((const unsigned*)(kt_ + k0_), (LAS unsigned*)(Kl + (kbuf) * SHM_K + (uw + 0) * 1024), 16, 0, 0); \
    __builtin_amdgcn_global_load_lds((const unsigned*)(kt_ + k1_), (LAS unsigned*)(Kl + (kbuf) * SHM_K + (uw + 8) * 1024), 16, 0, 0); \
    __builtin_amdgcn_global_load_lds((const unsigned*)(kt_ + k2_), (LAS unsigned*)(Kl + (kbuf) * SHM_K + (uw + 16) * 1024), 16, 0, 0); \
    if (uw == 0) __builtin_amdgcn_global_load_lds((const unsigned*)(kt_ + k3_), (LAS unsigned*)(Kl + (kbuf) * SHM_K + 24 * 1024), 16, 0, 0); \
    __builtin_amdgcn_global_load_lds((const unsigned*)(vt_ + v0_), (LAS unsigned*)(Vl + (vbuf) * SHM_V + (uw + 0) * 1024), 16, 0, 0); \
    __builtin_amdgcn_global_load_lds((const unsigned*)(vt_ + v1_), (LAS unsigned*)(Vl + (vbuf) * SHM_V + (uw + 8) * 1024), 16, 0, 0); } while (0)
#define DMA_SYNC() do { asm volatile("s_waitcnt vmcnt(0)" ::: "memory"); __syncthreads(); } while (0)
  f32x16 pA0, pA1, pB0, pB1; bf16x8 pa0, pa1, pa2, pa3; const int NT = seq / KVBLK;
  int ip = 2, ic = 0, in = 1;
#define ROT() do { const int t_ = ip; ip = ic; ic = in; in = t_; } while (0)
  DMA_TILE(0, 0, 0); DMA_SYNC();
  DMA_TILE(1, 1, in); SBAR();
  qkt(pA0, pA1, K_lds, qr, qrl, negm, r32, hi); expA(pA0);
  DMA_SYNC(); ROT();
  for (int j = 1; j + 1 < NT; j += 2) {
    DMA_TILE(j + 1, 0, in); SBAR();
    qkt(pB0, pB1, K_lds + SHM_K, qr, qrl, negm, r32, hi);
    finishSM(pA0, pA1, l_reg, pa0, pa1, pa2, pa3); sched_qk_sm(); SBAR();
    pv_d0(o, vb0 + ip * SHM_V, pa0, pa1, pa2, pa3); expA(pB0);
    DMA_SYNC(); ROT();
    DMA_TILE(j + 2, 1, in); SBAR();
    qkt(pA0, pA1, K_lds, qr, qrl, negm, r32, hi);
    finishSM(pB0, pB1, l_reg, pa0, pa1, pa2, pa3); sched_qk_sm(); SBAR();
    pv_d0(o, vb0 + ip * SHM_V, pa0, pa1, pa2, pa3); expA(pA0);
    DMA_SYNC(); ROT();
  }
  SBAR(); qkt(pB0, pB1, K_lds + SHM_K, qr, qrl, negm, r32, hi);
  finishSM(pA0, pA1, l_reg, pa0, pa1, pa2, pa3); SBAR();
  pv_d0(o, vb0 + ip * SHM_V, pa0, pa1, pa2, pa3); expA(pB0);
  finishSM(pB0, pB1, l_reg, pa0, pa1, pa2, pa3); SBAR();
  pv_d0(o, vb0 + ic * SHM_V, pa0, pa1, pa2, pa3);
#undef ROT
#undef DMA_TILE
#undef DMA_SYNC
  { auto rr = __builtin_amdgcn_permlane32_swap(__float_as_uint(l_reg), __float_as_uint(l_reg), false, false); l_reg = __uint_as_float(rr[0]) + __uint_as_float(rr[1]); }
  if (hi == 0) li_l[r32] = l_reg; asm volatile("s_waitcnt lgkmcnt(0)" ::: "memory");
  int lane_e = lane; asm volatile("" : "+v"(lane_e));
  const int r32e = lane_e & 31, hie = lane_e >> 5;
  float rli[16];
#pragma unroll
  for (int r = 0; r < 16; ++r) rli[r] = __builtin_amdgcn_rcpf(li_l[crow(r, hie)]);
  __syncthreads();
  bf16_t* stg = (bf16_t*)(lds + wid * 8192);
#pragma unroll
  for (int r = 0; r < 16; ++r) { const int orow = crow(r, hie);
#pragma unroll
    for (int d0 = 0; d0 < 4; ++d0) { const float v = o[d0][r] * rli[r]; stg[orow * 128 + d0 * 32 + r32e] = (bf16_t)(cvt_pk_bf16(v, v) & 0xffffu); } }
  asm volatile("s_waitcnt lgkmcnt(0)" ::: "memory");
#pragma unroll
  for (int i = 0; i < 8; ++i) { const int row = i * 4 + (lane_e >> 4), ch = lane_e & 15;
    const u32x4 v = *(const u32x4*)(stg + row * 128 + ch * 8);
    *(u32x4*)(Ob + (size_t)(wid * QBLK + row) * DM + ch * 8) = v;
    float q = bflo(v.x) * bflo(v.x) + bfhi(v.x) * bfhi(v.x) + bflo(v.y) * bflo(v.y) + bfhi(v.y) * bfhi(v.y) + bflo(v.z) * bflo(v.z) + bfhi(v.z) * bfhi(v.z) + bflo(v.w) * bflo(v.w) + bfhi(v.w) * bfhi(v.w);
    q += shflx(q, lane_e, 1); q += shflx(q, lane_e, 2); q += shflx(q, lane_e, 4); q += shflx(q, lane_e, 8);
    if (ch == 0) atomicAdd(ssq + wid * QBLK + row, q); }
  __syncthreads();
}
#undef SBAR
}

namespace lru {
constexpr int XROW = 136;
constexpr int X_BYTES = 256 * XROW * 2;
constexpr int COMP_OFF = X_BYTES, COMP_BYTES = 4 * 2 * 8 * 32 * 8;
constexpr int CARRY_OFF = COMP_OFF + COMP_BYTES;
constexpr int PRM_OFF = CARRY_OFF + 1024 + 32768;
constexpr int WB_OFF = CARRY_OFF + 1024;
template <bool REV> __device__ __forceinline__ void seg_comp(const float (&a)[16], const float (&bx)[16], float (&A)[4], float (&B)[4]) {
#pragma unroll
  for (int q = 0; q < 4; ++q) { float Aq = 1.f, Bq = 0.f;
#pragma unroll
    for (int ee = 0; ee < 4; ++ee) { const int e = REV ? 3 - ee : ee; const int r = 4 * q + e; Bq = a[r] * Bq + bx[r]; Aq *= a[r]; }
    A[q] = Aq; B[q] = Bq; }
}
template <bool REV> __device__ __forceinline__ float seg_prefix(const float (&loA)[4], const float (&loB)[4], const float (&hiA)[4], const float (&hiB)[4], int hi, float st, float (&start)[4]) {
#pragma unroll
  for (int qq = 0; qq < 4; ++qq) { const int q = REV ? 3 - qq : qq;
    if (!REV) { const float t1 = loA[q] * st + loB[q]; start[q] = hi ? t1 : st; st = hiA[q] * t1 + hiB[q]; }
    else { const float t1 = hiA[q] * st + hiB[q]; start[q] = hi ? st : t1; st = loA[q] * t1 + loB[q]; } }
  return st;
}
template <int PASS>
__device__ __forceinline__ void unit(const Params& p, int chunk, int n, char* lds, float* ssq_l) {
  int tid_ = threadIdx.x; asm volatile("" : "+v"(tid_));
  const int tid = tid_, wid = __builtin_amdgcn_readfirstlane(tid >> 6), lane = tid & 63, j = lane & 31, hi = lane >> 5;
  const int row0 = chunk * 256;
  int seq_start, seq_len;
  if (row0 < MP) { seq_start = row0 & ~(SEQP - 1); seq_len = SEQP; } else { seq_start = MP + ((row0 - MP) & ~(SEQS - 1)); seq_len = SEQS; }
  const int cs = (row0 - seq_start) >> 8, nch = seq_len >> 8, cbase = seq_start >> 8;
  const bf16_t* U = (const bf16_t*)(p.ws + WS_U);
  bf16_t* X = (bf16_t*)lds;
  f32x2* comp = (f32x2*)(lds + COMP_OFF);
  float* carry = (float*)(lds + CARRY_OFF);
  f32x2* agg = (f32x2*)(p.ws + WS_AGG);
  const bf16_t* Wf = (const bf16_t*)(p.ws + WS_BRG) + (size_t)n * 4 * 4 * 8 * 64 * 8;
  char* WB = lds + WB_OFF;
#define WSRC(cg, d, wh) (Wf + ((size_t)(((2 * (d) + (wh)) * 4 + (cg)) * 8) * 64 + tid) * 8)
  bf16x8 sw0 = *(const bf16x8*)WSRC(0, 0, 0), sw1 = *(const bf16x8*)WSRC(0, 0, 1);
  { const int cg8 = (tid & 15) * 8, tg = tid >> 4; const int c0 = n * 128 + cg8;
    const float* cw = p.in[10]; const float* cb = p.in[11];
    float w[4][8], bb[8];
#pragma unroll
    for (int t = 0; t < 4; ++t) { const f32x4 a = *(const f32x4*)(cw + t * 1024 + c0), b = *(const f32x4*)(cw + t * 1024 + c0 + 4);
      w[t][0] = a[0]; w[t][1] = a[1]; w[t][2] = a[2]; w[t][3] = a[3]; w[t][4] = b[0]; w[t][5] = b[1]; w[t][6] = b[2]; w[t][7] = b[3]; }
    { const f32x4 a = *(const f32x4*)(cb + c0), b = *(const f32x4*)(cb + c0 + 4); bb[0] = a[0]; bb[1] = a[1]; bb[2] = a[2]; bb[3] = a[3]; bb[4] = b[0]; bb[5] = b[1]; bb[6] = b[2]; bb[7] = b[3]; }
    u32x4 rw[11];
#pragma unroll
    for (int rr = 0; rr < 11; ++rr) { const int grow = row0 + tg * 8 + rr - 1; const bool ok = (grow >= seq_start) && (grow < seq_start + seq_len);
      rw[rr] = ok ? *(const u32x4*)(U + (size_t)grow * LDU + UC_X + c0) : (u32x4){0u, 0u, 0u, 0u}; }
#pragma unroll
    for (int t = 0; t < 8; ++t) { float y[8];
#pragma unroll
      for (int c = 0; c < 8; ++c) y[c] = bb[c];
#pragma unroll
      for (int tp = 0; tp < 4; ++tp) { const u32x4 v = rw[t + tp];
        y[0] += w[tp][0] * bflo(v.x); y[1] += w[tp][1] * bfhi(v.x); y[2] += w[tp][2] * bflo(v.y); y[3] += w[tp][3] * bfhi(v.y);
        y[4] += w[tp][4] * bflo(v.z); y[5] += w[tp][5] * bfhi(v.z); y[6] += w[tp][6] * bflo(v.w); y[7] += w[tp][7] * bfhi(v.w); }
      u32x4 o; o.x = cvt_pk_bf16(y[0], y[1]); o.y = cvt_pk_bf16(y[2], y[3]); o.z = cvt_pk_bf16(y[4], y[5]); o.w = cvt_pk_bf16(y[6], y[7]);
      *(u32x4*)(X + (tg * 8 + t) * XROW + cg8) = o; }
  }
  if (PASS == 2 && tid < 256) { const int dir = tid >> 7, ch = tid & 127; float st = 0.f;
    const int cnt = dir ? nch - 1 - cs : cs;
    for (int k0 = 0; k0 < cnt; k0 += 16) { f32x2 ab[16];
#pragma unroll
      for (int i = 0; i < 16; ++i) { const int k = k0 + i; const bool ok = k < cnt; const int c = ok ? (dir ? nch - 1 - k : k) : cs;
        ab[i] = agg[(size_t)(dir * NCHUNK + cbase + c) * 1024 + n * 128 + ch]; if (!ok) ab[i] = (f32x2){1.f, 0.f}; }
#pragma unroll
      for (int i = 0; i < 16; ++i) st = ab[i].x * st + ab[i].y; }
    carry[dir * 128 + ch] = st; }
  *(bf16x8*)(WB + tid * 16) = sw0; *(bf16x8*)(WB + 8192 + tid * 16) = sw1;
  if (tid < 256) { const int dir = tid >> 7, ch = tid & 127;
    const float lm = p.in[16][dir * 1024 + n * 128 + ch];
    *(f32x4*)(lds + PRM_OFF + (dir * 128 + ch) * 16) = (f32x4){p.in[13][(dir * 8 + n) * 128 + ch], p.in[15][(dir * 8 + n) * 128 + ch], (8.0f * 1.4426950408889634f) * log1pf(__expf(-lm)), 0.f}; }
  __syncthreads();
  const float* lam = p.in[16];
  const bf16_t* Xw = X + (32 * wid + j) * XROW + 8 * hi;
  for (int cgp = 0; cgp < 4; ++cgp) {
    const int ch = 32 * cgp + j, gch = n * 128 + ch;
    float sum[16];
    bf16_t graw[16];
    if (PASS == 2) { int rb = row0 + 32 * wid + 4 * hi; asm volatile("" : "+v"(rb));
#pragma unroll
      for (int r = 0; r < 16; ++r) graw[r] = U[(size_t)(rb + (r & 3) + 8 * (r >> 2)) * LDU + UC_G + gch];
    }
#pragma unroll
    for (int dir = 0; dir < 2; ++dir) {
      const bool has_next = !(cgp == 3 && dir == 1);
      if (has_next) { const int ncg = dir ? cgp + 1 : cgp; sw0 = *(const bf16x8*)WSRC(ncg, dir ^ 1, 0); sw1 = *(const bf16x8*)WSRC(ncg, dir ^ 1, 1); }
      f32x16 accr = f32x16{}, acci = f32x16{};
#pragma unroll
      for (int ks = 0; ks < 8; ++ks) { const bf16x8 xa = *(const bf16x8*)(Xw + 16 * ks);
        const bf16x8 bfr = *(const bf16x8*)(WB + dir * 16384 + ks * 1024 + lane * 16);
        const bf16x8 bfi = *(const bf16x8*)(WB + dir * 16384 + 8192 + ks * 1024 + lane * 16);
        accr = __builtin_amdgcn_mfma_f32_32x32x16_bf16(xa, bfr, accr, 0, 0, 0);
        acci = __builtin_amdgcn_mfma_f32_32x32x16_bf16(xa, bfi, acci, 0, 0, 0);
        if ((ks & 3) == 3) __builtin_amdgcn_sched_barrier(0); }
      const f32x4 prm = *(const f32x4*)(lds + PRM_OFF + (dir * 128 + ch) * 16);
      const float br = prm[0], bi = prm[1], c8 = prm[2];
      float a[16], bx[16];
#pragma unroll
      for (int r = 0; r < 16; ++r) { const float xv = bf2f(X[(32 * wid + crow(r, hi)) * XROW + ch]);
        const float rg = sigmoidf_(accr[r] + br), ig = sigmoidf_(acci[r] + bi);
        const float av = __builtin_amdgcn_exp2f(-c8 * rg); a[r] = av; bx[r] = __builtin_amdgcn_sqrtf(fmaxf(1.0f - av * av, 0.f)) * ig * xv; }
      float A[4], B[4], loA[4], loB[4], hiA[4], hiB[4], start[4];
      if (dir == 0) seg_comp<false>(a, bx, A, B); else seg_comp<true>(a, bx, A, B);
#pragma unroll
      for (int q = 0; q < 4; ++q) { const float pA = __shfl_xor(A[q], 32), pB = __shfl_xor(B[q], 32);
        loA[q] = hi ? pA : A[q]; loB[q] = hi ? pB : B[q]; hiA[q] = hi ? A[q] : pA; hiB[q] = hi ? B[q] : pB; }
      float Aw = 1.f;
#pragma unroll
      for (int q = 0; q < 4; ++q) Aw *= loA[q] * hiA[q];
      const float Bw = (dir == 0) ? seg_prefix<false>(loA, loB, hiA, hiB, hi, 0.f, start) : seg_prefix<true>(loA, loB, hiA, hiB, hi, 0.f, start);
      if (hi == 0) comp[((cgp * 2 + dir) * 8 + wid) * 32 + j] = (f32x2){Aw, Bw};
      if (has_next) { *(bf16x8*)(WB + (dir ^ 1) * 16384 + tid * 16) = sw0; *(bf16x8*)(WB + (dir ^ 1) * 16384 + 8192 + tid * 16) = sw1; }
      __syncthreads();
      if (PASS == 2) {
        float st = carry[dir * 128 + ch];
        if (dir == 0) { for (int w2 = 0; w2 < wid; ++w2) { const f32x2 ab = comp[((cgp * 2 + 0) * 8 + w2) * 32 + j]; st = ab.x * st + ab.y; } }
        else { for (int w2 = 7; w2 > wid; --w2) { const f32x2 ab = comp[((cgp * 2 + 1) * 8 + w2) * 32 + j]; st = ab.x * st + ab.y; } }
        if (dir == 0) { (void)seg_prefix<false>(loA, loB, hiA, hiB, hi, st, start);
#pragma unroll
          for (int q = 0; q < 4; ++q) { float h = start[q];
#pragma unroll
            for (int e = 0; e < 4; ++e) { const int r = 4 * q + e; h = a[r] * h + bx[r]; sum[r] = h; } } }
        else { (void)seg_prefix<true>(loA, loB, hiA, hiB, hi, st, start);
#pragma unroll
          for (int q = 0; q < 4; ++q) { float h = start[q];
#pragma unroll
            for (int ee = 0; ee < 4; ++ee) { const int r = 4 * q + 3 - ee; h = a[r] * h + bx[r]; sum[r] += h; } } }
      }
    }
    if (PASS == 2) {
      bf16_t* mixed = (bf16_t*)(p.ws + WS_XB);
      int rb2 = row0 + 32 * wid + 4 * hi, lane2 = lane; asm volatile("" : "+v"(rb2), "+v"(lane2));
#pragma unroll
      for (int r = 0; r < 16; ++r) { const int row = rb2 + (r & 3) + 8 * (r >> 2);
        const float g = bf2f(graw[r]);
        const float u3 = 0.7978845608028654f * (g + 0.044715f * g * g * g);
        const float th = 1.0f - 2.0f * __builtin_amdgcn_rcpf(1.0f + __builtin_amdgcn_exp2f((2.0f * 1.4426950408889634f) * u3));
        const float val = sum[r] * (0.5f * g * (1.0f + th));
        const unsigned pk = cvt_pk_bf16(val, val); const bf16_t hv = (bf16_t)(pk & 0xffffu);
        mixed[(size_t)row * DM + 1024 + gch] = hv;
        float q = bf2f(hv); q = q * q;
        q += shflx(q, lane2, 1); q += shflx(q, lane2, 2); q += shflx(q, lane2, 4); q += shflx(q, lane2, 8); q += shflx(q, lane2, 16);
        if ((lane2 & 31) == 0) atomicAdd(ssq_l + row, q); }
    }
  }
  if (PASS == 1) {
    __syncthreads();
    if (tid < 256) { const int dir = tid >> 7, ch = tid & 127, cgp = ch >> 5, jj = ch & 31; float A = 1.f, B = 0.f;
      if (dir == 0) { for (int w2 = 0; w2 < 8; ++w2) { const f32x2 ab = comp[((cgp * 2 + 0) * 8 + w2) * 32 + jj]; B = ab.x * B + ab.y; A *= ab.x; } }
      else { for (int w2 = 7; w2 >= 0; --w2) { const f32x2 ab = comp[((cgp * 2 + 1) * 8 + w2) * 32 + jj]; B = ab.x * B + ab.y; A *= ab.x; } }
      agg[(size_t)(dir * NCHUNK + chunk) * 1024 + n * 128 + ch] = (f32x2){A, B}; }
  }
  __syncthreads();
#undef WSRC
}
}

__device__ __forceinline__ void tr_item(const float* W, int ldw, int K, int srccol0, const float* gk, bf16_t* dst, int k0, LAS float* scr, int lane) {
  { const int n4 = (lane & 7) * 4; f32x4 v[8];
#pragma unroll
    for (int i = 0; i < 8; ++i) { const int kk = 8 * i + (lane >> 3); v[i] = (f32x4){0.f, 0.f, 0.f, 0.f};
      if (srccol0 >= 0) { v[i] = *(const f32x4*)(W + (size_t)(k0 + kk) * ldw + srccol0 + n4); if (gk) v[i] = v[i] * gk[kk]; } }
#pragma unroll
    for (int i = 0; i < 8; ++i) { const int kk = 8 * i + (lane >> 3); LAS float* d = scr + kk * 33 + n4; d[0] = v[i][0]; d[1] = v[i][1]; d[2] = v[i][2]; d[3] = v[i][3]; } }
  asm volatile("s_waitcnt lgkmcnt(0)" ::: "memory");
  const int c = lane & 7;
#pragma unroll
  for (int jq = 0; jq < 4; ++jq) { const int nn = (lane >> 3) + 8 * jq; const LAS float* s = scr + (8 * c) * 33 + nn;
    u32x4 o; o.x = cvt_pk_bf16(s[0 * 33], s[1 * 33]); o.y = cvt_pk_bf16(s[2 * 33], s[3 * 33]); o.z = cvt_pk_bf16(s[4 * 33], s[5 * 33]); o.w = cvt_pk_bf16(s[6 * 33], s[7 * 33]);
    *(u32x4*)(dst + (size_t)nn * K + k0 + 8 * c) = o; }
  asm volatile("s_waitcnt lgkmcnt(0)" ::: "memory");
}

__device__ __forceinline__ void p0_prologue(const Params& p, LAS unsigned char* lds, int vcu, int G) {
  int tid_ = threadIdx.x; asm volatile("" : "+v"(tid_));
  const int tid = tid_, lane = tid & 63, wave = __builtin_amdgcn_readfirstlane(tid >> 6);
  const int gw = vcu * 8 + wave, NGW = G * 8;
  const size_t gt = (size_t)blockIdx.x * 512 + tid, NGT = (size_t)G * 512;
  unsigned char* ws = p.ws;
  { float* z = (float*)(ws + WS_ZERO); for (size_t i = gt; i < ZERO_BYTES / 4; i += NGT) z[i] = 0.f; }
  { f32x2* rt = (f32x2*)(ws + WS_ROPE);
    for (size_t i = gt; i < (size_t)SEQP * 32; i += NGT) { const int s = (int)(i >> 5), f = (int)(i & 31);
      double rev = (double)s * INV_FREQ[f] * 0.15915494309189535; rev -= __builtin_rint(rev); const float r = (float)rev;
      rt[i] = (f32x2){__builtin_amdgcn_cosf(r), __builtin_amdgcn_sinf(r)}; } }
  { bf16_t* wf = (bf16_t*)(ws + WS_BRG);
    for (size_t ci = gt; ci < 65536; ci += NGT) { const int ln = (int)(ci & 63), ks = (int)((ci >> 6) & 7), cgp = (int)((ci >> 9) & 3), dw = (int)((ci >> 11) & 3), n = (int)(ci >> 13);
      const int jj = ln & 31, kg = ln >> 5, dir = dw >> 1, wh = dw & 1;
      const float* src = (wh ? p.in[14] : p.in[12]) + (size_t)(dir * 8 + n) * 128 * 128 + (size_t)(16 * ks + 8 * kg) * 128 + 32 * cgp + jj;
      u32x4 o; o.x = cvt_pk_bf16(src[0], src[128]); o.y = cvt_pk_bf16(src[256], src[384]); o.z = cvt_pk_bf16(src[512], src[640]); o.w = cvt_pk_bf16(src[768], src[896]);
      *(u32x4*)(wf + ci * 8) = o; } }
  { bf16_t* xb = (bf16_t*)(ws + WS_XB); float* rs1 = (float*)(ws + WS_RS1);
    for (int m0 = gw; m0 < M; m0 += 2 * NGW) {
      const int m1 = (m0 + NGW < M) ? m0 + NGW : m0;
      const float* xr0 = (m0 < MP) ? p.in[0] + (size_t)m0 * DM : p.in[1] + (size_t)(m0 - MP) * DM;
      const float* xr1 = (m1 < MP) ? p.in[0] + (size_t)m1 * DM : p.in[1] + (size_t)(m1 - MP) * DM;
      f32x4 v0[8], v1[8]; float s0 = 0.f, s1 = 0.f;
#pragma unroll
      for (int q = 0; q < 8; ++q) { v0[q] = *(const f32x4*)(xr0 + q * 256 + lane * 4); v1[q] = *(const f32x4*)(xr1 + q * 256 + lane * 4); }
#pragma unroll
      for (int q = 0; q < 8; ++q) { s0 += (v0[q][0] * v0[q][0] + v0[q][1] * v0[q][1]) + (v0[q][2] * v0[q][2] + v0[q][3] * v0[q][3]);
        s1 += (v1[q][0] * v1[q][0] + v1[q][1] * v1[q][1]) + (v1[q][2] * v1[q][2] + v1[q][3] * v1[q][3]); }
      s0 = wave_sum(s0); s1 = wave_sum(s1);
      if (lane == 0) { rs1[m0] = 1.0f / sqrtf(s0 * (1.0f / DM) + EPS); rs1[m1] = 1.0f / sqrtf(s1 * (1.0f / DM) + EPS); }
#pragma unroll
      for (int q = 0; q < 8; ++q) { u32x2 w; w.x = cvt_pk_bf16(v0[q][0], v0[q][1]); w.y = cvt_pk_bf16(v0[q][2], v0[q][3]); *(u32x2*)(xb + (size_t)m0 * DM + q * 256 + lane * 4) = w;
        u32x2 w1; w1.x = cvt_pk_bf16(v1[q][0], v1[q][1]); w1.y = cvt_pk_bf16(v1[q][2], v1[q][3]); *(u32x2*)(xb + (size_t)m1 * DM + q * 256 + lane * 4) = w1; } } }
  LAS float* scr = (LAS float*)(lds + wave * 16384);
  constexpr int I_IN = 96 * 32, I_UQ = 64 * 8, I_UKV = 64 * 4, I_OUT = 64 * 32, I_GU = 352 * 32, I_DN = 64 * 88;
  constexpr int NITEMS = I_IN + I_UQ + I_UKV + I_OUT + I_GU + I_DN;
  for (int it = gw; it < NITEMS; it += NGW) {
    int r = it;
    if (r < I_IN) { const int ng = r >> 5, kb = r & 31, dc = ng * 32; int sc;
      if (dc < 768) sc = dc; else if (dc < 1792) sc = dc - 768 + 832; else if (dc < 2816) sc = dc - 1792 + 1856; else if (dc < 2880) sc = dc - 2816 + 768; else sc = -1;
      tr_item(p.in[3], 2880, 2048, sc, p.in[2] + kb * 64, (bf16_t*)(ws + WS_BIN) + (size_t)dc * 2048, kb * 64, scr, lane); continue; } r -= I_IN;
    if (r < I_UQ) { const int ng = r >> 3, kb = r & 7, h = ng >> 3, t0 = (ng & 7) * 32; int d;
      if (t0 < 96) d = t0; else if (t0 == 96) d = 128; else if (t0 == 128) d = 96; else if (t0 == 224) d = 160; else d = -1;
      tr_item(p.in[5], 1536, 512, d < 0 ? -1 : h * 192 + d, p.in[4] + kb * 64, (bf16_t*)(ws + WS_BUQ) + (size_t)(ng * 32) * 512, kb * 64, scr, lane); continue; } r -= I_UQ;
    if (r < I_UKV) { const int ng = r >> 2, kb = r & 3;
      tr_item(p.in[7], 2048, 256, ng * 32, p.in[6] + kb * 64, (bf16_t*)(ws + WS_BUKV) + (size_t)(ng * 32) * 256, kb * 64, scr, lane); continue; } r -= I_UKV;
    if (r < I_OUT) { const int ng = r >> 5, kb = r & 31; const float* gk = (kb < 16) ? p.in[17] + kb * 64 : p.in[18] + (kb - 16) * 64;
      tr_item(p.in[19], 2048, 2048, ng * 32, gk, (bf16_t*)(ws + WS_BOUT) + (size_t)(ng * 32) * 2048, kb * 64, scr, lane); continue; } r -= I_OUT;
    if (r < I_GU) { const int ng = r >> 5, kb = r & 31, R = ng * 32, pn = R >> 8, within = R & 255, bj = within >> 7, c = within & 127;
      tr_item(bj ? p.in[22] : p.in[21], DFF, 2048, pn * 128 + c, p.in[20] + kb * 64, (bf16_t*)(ws + WS_BGU) + (size_t)R * 2048, kb * 64, scr, lane); continue; } r -= I_GU;
    { const int ng = r / 88, kb = r % 88;
      tr_item(p.in[23], 2048, DFF, ng * 32, nullptr, (bf16_t*)(ws + WS_BDN) + (size_t)(ng * 32) * DFF, kb * 64, scr, lane); }
  }
}

__global__ void __launch_bounds__(512, 2) hymba_fwd(Params p) {
  extern __shared__ __attribute__((aligned(16))) unsigned char lds[];
  cg::grid_group grid = cg::this_grid();
  LAS unsigned char* ldsl = (LAS unsigned char*)lds;
  const int G = gridDim.x, bx = blockIdx.x;
  const int vcu = (G % 8 == 0) ? (bx % 8) * (G / 8) + bx / 8 : bx;
  unsigned char* ws = p.ws;
  float* const dummy = (float*)(ws + WS_DUMMY);
#ifndef PROBE_TA
#define PROBE_TA -1
#define PROBE_TB -1
#endif
  unsigned long long t_a = 0, t_b = 0;
#define STAMP(k) do { if (PROBE_TA >= 0) { if ((k) == PROBE_TA) t_a = __builtin_amdgcn_s_memrealtime(); if ((k) == PROBE_TB) t_b = __builtin_amdgcn_s_memrealtime(); } } while (0)
  STAMP(0);

#ifndef NO_P0
  for (int rep = 0; rep < NREP(0); ++rep) p0_prologue(p, ldsl, vcu, G);
#endif
  grid.sync(); STAMP(1);

  for (int rep = 0; rep < NREP(1); ++rep) { pg8::Gemm g{(const bf16_t*)(ws + WS_XB), (const bf16_t*)(ws + WS_BIN), DM, LDU, DM}; pg8::StaticOrder S; S.init(M, LDU, G, bx);
    pg8::EpiU E{(bf16_t*)(ws + WS_U), (const float*)(ws + WS_RS1), rep ? dummy : (float*)(ws + WS_SSQ_Q), rep ? dummy : (float*)(ws + WS_SSQ_KV), rep ? dummy : (float*)(ws + WS_SSQ_PE)};

#ifndef NO_EPIU
    pg8::gemm_phase<pg8::EpiU>(ldsl, g, S, E);
#endif
  }
  grid.sync(); STAMP(2);

  for (int rep = 0; rep < NREP(2); ++rep) {
  { pg8::Gemm g{(const bf16_t*)(ws + WS_U) + UC_Q, (const bf16_t*)(ws + WS_BUQ), LDU, 2048, 512}; pg8::StaticOrder S; S.init(M, 2048, G, bx);
    pg8::EpiQ E{(bf16_t*)(ws + WS_Q), (const float*)(ws + WS_SSQ_Q), p.in[8], (const f32x2*)(ws + WS_ROPE), (LAS float*)(ldsl + XCH_OFF)};

#ifndef NO_EPIQ
    pg8::gemm_phase<pg8::EpiQ>(ldsl, g, S, E);
#endif
  }
  { pg8::Gemm g{(const bf16_t*)(ws + WS_U) + UC_KV, (const bf16_t*)(ws + WS_BUKV), LDU, 2048, 256}; pg8::StaticOrder S; S.init(M, 2048, G, bx);
    pg8::EpiKV E{(bf16_t*)(ws + WS_K), (bf16_t*)(ws + WS_V), (const bf16_t*)(ws + WS_U), (const float*)(ws + WS_SSQ_KV), (const float*)(ws + WS_SSQ_PE), p.in[9], (const f32x2*)(ws + WS_ROPE), (LAS float*)(ldsl + XCH_OFF)};

#ifndef NO_EPIKV
    pg8::gemm_phase<pg8::EpiKV>(ldsl, g, S, E);
#endif
  }
#ifndef NO_LRU1
  for (int u = vcu; u < NCHUNK * 8; u += G) lru::unit<1>(p, u >> 3, u & 7, (char*)lds, nullptr);
#endif
  }
  grid.sync(); STAMP(3);

#ifndef NO_LRU2
  for (int rep = 0; rep < NREP(3); ++rep)
  for (int u = vcu; u < NCHUNK * 8; u += G) lru::unit<2>(p, u >> 3, u & 7, (char*)lds, rep ? dummy : (float*)(ws + WS_SSQ_L));
#endif
  STAMP(4);

#ifndef NO_ATT
  { const bf16_t* Qt = (const bf16_t*)(ws + WS_Q); const bf16_t* Kt = (const bf16_t*)(ws + WS_K); const bf16_t* Vt = (const bf16_t*)(ws + WS_V);
    bf16_t* mixed = (bf16_t*)(ws + WS_XB); float* ssq_a = (float*)(ws + WS_SSQ_A);
    float kbound; { const int ln = threadIdx.x & 63; float gm = fmaxf(fmaxf(fabsf(p.in[9][ln]), fabsf(p.in[9][64 + ln])), fabsf(p.in[9][128 + ln]));
#pragma unroll
      for (int o = 1; o < 64; o <<= 1) gm = fmaxf(gm, __shfl_xor(gm, o));
      kbound = 13.856406460551018f * 1.02f * gm; }
    const int nrp = (1024 + G - 1) / G, nrs = (256 + G - 1) / G;
    for (int rep = 0; rep < NREP(4); ++rep)
    for (int i = 0; i < nrp + nrs; ++i) { int pl, qb, seq, row0; size_t prow;
      if (i < nrp) { if (G == 256) { pl = 2 * (vcu >> 5) + (i >> 1); qb = (vcu & 31) + 32 * (i & 1); } else { const int uu = i * G + vcu; if (uu >= 1024) continue; pl = uu >> 6; qb = uu & 63; }
        prow = (size_t)pl * SEQP; seq = SEQP; row0 = (pl >> 3) * SEQP + qb * 256; }
      else { const int uu = (i - nrp) * G + vcu; if (uu >= 256) continue; pl = uu >> 3; qb = uu & 7; prow = (size_t)MP * NH + (size_t)pl * SEQS; seq = SEQS; row0 = MP + (pl >> 3) * SEQS + qb * 256; }
      const int h = pl & 7;
      att::attn_unit(Qt + (prow + qb * 256) * DK, Kt + prow * DK, Vt + prow * DV, mixed + (size_t)row0 * DM + h * 128, (rep ? dummy : ssq_a) + row0, seq, kbound, (char*)lds, ldsl); }
  }
#endif
  grid.sync(); STAMP(5);

  for (int rep = 0; rep < NREP(5); ++rep) { pg8::Gemm g{(const bf16_t*)(ws + WS_XB), (const bf16_t*)(ws + WS_BOUT), DM, DM, DM}; pg8::StaticOrder S; S.init(M, DM, G, bx);
    pg8::EpiOut E{p.in[0], p.in[1], p.out, (bf16_t*)(ws + WS_U), (const float*)(ws + WS_SSQ_A), (const float*)(ws + WS_SSQ_L), rep ? dummy : (float*)(ws + WS_SSQ_2)};

#ifndef NO_EPIOUT
    pg8::gemm_phase<pg8::EpiOut>(ldsl, g, S, E);
#endif
  }
  grid.sync(); STAMP(6);

  for (int rep = 0; rep < NREP(6); ++rep) { pg8::Gemm g{(const bf16_t*)(ws + WS_U), (const bf16_t*)(ws + WS_BGU), DM, 2 * DFF, DM}; pg8::StaticOrder S; S.init(M, 2 * DFF, G, bx);
    pg8::EpiGU E{(bf16_t*)(ws + WS_ACT), (const float*)(ws + WS_SSQ_2)};

#ifndef NO_EPIGU
    pg8::gemm_phase<pg8::EpiGU>(ldsl, g, S, E);
#endif
  }
  grid.sync(); STAMP(7);

  { pg8::Gemm g{(const bf16_t*)(ws + WS_ACT), (const bf16_t*)(ws + WS_BDN), DFF, DM, DFF}; pg8::StaticOrder S; S.init(M, DM, G, bx);
    pg8::EpiDown E{p.out};

#ifndef NO_EPIDOWN
    pg8::gemm_phase<pg8::EpiDown>(ldsl, g, S, E);
#endif
  }
  if (PROBE_TA >= 0) { grid.sync(); STAMP(8); if (bx == 0 && threadIdx.x == 0) p.out[(size_t)MP * DM + 12345] += (float)(t_b - t_a) * 1e-5f; }
}

extern "C" void kernel_launch(void* const* d_in, const int* in_sizes, int n_in, void* d_out, int out_size, void* d_ws, size_t ws_size, hipStream_t stream) {
  static int grid = 0;
  if (grid == 0) {
    if (n_in != 24 || out_size != M * DM || ws_size < WS_END) { fprintf(stderr, "kernel_launch: unexpected shapes: n_in %d out %d ws %zu (need %zu)\n", n_in, out_size, ws_size, (size_t)WS_END); grid = -1; return; }
    int dev = 0, cus = 0, per_cu = 0;
    hipGetDevice(&dev); hipDeviceGetAttribute(&cus, hipDeviceAttributeMultiprocessorCount, dev);
    if (hipFuncSetAttribute((const void*)hymba_fwd, hipFuncAttributeMaxDynamicSharedMemorySize, LDS_BYTES) != hipSuccess) { fprintf(stderr, "kernel_launch: hipFuncSetAttribute failed\n"); grid = -1; return; }
    if (hipOccupancyMaxActiveBlocksPerMultiprocessor(&per_cu, (const void*)hymba_fwd, 512, LDS_BYTES) != hipSuccess || per_cu < 1) { fprintf(stderr, "kernel_launch: occupancy query says %d\n", per_cu); per_cu = 1; }
    (void)hipGetLastError();
    grid = cus * 1;
  }
  if (grid < 0) return;
  Params p{};
  for (int i = 0; i < 24; ++i) p.in[i] = (const float*)d_in[i];
  p.out = (float*)d_out; p.ws = (unsigned char*)d_ws;
  void* args[] = {&p};
  hipError_t e = hipLaunchCooperativeKernel((const void*)hymba_fwd, dim3(grid), dim3(512), args, LDS_BYTES, stream);
  if (e != hipSuccess) fprintf(stderr, "cooperative launch failed: %s (grid %d)\n", hipGetErrorString(e), grid);
}
```

```cpp
#include <hip/hip_runtime.h>
#include <hip/hip_cooperative_groups.h>
#include <cstdio>
#include <cstdint>
namespace cg = cooperative_groups;

#define LAS __attribute__((address_space(3)))
typedef unsigned short bf16_t;
typedef short bf16x8 __attribute__((ext_vector_type(8)));
typedef short s16x4 __attribute__((ext_vector_type(4)));
typedef float f32x4 __attribute__((ext_vector_type(4)));
typedef float f32x2 __attribute__((ext_vector_type(2)));
typedef float f32x16 __attribute__((ext_vector_type(16)));
typedef unsigned u32x4 __attribute__((ext_vector_type(4)));
typedef unsigned u32x2 __attribute__((ext_vector_type(2)));

constexpr int M = 40960, MP = 32768, SEQP = 16384, SEQS = 2048, DM = 2048;
constexpr int LDU = 3072, UC_Q = 0, UC_KV = 512, UC_X = 768, UC_G = 1792, UC_PE = 2816;
constexpr int NH = 8, DK = 192, DV = 128, DFF = 5632;
constexpr float EPS = 1e-6f;
constexpr int NCHUNK = M / 256;

constexpr size_t MiB = 1u << 20, KiB = 1024;
constexpr size_t WS_RS1 = 0;
constexpr size_t WS_ZERO = 256 * KiB;
constexpr size_t WS_SSQ_Q = WS_ZERO, WS_SSQ_KV = WS_ZERO + 256 * KiB, WS_SSQ_PE = WS_ZERO + 512 * KiB, WS_SSQ_A = WS_ZERO + 768 * KiB,
                 WS_SSQ_L = WS_ZERO + 1024 * KiB, WS_SSQ_2 = WS_ZERO + 1280 * KiB;
constexpr size_t ZERO_BYTES = 1536 * KiB;
constexpr size_t WS_ROPE = 2 * MiB;
constexpr size_t WS_AGG = 6 * MiB;
constexpr size_t WS_DUMMY = 9 * MiB;
constexpr size_t WS_BIN = 16 * MiB, WS_BUQ = 28 * MiB, WS_BUKV = 30 * MiB, WS_BRG = 31 * MiB, WS_BOUT = 32 * MiB, WS_BGU = 40 * MiB, WS_BDN = 84 * MiB;
constexpr size_t WS_XB = 112 * MiB;
constexpr size_t WS_U = 272 * MiB;
constexpr size_t WS_Q = 512 * MiB, WS_K = 632 * MiB, WS_V = 752 * MiB;
constexpr size_t WS_ACT = 512 * MiB;
constexpr size_t WS_END = 952 * MiB;

constexpr int RING_BYTES = 131072, XCH_OFF = 131072, LDS_BYTES = 147456;

#ifndef PROBE_REPEAT
#define PROBE_REPEAT 0
#endif
#define NREP(bit) ((PROBE_REPEAT >> (bit)) & 1 ? 2 : 1)
struct Params {
  const float* in[24];
  float* out;
  unsigned char* ws;
};

__device__ const double INV_FREQ[32] = {1.0, 0.7498942093324559, 0.5623413251903491, 0.4216965034285822, 0.31622776601683794, 0.23713737056616552, 0.1778279410038923, 0.1333521432163324, 0.1, 0.07498942093324558, 0.05623413251903491, 0.042169650342858224, 0.03162277660168379, 0.023713737056616554, 0.01778279410038923, 0.01333521432163324, 0.01, 0.007498942093324558, 0.005623413251903491, 0.004216965034285823, 0.0031622776601683794, 0.0023713737056616554, 0.0017782794100389228, 0.001333521432163324, 0.001, 0.0007498942093324559, 0.0005623413251903491, 0.00042169650342858224, 0.00031622776601683794, 0.00023713737056616554, 0.00017782794100389227, 0.0001333521432163324};

__device__ __forceinline__ unsigned cvt_pk_bf16(float lo, float hi) { unsigned r; asm volatile("v_cvt_pk_bf16_f32 %0, %1, %2" : "=v"(r) : "v"(lo), "v"(hi)); return r; }
__device__ __forceinline__ float bf2f(bf16_t v) { return __uint_as_float(((unsigned)v) << 16); }
__device__ __forceinline__ float bflo(unsigned w) { return __uint_as_float(w << 16); }
__device__ __forceinline__ float bfhi(unsigned w) { return __uint_as_float(w & 0xffff0000u); }
__device__ __forceinline__ float wave_sum(float v) {
#pragma unroll
  for (int o = 1; o < 64; o <<= 1) v += __shfl_xor(v, o);
  return v;
}
__device__ __forceinline__ float shflx(float v, int lane, int mask) { return __int_as_float(__builtin_amdgcn_ds_bpermute((lane ^ mask) << 2, __float_as_int(v))); }
__device__ __forceinline__ float sigmoidf_(float x) { return __builtin_amdgcn_rcpf(1.0f + __builtin_amdgcn_exp2f(x * -1.4426950408889634f)); }
__device__ __forceinline__ int crow(int r, int hi) { return (r & 3) + 8 * (r >> 2) + 4 * hi; }
__device__ __forceinline__ size_t plane_row(int m, int h) {
  if (m < MP) { const int b = m >> 14, s = m & (SEQP - 1); return ((size_t)(b * NH + h) * SEQP + s); }
  const int mm = m - MP, b = mm >> 11, s = mm & (SEQS - 1); return (size_t)MP * NH + ((size_t)(b * NH + h) * SEQS + s);
}
__device__ __forceinline__ int seq_pos(int m) { return m < MP ? (m & (SEQP - 1)) : ((m - MP) & (SEQS - 1)); }

namespace pg8 {
constexpr int BM = 256, BK = 64, HALF = 128, HTB = HALF * BK * 2, STAGE_BYTES = 8 * HTB, NXCD = 8, WGM = 8;
__host__ __device__ __forceinline__ int lds_byte(int r, int c) { const int st = (r >> 4) * 2 + (c >> 5), rr = r & 15, cc = c & 31, ob = rr * 64 + cc * 2; return st * 1024 + (ob ^ (((ob >> 9) & 1) << 5)); }
__host__ __device__ __forceinline__ void stage_rc(int b, int& R, int& C) { const int st = b / 1024, sb = b % 1024, swz = sb ^ (((sb >> 9) & 1) << 5); R = (st >> 1) * 16 + swz / 64; C = (st & 1) * 32 + (swz % 64) / 2; }
__host__ __device__ __forceinline__ int perm32(int rho) { const int n = rho >> 4, i = rho & 15; return 8 * (i >> 2) + 4 * n + (i & 3); }
struct Unit { int pm, pn; };
struct Gemm { const bf16_t* A; const bf16_t* Bt; int lda, N, K; };
struct StaticOrder {
  int nM, nN, nwg, G, c;
  __device__ void init(int Mr, int N, int G_, int c_) { nM = Mr / BM; nN = N / BM; nwg = nM * nN; G = G_; c = c_; }
  __device__ bool next(int i, Unit& u) const {
    const long L = (long)i * G + c; if (L >= nwg) return false;
    int wgid = (int)L; { const int q = nwg / NXCD, r = nwg % NXCD, xcd = wgid % NXCD, off = wgid / NXCD; wgid = (xcd < r ? xcd * (q + 1) : r * (q + 1) + (xcd - r) * q) + off; }
    const int nig = WGM * nN, gid = wgid / nig, fm = gid * WGM, gsz = (nM - fm) < WGM ? (nM - fm) : WGM;
    u.pm = fm + ((wgid % nig) % gsz); u.pn = (wgid % nig) / gsz; return true;
  }
};
template <class Epi>
__device__ __forceinline__ void gemm_phase(LAS unsigned char* lds, const Gemm g, const StaticOrder& S, const Epi& E) {
  int tid_ = threadIdx.x; asm volatile("" : "+v"(tid_));
  const int tid = tid_, wid = __builtin_amdgcn_readfirstlane(tid >> 6), lane = tid & 63, wr = wid >> 2, wc = wid & 3, fr = lane & 15, fq = lane >> 4;
  const int K = g.K, nt = K / BK, lda = g.lda;
  unsigned voffA[2], voffB[2];
#pragma unroll
  for (int i = 0; i < 2; ++i) { int R, C; stage_rc(tid * 16 + i * 8192, R, C); const int Rb = Epi::PERM ? ((R & ~31) + perm32(R & 31)) : R;
    voffA[i] = (unsigned)(R * lda + C) * 2u; voffB[i] = (unsigned)(Rb * K + C) * 2u; }
  const size_t kstep = (size_t)(BK * 2);
  const size_t hstepA = (size_t)HALF * lda * 2, hstepB = (size_t)HALF * K * 2;
  const size_t tstepA = 2 * hstepA, tstepB = 2 * hstepB;
  const unsigned ldsw = (unsigned)wid * 1024u;
  const int aoff = lds_byte(wr * 64 + fr, fq * 8), boff = lds_byte(wc * 32 + fr, fq * 8);
#define PG8_SA(b, h) (((b) * 2 + (h)) * HTB)
#define PG8_SB(b, h) ((4 + (b) * 2 + (h)) * HTB)
#define PG8_STAGE(bufoff, gbase, voff) do { _Pragma("unroll") for (int _i = 0; _i < 2; ++_i) \
    __builtin_amdgcn_global_load_lds((const unsigned*)((const char*)(gbase) + (voff)[_i]), (LAS unsigned*)(lds + (bufoff) + ldsw + _i * 8192), 16, 0, 0); } while (0)
#define PG8_LDA(dst, b, h) do { _Pragma("unroll") for (int m = 0; m < 4; ++m) _Pragma("unroll") for (int k = 0; k < 2; ++k) dst[m][k] = *(const LAS bf16x8*)(lds + PG8_SA(b, h) + aoff + m * 2048 + k * 1024); } while (0)
#define PG8_LDB(dst, b, h) do { _Pragma("unroll") for (int n = 0; n < 2; ++n) _Pragma("unroll") for (int k = 0; k < 2; ++k) dst[n][k] = *(const LAS bf16x8*)(lds + PG8_SB(b, h) + boff + n * 2048 + k * 1024); } while (0)
#define PG8_MMA(ai, bj, At, Bt) do { __builtin_amdgcn_s_setprio(1); _Pragma("unroll") for (int m = 0; m < 4; ++m) _Pragma("unroll") for (int n = 0; n < 2; ++n) _Pragma("unroll") for (int k = 0; k < 2; ++k) \
    acc[ai][bj][m][n] = __builtin_amdgcn_mfma_f32_16x16x32_bf16(Bt[n][k], At[m][k], acc[ai][bj][m][n], 0, 0, 0); __builtin_amdgcn_s_setprio(0); } while (0)
#define PG8_WAIT_V(n) asm volatile("s_waitcnt vmcnt(" #n ")" ::: "memory")
#define PG8_WAIT_L(n) asm volatile("s_waitcnt lgkmcnt(" #n ")" ::: "memory")
#define PG8_BAR __builtin_amdgcn_s_barrier()
#define PG8_SCHED __builtin_amdgcn_sched_barrier(0)
  Unit cur, nxt; int ui = 0;
  if (!S.next(0, cur)) return;
  f32x4 acc[2][2][4][2];
#pragma unroll
  for (int a = 0; a < 2; ++a)
#pragma unroll
    for (int b = 0; b < 2; ++b)
#pragma unroll
      for (int m = 0; m < 4; ++m)
#pragma unroll
        for (int n = 0; n < 2; ++n) acc[a][b][m][n] = (f32x4){0.f, 0.f, 0.f, 0.f};
  bf16x8 At[4][2], B0[2][2], B1[2][2];
  const char* cA = (const char*)g.A + (size_t)cur.pm * tstepA; const char* cB = (const char*)g.Bt + (size_t)cur.pn * tstepB;
  PG8_STAGE(PG8_SB(0, 0), cB, voffB); PG8_STAGE(PG8_SB(0, 1), cB + hstepB, voffB); PG8_STAGE(PG8_SA(0, 0), cA, voffA); PG8_STAGE(PG8_SA(0, 1), cA + hstepA, voffA);
  if (wr == 1) PG8_BAR;
  PG8_WAIT_V(2); PG8_BAR;
  PG8_STAGE(PG8_SB(1, 0), cB + kstep, voffB); PG8_STAGE(PG8_SA(1, 0), cA + kstep, voffA); PG8_STAGE(PG8_SB(1, 1), cB + hstepB + kstep, voffB);
  PG8_WAIT_V(6); PG8_BAR;
  for (;;) {
    const bool has_next = S.next(ui + 1, nxt);
    const char* nA = has_next ? (const char*)g.A + (size_t)nxt.pm * tstepA : cA; const char* nB = has_next ? (const char*)g.Bt + (size_t)nxt.pn * tstepB : cB;
    for (int t = 0; t < nt; t += 2) {
      const bool last = (t == nt - 2);
      const char* a1 = cA + (size_t)(t + 1) * kstep;
      const char* a2 = last ? nA : cA + (size_t)(t + 2) * kstep; const char* b2 = last ? nB : cB + (size_t)(t + 2) * kstep;
      const char* a3 = a2 + kstep; const char* b3 = b2 + kstep;
      if constexpr (Epi::MIDK) { if (t == (nt >> 1)) E.mid(acc, cur, wr, fr); }
      PG8_LDB(B0, 0, 0); PG8_LDB(B1, 0, 1); PG8_SCHED; PG8_LDA(At, 0, 0); PG8_STAGE(PG8_SA(1, 1), a1 + hstepA, voffA);
      PG8_WAIT_V(8); PG8_WAIT_L(0); PG8_BAR; PG8_MMA(0, 0, At, B0); PG8_MMA(0, 1, At, B1); PG8_BAR; PG8_SCHED;
      PG8_LDA(At, 0, 1); PG8_STAGE(PG8_SB(0, 0), b2, voffB); PG8_STAGE(PG8_SB(0, 1), b2 + hstepB, voffB); PG8_STAGE(PG8_SA(0, 0), a2, voffA);
      PG8_WAIT_V(8); PG8_WAIT_L(0); PG8_BAR; PG8_MMA(1, 0, At, B0); PG8_MMA(1, 1, At, B1); PG8_BAR; PG8_SCHED;
      PG8_LDB(B0, 1, 0); PG8_LDB(B1, 1, 1); PG8_SCHED; PG8_LDA(At, 1, 0); PG8_STAGE(PG8_SA(0, 1), a2 + hstepA, voffA);
      PG8_WAIT_V(8); PG8_WAIT_L(0); PG8_BAR; PG8_MMA(0, 0, At, B0); PG8_MMA(0, 1, At, B1); PG8_BAR; PG8_SCHED;
      PG8_LDA(At, 1, 1); PG8_STAGE(PG8_SB(1, 0), b3, voffB); PG8_STAGE(PG8_SB(1, 1), b3 + hstepB, voffB); PG8_STAGE(PG8_SA(1, 0), a3, voffA);
      PG8_WAIT_V(8); PG8_WAIT_L(0); PG8_BAR; PG8_MMA(1, 0, At, B0); PG8_MMA(1, 1, At, B1); PG8_BAR; PG8_SCHED;
    }
    if (wr == 0) PG8_BAR;
    E(acc, cur, wr, wc, fr, fq);
    if (!has_next) break;
#pragma unroll
    for (int a = 0; a < 2; ++a)
#pragma unroll
      for (int b = 0; b < 2; ++b)
#pragma unroll
        for (int m = 0; m < 4; ++m)
#pragma unroll
          for (int n = 0; n < 2; ++n) acc[a][b][m][n] = (f32x4){0.f, 0.f, 0.f, 0.f};
    cur = nxt; cA = nA; cB = nB; ++ui;
    if (wr == 1) PG8_BAR;
  }
  PG8_WAIT_V(0);
  PG8_BAR;
#undef PG8_SA
#undef PG8_SB
#undef PG8_STAGE
#undef PG8_LDA
#undef PG8_LDB
#undef PG8_MMA
}

struct EpiU {
  static constexpr bool PERM = true, MIDK = false;
  bf16_t* U; const float* rs1; float* ssq_q; float* ssq_kv; float* ssq_pe;
  __device__ __forceinline__ void operator()(const f32x4 (&acc)[2][2][4][2], const Unit& u, int wr, int wc, int fr_, int fq_) const {
    int fr = fr_, fq = fq_; asm volatile("" : "+v"(fr), "+v"(fq));
    float* ssq = (u.pn < 2) ? ssq_q : (u.pn == 2 ? ssq_kv : (u.pn == 11 ? ssq_pe : (float*)nullptr));
    const int col0 = u.pn * BM + wc * 32 + 8 * fq;
#pragma unroll
    for (int ai = 0; ai < 2; ++ai)
#pragma unroll
      for (int m = 0; m < 4; ++m) {
        const int row = u.pm * BM + ai * HALF + wr * 64 + m * 16 + fr; const float s = rs1[row]; float q = 0.f;
        bf16_t* rowp = U + (size_t)row * LDU + col0;
#pragma unroll
        for (int bj = 0; bj < 2; ++bj) { const f32x4 v0 = acc[ai][bj][m][0] * s, v1 = acc[ai][bj][m][1] * s;
          q += (v0[0] * v0[0] + v0[1] * v0[1]) + (v0[2] * v0[2] + v0[3] * v0[3]) + (v1[0] * v1[0] + v1[1] * v1[1]) + (v1[2] * v1[2] + v1[3] * v1[3]);
          u32x4 w; w.x = cvt_pk_bf16(v0[0], v0[1]); w.y = cvt_pk_bf16(v0[2], v0[3]); w.z = cvt_pk_bf16(v1[0], v1[1]); w.w = cvt_pk_bf16(v1[2], v1[3]);
          *(u32x4*)(rowp + bj * HALF) = w; }
        if (ssq) { q += __shfl_xor(q, 16); q += __shfl_xor(q, 32); if (fq == 0) atomicAdd(ssq + row, q); }
      }
  }
};

struct EpiQ {
  static constexpr bool PERM = false, MIDK = false;
  bf16_t* Q; const float* ssq_q; const float* g_qn; const f32x2* rope; LAS float* xch;
  __device__ __forceinline__ void operator()(const f32x4 (&acc)[2][2][4][2], const Unit& u, int wr, int wc, int fr_, int fq_) const {
    int fr = fr_, fq = fq_; asm volatile("" : "+v"(fr), "+v"(fq));
    float rsq[2][4];
#pragma unroll
    for (int ai = 0; ai < 2; ++ai)
#pragma unroll
      for (int m = 0; m < 4; ++m) {
        const int rl = ai * HALF + wr * 64 + m * 16 + fr; const int row = u.pm * BM + rl;
        const float s = __builtin_amdgcn_rsqf(ssq_q[row] * (1.0f / 512.0f) + EPS); rsq[ai][m] = s; float q = 0.f;
#pragma unroll
        for (int bj = 0; bj < 2; ++bj)
#pragma unroll
          for (int n = 0; n < 2; ++n) { const f32x4 v = acc[ai][bj][m][n] * s; q += (v[0] * v[0] + v[1] * v[1]) + (v[2] * v[2] + v[3] * v[3]); }
        q += __shfl_xor(q, 16); q += __shfl_xor(q, 32);
        if (fq == 0) xch[rl * 4 + wc] = q;
      }
    asm volatile("s_waitcnt lgkmcnt(0)" ::: "memory"); __builtin_amdgcn_s_barrier(); asm volatile("" ::: "memory");
    const int h = u.pn;
#pragma unroll
    for (int ai = 0; ai < 2; ++ai)
#pragma unroll
      for (int m = 0; m < 4; ++m) {
        const int rl = ai * HALF + wr * 64 + m * 16 + fr; const int row = u.pm * BM + rl;
        const f32x4 pq = *(const LAS f32x4*)(xch + rl * 4);
        const float tot = (pq[0] + pq[1]) + (pq[2] + pq[3]);
        const float sc = rsq[ai][m] * __builtin_amdgcn_rsqf(tot * (1.0f / 192.0f) + EPS) * 0.10411754627697264f;
        bf16_t* qrow = Q + (plane_row(row, h)) * DK;
        if (wc == 3) {
          const int s = seq_pos(row);
#pragma unroll
          for (int n = 0; n < 2; ++n) { const int i0 = 16 * n + 4 * fq;
            const f32x4 g1 = *(const f32x4*)(g_qn + 128 + i0), g2 = *(const f32x4*)(g_qn + 160 + i0);
            const f32x4 x1 = acc[ai][0][m][n] * sc * g1, x2 = acc[ai][1][m][n] * sc * g2; float o1[4], o2[4];
#pragma unroll
            for (int j = 0; j < 4; ++j) { const f32x2 cs = rope[(size_t)s * 32 + i0 + j]; o1[j] = x1[j] * cs.x - x2[j] * cs.y; o2[j] = x2[j] * cs.x + x1[j] * cs.y; }
            u32x2 w1, w2; w1.x = cvt_pk_bf16(o1[0], o1[1]); w1.y = cvt_pk_bf16(o1[2], o1[3]); w2.x = cvt_pk_bf16(o2[0], o2[1]); w2.y = cvt_pk_bf16(o2[2], o2[3]);
            *(u32x2*)(qrow + 128 + i0) = w1; *(u32x2*)(qrow + 160 + i0) = w2; }
        } else {
#pragma unroll
          for (int n = 0; n < 2; ++n) { const int d = 32 * wc + 16 * n + 4 * fq;
            const f32x4 gg = *(const f32x4*)(g_qn + d); const f32x4 v = acc[ai][0][m][n] * sc * gg;
            u32x2 w; w.x = cvt_pk_bf16(v[0], v[1]); w.y = cvt_pk_bf16(v[2], v[3]); *(u32x2*)(qrow + d) = w; }
          if (wc == 0) {
#pragma unroll
            for (int n = 0; n < 2; ++n) { const int d = 96 + 16 * n + 4 * fq;
              const f32x4 gg = *(const f32x4*)(g_qn + d); const f32x4 v = acc[ai][1][m][n] * sc * gg;
              u32x2 w; w.x = cvt_pk_bf16(v[0], v[1]); w.y = cvt_pk_bf16(v[2], v[3]); *(u32x2*)(qrow + d) = w; }
          }
        }
      }
  }
};

struct EpiKV {
  static constexpr bool PERM = false, MIDK = false;
  bf16_t* Kt; bf16_t* Vt; const bf16_t* U; const float* ssq_kv; const float* ssq_pe; const float* g_kn; const f32x2* rope; LAS float* xch;
  __device__ __forceinline__ void operator()(const f32x4 (&acc)[2][2][4][2], const Unit& u, int wr, int wc, int fr_, int fq_) const {
    int fr = fr_, fq = fq_; asm volatile("" : "+v"(fr), "+v"(fq));
    float rsq[2][4];
#pragma unroll
    for (int ai = 0; ai < 2; ++ai)
#pragma unroll
      for (int m = 0; m < 4; ++m) {
        const int rl = ai * HALF + wr * 64 + m * 16 + fr; const int row = u.pm * BM + rl;
        const float s = __builtin_amdgcn_rsqf(ssq_kv[row] * (1.0f / 256.0f) + EPS); rsq[ai][m] = s; float q = 0.f;
#pragma unroll
        for (int n = 0; n < 2; ++n) { const f32x4 v = acc[ai][0][m][n] * s; q += (v[0] * v[0] + v[1] * v[1]) + (v[2] * v[2] + v[3] * v[3]); }
        q += __shfl_xor(q, 16); q += __shfl_xor(q, 32);
        if (fq == 0) xch[rl * 4 + wc] = q;
      }
    asm volatile("s_waitcnt lgkmcnt(0)" ::: "memory"); __builtin_amdgcn_s_barrier(); asm volatile("" ::: "memory");
    const int h = u.pn;
#pragma unroll
    for (int ai = 0; ai < 2; ++ai)
#pragma unroll
      for (int m = 0; m < 4; ++m) {
        const int rl = ai * HALF + wr * 64 + m * 16 + fr; const int row = u.pm * BM + rl;
        const f32x4 pq = *(const LAS f32x4*)(xch + rl * 4);
        const float tot = (pq[0] + pq[1]) + (pq[2] + pq[3]) + ssq_pe[row];
        const float rstd = __builtin_amdgcn_rsqf(tot * (1.0f / 192.0f) + EPS);
        const float sc = rsq[ai][m] * rstd;
        const size_t pr = plane_row(row, h);
        bf16_t* krow = Kt + pr * DK; bf16_t* vrow = Vt + pr * DV;
#pragma unroll
        for (int n = 0; n < 2; ++n) { const int d = 32 * wc + 16 * n + 4 * fq;
          const f32x4 gg = *(const f32x4*)(g_kn + d); const f32x4 kv = acc[ai][0][m][n] * sc * gg; const f32x4 vv = acc[ai][1][m][n] * rsq[ai][m];
          u32x2 w; w.x = cvt_pk_bf16(kv[0], kv[1]); w.y = cvt_pk_bf16(kv[2], kv[3]); *(u32x2*)(krow + d) = w;
          u32x2 wv; wv.x = cvt_pk_bf16(vv[0], vv[1]); wv.y = cvt_pk_bf16(vv[2], vv[3]); *(u32x2*)(vrow + d) = wv; }
        { const int i0 = 8 * wc + 2 * fq; const int s = seq_pos(row);
          const unsigned p1 = *(const unsigned*)(U + (size_t)row * LDU + UC_PE + i0), p2 = *(const unsigned*)(U + (size_t)row * LDU + UC_PE + 32 + i0);
          const float x1a = bflo(p1) * rstd * g_kn[128 + i0], x1b = bfhi(p1) * rstd * g_kn[128 + i0 + 1];
          const float x2a = bflo(p2) * rstd * g_kn[160 + i0], x2b = bfhi(p2) * rstd * g_kn[160 + i0 + 1];
          const f32x2 ca = rope[(size_t)s * 32 + i0], cb = rope[(size_t)s * 32 + i0 + 1];
          *(unsigned*)(krow + 128 + i0) = cvt_pk_bf16(x1a * ca.x - x2a * ca.y, x1b * cb.x - x2b * cb.y);
          *(unsigned*)(krow + 160 + i0) = cvt_pk_bf16(x2a * ca.x + x1a * ca.y, x2b * cb.x + x1b * cb.y); }
        asm volatile("" ::: "memory");
      }
  }
};

struct EpiOut {
  static constexpr bool PERM = false, MIDK = true;
  const float* xp; const float* xs; float* out; bf16_t* x1b; const float* ssq_a; const float* ssq_l; float* ssq2;
  __device__ __forceinline__ void mid(f32x4 (&acc)[2][2][4][2], const Unit& u, int wr, int fr_) const {
    int fr = fr_; asm volatile("" : "+v"(fr));
#pragma unroll
    for (int ai = 0; ai < 2; ++ai)
#pragma unroll
      for (int m = 0; m < 4; ++m) { const int row = u.pm * BM + ai * HALF + wr * 64 + m * 16 + fr;
        const float sa = __builtin_amdgcn_rsqf(ssq_a[row] * (1.0f / 1024.0f) + EPS), sl = __builtin_amdgcn_rsqf(ssq_l[row] * (1.0f / 1024.0f) + EPS);
        const float ratio = sa / sl;
#pragma unroll
        for (int bj = 0; bj < 2; ++bj)
#pragma unroll
          for (int n = 0; n < 2; ++n) acc[ai][bj][m][n] *= ratio; }
  }
  __device__ __forceinline__ void operator()(const f32x4 (&acc)[2][2][4][2], const Unit& u, int wr, int wc, int fr_, int fq_) const {
    int fr = fr_, fq = fq_; asm volatile("" : "+v"(fr), "+v"(fq));
    const int col0 = u.pn * BM + wc * 32 + 4 * fq;
#pragma unroll
    for (int ai = 0; ai < 2; ++ai)
#pragma unroll
      for (int m = 0; m < 4; ++m) { const int row = u.pm * BM + ai * HALF + wr * 64 + m * 16 + fr;
        const float sl = __builtin_amdgcn_rsqf(ssq_l[row] * (1.0f / 1024.0f) + EPS);
        const float* xrow = (row < MP) ? xp + (size_t)row * DM : xs + (size_t)(row - MP) * DM; float q = 0.f;
#pragma unroll
        for (int bj = 0; bj < 2; ++bj)
#pragma unroll
          for (int n = 0; n < 2; ++n) { const int c = col0 + bj * HALF + n * 16;
            const f32x4 xv = *(const f32x4*)(xrow + c); const f32x4 o = xv + acc[ai][bj][m][n] * sl;
            *(f32x4*)(out + (size_t)row * DM + c) = o; q += (o[0] * o[0] + o[1] * o[1]) + (o[2] * o[2] + o[3] * o[3]);
            u32x2 w; w.x = cvt_pk_bf16(o[0], o[1]); w.y = cvt_pk_bf16(o[2], o[3]); *(u32x2*)(x1b + (size_t)row * DM + c) = w; }
        q += __shfl_xor(q, 16); q += __shfl_xor(q, 32); if (fq == 0) atomicAdd(ssq2 + row, q); }
  }
};

struct EpiGU {
  static constexpr bool PERM = true, MIDK = false;
  bf16_t* act; const float* ssq2;
  __device__ __forceinline__ void operator()(const f32x4 (&acc)[2][2][4][2], const Unit& u, int wr, int wc, int fr_, int fq_) const {
    int fr = fr_, fq = fq_; asm volatile("" : "+v"(fr), "+v"(fq));
    const int col0 = u.pn * HALF + wc * 32 + 8 * fq;
#pragma unroll
    for (int ai = 0; ai < 2; ++ai)
#pragma unroll
      for (int m = 0; m < 4; ++m) { const int row = u.pm * BM + ai * HALF + wr * 64 + m * 16 + fr;
        const float rs = __builtin_amdgcn_rsqf(ssq2[row] * (1.0f / 2048.0f) + EPS);
        float r[8];
#pragma unroll
        for (int n = 0; n < 2; ++n)
#pragma unroll
          for (int j = 0; j < 4; ++j) { const float gv = acc[ai][0][m][n][j] * rs, uv = acc[ai][1][m][n][j] * rs; r[n * 4 + j] = gv * sigmoidf_(gv) * uv; }
        u32x4 w; w.x = cvt_pk_bf16(r[0], r[1]); w.y = cvt_pk_bf16(r[2], r[3]); w.z = cvt_pk_bf16(r[4], r[5]); w.w = cvt_pk_bf16(r[6], r[7]);
        *(u32x4*)(act + (size_t)row * DFF + col0) = w; }
  }
};

struct EpiDown {
  static constexpr bool PERM = false, MIDK = false;
  float* out;
  __device__ __forceinline__ void operator()(const f32x4 (&acc)[2][2][4][2], const Unit& u, int wr, int wc, int fr_, int fq_) const {
    int fr = fr_, fq = fq_; asm volatile("" : "+v"(fr), "+v"(fq));
    const int col0 = u.pn * BM + wc * 32 + 4 * fq;
#pragma unroll
    for (int ai = 0; ai < 2; ++ai)
#pragma unroll
      for (int m = 0; m < 4; ++m) { const int row = u.pm * BM + ai * HALF + wr * 64 + m * 16 + fr;
#pragma unroll
        for (int bj = 0; bj < 2; ++bj)
#pragma unroll
          for (int n = 0; n < 2; ++n) { float* p = out + (size_t)row * DM + col0 + bj * HALF + n * 16; const f32x4 xv = *(const f32x4*)p; *(f32x4*)p = xv + acc[ai][bj][m][n]; } }
  }
};
}

namespace att {
constexpr int NW = 8, QBLK = 32, KVBLK = 64;
constexpr float QSCALE = 0.10411754627697264f;
constexpr int KROWB = 400;
constexpr int SHM_V = KVBLK * DV * 2, SHM_K = KVBLK * KROWB;
constexpr int QRP = 144;
constexpr int SHM_WS = 3 * SHM_V + 2 * SHM_K, SHM_QR = SHM_WS + NW * 64 * 4, SHM_ATTN = SHM_QR + NW * 32 * QRP;
static_assert(SHM_ATTN <= LDS_BYTES, "attention LDS");
#define SBAR() __builtin_amdgcn_sched_barrier(0)
#define SGB(mask, n) __builtin_amdgcn_sched_group_barrier(mask, n, 0)
__device__ __forceinline__ void sched_qk_sm() {
  SGB(0x100, 4);
#pragma unroll
  for (int i = 0; i < 10; ++i) { SGB(0x008, 2); SGB(0x100, 2); SGB(0x402, 8); }
#pragma unroll
  for (int i = 0; i < 2; ++i) { SGB(0x008, 2); SGB(0x402, 8); }
}
typedef __bf16 bf16x2_t __attribute__((ext_vector_type(2)));
__device__ __forceinline__ unsigned cvtpk_s(float lo, float hi) { f32x2 v = {lo, hi}; bf16x2_t b = __builtin_convertvector(v, bf16x2_t); return __builtin_bit_cast(unsigned, b); }
__device__ __forceinline__ void expA(f32x16& p0) {
#pragma unroll
  for (int r = 0; r < 16; ++r) p0[r] = __builtin_amdgcn_exp2f(p0[r]);
}
__device__ __forceinline__ void finishSM(f32x16& p0, f32x16& p1, float& l_reg, bf16x8& pa0, bf16x8& pa1, bf16x8& pa2, bf16x8& pa3) {
#pragma unroll
  for (int r = 0; r < 16; ++r) p1[r] = __builtin_amdgcn_exp2f(p1[r]);
  float ps = 0;
#pragma unroll
  for (int r = 0; r < 16; ++r) ps += p0[r];
#pragma unroll
  for (int r = 0; r < 16; ++r) ps += p1[r];
  l_reg += ps;
#define PK4(P, BASE, OUT) do { unsigned a0 = cvtpk_s(P[BASE + 0], P[BASE + 1]), a1 = cvtpk_s(P[BASE + 2], P[BASE + 3]);   \
    unsigned b0 = cvtpk_s(P[BASE + 4], P[BASE + 5]), b1 = cvtpk_s(P[BASE + 6], P[BASE + 7]);                              \
    auto r0 = __builtin_amdgcn_permlane32_swap(a0, b0, false, false); auto r1 = __builtin_amdgcn_permlane32_swap(a1, b1, false, false); \
    u32x4 w = {r0[0], r1[0], r0[1], r1[1]}; OUT = *reinterpret_cast<bf16x8*>(&w); } while (0)
  PK4(p0, 0, pa0); PK4(p0, 8, pa1); PK4(p1, 0, pa2); PK4(p1, 8, pa3);
#undef PK4
}
__device__ __forceinline__ void qkt(f32x16& p0, f32x16& p1, const char* Ks, const bf16x8* qr, const char* qrl, const f32x16& negm, int r32, int hi) {
  p0 = negm; p1 = negm;
#pragma unroll
  for (int d0 = 0; d0 < 12; ++d0) { const int cb = (d0 * 16 + hi * 8) * 2;
    const bf16x8 b0 = *reinterpret_cast<const bf16x8*>(Ks + r32 * KROWB + cb);
    const bf16x8 b1 = *reinterpret_cast<const bf16x8*>(Ks + (32 + r32) * KROWB + cb);
    const bf16x8 qf = qr[d0];
    p0 = __builtin_amdgcn_mfma_f32_32x32x16_bf16(b0, qf, p0, 0, 0, 0);
    p1 = __builtin_amdgcn_mfma_f32_32x32x16_bf16(b1, qf, p1, 0, 0, 0); }
}
__device__ __forceinline__ int v_st(int k, int c) { const int kk = (k & ~0xC) | ((k & 4) << 1) | ((k & 8) >> 1); return ((kk >> 3) * 4 + (c >> 5)) * 512 + ((kk & 7) * 32 + (c & 31)) * 2; }
__device__ __forceinline__ int v_rd_base(int lane) { return ((lane & 3) << 3) | (((lane >> 2) & 3) << 6) | (((lane >> 4) & 1) << 5) | (((lane >> 5) & 1) << 8); }
constexpr int v_rd_off(int d0, int ks, int half) { return d0 * 512 + ks * 4096 + half * 2048; }
template <int OFF> __device__ __forceinline__ s16x4 tr_read(int vb) {
  s16x4 r; asm volatile("ds_read_b64_tr_b16 %0, %1 offset:%2" : "=&v"(r) : "v"(vb), "i"(OFF) : "memory"); return r;
}
template <int D0> __device__ __forceinline__ void pv_one(f32x16& od, int vb, bf16x8 pa0, bf16x8 pa1, bf16x8 pa2, bf16x8 pa3) {
  const s16x4 l0 = tr_read<v_rd_off(D0, 0, 0)>(vb), h0 = tr_read<v_rd_off(D0, 0, 1)>(vb), l1 = tr_read<v_rd_off(D0, 1, 0)>(vb), h1 = tr_read<v_rd_off(D0, 1, 1)>(vb);
  const s16x4 l2 = tr_read<v_rd_off(D0, 2, 0)>(vb), h2 = tr_read<v_rd_off(D0, 2, 1)>(vb), l3 = tr_read<v_rd_off(D0, 3, 0)>(vb), h3 = tr_read<v_rd_off(D0, 3, 1)>(vb);
  asm volatile("s_waitcnt lgkmcnt(0)" ::: "memory"); SBAR();
#define PK(L, H) (bf16x8){L[0], L[1], L[2], L[3], H[0], H[1], H[2], H[3]}
  od = __builtin_amdgcn_mfma_f32_32x32x16_bf16(pa0, PK(l0, h0), od, 0, 0, 0);
  od = __builtin_amdgcn_mfma_f32_32x32x16_bf16(pa1, PK(l1, h1), od, 0, 0, 0);
  od = __builtin_amdgcn_mfma_f32_32x32x16_bf16(pa2, PK(l2, h2), od, 0, 0, 0);
  od = __builtin_amdgcn_mfma_f32_32x32x16_bf16(pa3, PK(l3, h3), od, 0, 0, 0);
#undef PK
}
__device__ __forceinline__ void pv_d0(f32x16* o, int vb, bf16x8 pa0, bf16x8 pa1, bf16x8 pa2, bf16x8 pa3) {
  pv_one<0>(o[0], vb, pa0, pa1, pa2, pa3); pv_one<1>(o[1], vb, pa0, pa1, pa2, pa3); pv_one<2>(o[2], vb, pa0, pa1, pa2, pa3); pv_one<3>(o[3], vb, pa0, pa1, pa2, pa3);
}
__device__ __forceinline__ void attn_unit(const bf16_t* __restrict__ Qb, const bf16_t* __restrict__ Kh, const bf16_t* __restrict__ Vh, bf16_t* __restrict__ Ob, float* __restrict__ ssq, int seq, float kbound, char* lds, LAS unsigned char* ldsl) {
  int tid_ = threadIdx.x; asm volatile("" : "+v"(tid_));
  const int tid = tid_, wid = tid >> 6, lane = tid & 63, r32 = lane & 31, hi = lane >> 5;
  char* V_lds = lds; char* K_lds = lds + 3 * SHM_V;
  float* ws = (float*)(lds + SHM_WS) + wid * 64; float* li_l = ws;
  float l_reg = 0; f32x16 o[4] = {}; bf16x8 qr[12];
  const bf16_t* Qw = Qb + (size_t)(wid * QBLK + r32) * DK + hi * 8;
  float qss = 0.f;
#pragma unroll
  for (int d0 = 0; d0 < 8; ++d0) { qr[d0] = *reinterpret_cast<const bf16x8*>(Qw + d0 * 16);
#pragma unroll
    for (int e = 0; e < 8; ++e) { const float v = bf2f((bf16_t)qr[d0][e]); qss += v * v; } }
  const char* qrl = nullptr;
#pragma unroll
  for (int d0 = 8; d0 < 12; ++d0) { const bf16x8 qv = *reinterpret_cast<const bf16x8*>(Qw + d0 * 16); qr[d0] = qv;
#pragma unroll
    for (int e = 0; e < 8; ++e) { const float v = bf2f((bf16_t)qv[e]); qss += v * v; } }
  { auto rr = __builtin_amdgcn_permlane32_swap(__float_as_uint(qss), __float_as_uint(qss), false, false); qss = __uint_as_float(rr[0]) + __uint_as_float(rr[1]); }
  f32x16 negm; { const float nm = -__builtin_amdgcn_sqrtf(qss) * kbound;
#pragma unroll
    for (int r = 0; r < 16; ++r) negm[r] = nm; }
  asm volatile("" : "+v"(negm));
  const int vb0 = (int)(uintptr_t)V_lds + v_rd_base(lane);
  const int uw = __builtin_amdgcn_readfirstlane(wid);
  unsigned koff[4], voff[2];
#pragma unroll
  for (int i = 0; i < 4; ++i) { const int c = (uw + 8 * i) * 64 + lane, row = c / 25, cc = c - row * 25; koff[i] = (unsigned)(row * 384 + (cc < 24 ? cc : 23) * 16); }
#pragma unroll
  for (int i = 0; i < 2; ++i) { const int P = (uw + 8 * i) * 64 + lane, sub = P >> 5, within = P & 31, kk = (sub >> 2) * 8 + (within >> 2), c = (sub & 3) * 32 + (within & 3) * 8;
    const int k = (kk & ~0xC) | ((kk & 4) << 1) | ((kk & 8) >> 1); voff[i] = (unsigned)(k * 256 + c * 2); }
  LAS unsigned char* Vl = ldsl; LAS unsigned char* Kl = ldsl + 3 * SHM_V;
#define DMA_TILE(t, kbuf, vbuf) do { const char* kt_ = (const char*)Kh + (size_t)(t) * (KVBLK * DK * 2); const char* vt_ = (const char*)Vh + (size_t)(t) * (KVBLK * DV * 2); \
    unsigned k0_ = koff[0], k1_ = koff[1], k2_ = koff[2], k3_ = koff[3], v0_ = voff[0], v1_ = voff[1]; \
    asm volatile("" : "+v"(k0_), "+v"(k1_), "+v"(k2_), "+v"(k3_), "+v"(v0_), "+v"(v1_));     \
    __builtin_amdgcn_global_load_lds((const unsigned*)(kt_ + k0_), (LAS unsigned*)(Kl + (kbuf) * SHM_K + (uw + 0) * 1024), 16, 0, 0); \
    __builtin_amdgcn_global_load_lds((const unsigned*)(kt_ + k1_), (LAS unsigned*)(Kl + (kbuf) * SHM_K + (uw + 8) * 1024), 16, 0, 0); \
    __builtin_amdgcn_global_load_lds((const unsigned*)(kt_ + k2_), (LAS unsigned*)(Kl + (kbuf) * SHM_K + (uw + 16) * 1024), 16, 0, 0); \
    if (uw == 0) __builtin_amdgcn_global_load_lds((const unsigned*)(kt_ + k3_), (LAS unsigned*)(Kl + (kbuf) * SHM_K + 24 * 1024), 16, 0, 0); \
    __builtin_amdgcn_global_load_lds((const unsigned*)(vt_ + v0_), (LAS unsigned*)(Vl + (vbuf) * SHM_V + (uw + 0) * 1024), 16, 0, 0); \
    __builtin_amdgcn_global_load_lds((const unsigned*)(vt_ + v1_), (LAS unsigned*)(Vl + (vbuf) * SHM_V + (uw + 8) * 1024), 16, 0, 0); } while (0)
#define DMA_SYNC() do { asm volatile("s_waitcnt vmcnt(0)" ::: "memory"); __syncthreads(); } while (0)
  f32x16 pA0, pA1, pB0, pB1; bf16x8 pa0, pa1, pa2, pa3; const int NT = seq / KVBLK;
  int ip = 2, ic = 0, in = 1;
#define ROT() do { const int t_ = ip; ip = ic; ic = in; in = t_; } while (0)
  DMA_TILE(0, 0, 0); DMA_SYNC();
  DMA_TILE(1, 1, in); SBAR();
  qkt(pA0, pA1, K_lds, qr, qrl, negm, r32, hi); expA(pA0);
  DMA_SYNC(); ROT();
  for (int j = 1; j + 1 < NT; j += 2) {
    DMA_TILE(j + 1, 0, in); SBAR();
    qkt(pB0, pB1, K_lds + SHM_K, qr, qrl, negm, r32, hi);
    finishSM(pA0, pA1, l_reg, pa0, pa1, pa2, pa3); sched_qk_sm(); SBAR();
    pv_d0(o, vb0 + ip * SHM_V, pa0, pa1, pa2, pa3); expA(pB0);
    DMA_SYNC(); ROT();
    DMA_TILE(j + 2, 1, in); SBAR();
    qkt(pA0, pA1, K_lds, qr, qrl, negm, r32, hi);
    finishSM(pB0, pB1, l_reg, pa0, pa1, pa2, pa3); sched_qk_sm(); SBAR();
    pv_d0(o, vb0 + ip * SHM_V, pa0, pa1, pa2, pa3); expA(pA0);
    DMA_SYNC(); ROT();
  }
  SBAR(); qkt(pB0, pB1, K_lds + SHM_K, qr, qrl, negm, r32, hi);
  finishSM(pA0, pA1, l_reg, pa0, pa1, pa2, pa3); SBAR();
  pv_d0(o, vb0 + ip * SHM_V, pa0, pa1, pa2, pa3); expA(pB0);
  finishSM(pB0, pB1, l_reg, pa0, pa1, pa2, pa3); SBAR();
  pv_d0(o, vb0 + ic * SHM_V, pa0, pa1, pa2, pa3);
#undef ROT
#undef DMA_TILE
#undef DMA_SYNC
  { auto rr = __builtin_amdgcn_permlane32_swap(__float_as_uint(l_reg), __float_as_uint(l_reg), false, false); l_reg = __uint_as_float(rr[0]) + __uint_as_float(rr[1]); }
  if (hi == 0) li_l[r32] = l_reg; asm volatile("s_waitcnt lgkmcnt(0)" ::: "memory");
  int lane_e = lane; asm volatile("" : "+v"(lane_e));
  const int r32e = lane_e & 31, hie = lane_e >> 5;
  float rli[16];
#pragma unroll
  for (int r = 0; r < 16; ++r) rli[r] = __builtin_amdgcn_rcpf(li_l[crow(r, hie)]);
  __syncthreads();
  bf16_t* stg = (bf16_t*)(lds + wid * 8192);
#pragma unroll
  for (int r = 0; r < 16; ++r) { const int orow = crow(r, hie);
#pragma unroll
    for (int d0 = 0; d0 < 4; ++d0) { const float v = o[d0][r] * rli[r]; stg[orow * 128 + d0 * 32 + r32e] = (bf16_t)(cvt_pk_bf16(v, v) & 0xffffu); } }
  asm volatile("s_waitcnt lgkmcnt(0)" ::: "memory");
#pragma unroll
  for (int i = 0; i < 8; ++i) { const int row = i * 4 + (lane_e >> 4), ch = lane_e & 15;
    const u32x4 v = *(const u32x4*)(stg + row * 128 + ch * 8);
    *(u32x4*)(Ob + (size_t)(wid * QBLK + row) * DM + ch * 8) = v;
    float q = bflo(v.x) * bflo(v.x) + bfhi(v.x) * bfhi(v.x) + bflo(v.y) * bflo(v.y) + bfhi(v.y) * bfhi(v.y) + bflo(v.z) * bflo(v.z) + bfhi(v.z) * bfhi(v.z) + bflo(v.w) * bflo(v.w) + bfhi(v.w) * bfhi(v.w);
    q += shflx(q, lane_e, 1); q += shflx(q, lane_e, 2); q += shflx(q, lane_e, 4); q += shflx(q, lane_e, 8);
    if (ch == 0) atomicAdd(ssq + wid * QBLK + row, q); }
  __syncthreads();
}
#undef SBAR
}

namespace lru {
constexpr int XROW = 136;
constexpr int X_BYTES = 256 * XROW * 2;
constexpr int COMP_OFF = X_BYTES, COMP_BYTES = 4 * 2 * 8 * 32 * 8;
constexpr int CARRY_OFF = COMP_OFF + COMP_BYTES;
constexpr int PRM_OFF = CARRY_OFF + 1024 + 32768;
constexpr int WB_OFF = CARRY_OFF + 1024;
template <bool REV> __device__ __forceinline__ void seg_comp(const float (&a)[16], const float (&bx)[16], float (&A)[4], float (&B)[4]) {
#pragma unroll
  for (int q = 0; q < 4; ++q) { float Aq = 1.f, Bq = 0.f;
#pragma unroll
    for (int ee = 0; ee < 4; ++ee) { const int e = REV ? 3 - ee : ee; const int r = 4 * q + e; Bq = a[r] * Bq + bx[r]; Aq *= a[r]; }
    A[q] = Aq; B[q] = Bq; }
}
template <bool REV> __device__ __forceinline__ float seg_prefix(const float (&loA)[4], const float (&loB)[4], const float (&hiA)[4], const float (&hiB)[4], int hi, float st, float (&start)[4]) {
#pragma unroll
  for (int qq = 0; qq < 4; ++qq) { const int q = REV ? 3 - qq : qq;
    if (!REV) { const float t1 = loA[q] * st + loB[q]; start[q] = hi ? t1 : st; st = hiA[q] * t1 + hiB[q]; }
    else { const float t1 = hiA[q] * st + hiB[q]; start[q] = hi ? st : t1; st = loA[q] * t1 + loB[q]; } }
  return st;
}
template <int PASS>
__device__ __forceinline__ void unit(const Params& p, int chunk, int n, char* lds, float* ssq_l) {
  int tid_ = threadIdx.x; asm volatile("" : "+v"(tid_));
  const int tid = tid_, wid = __builtin_amdgcn_readfirstlane(tid >> 6), lane = tid & 63, j = lane & 31, hi = lane >> 5;
  const int row0 = chunk * 256;
  int seq_start, seq_len;
  if (row0 < MP) { seq_start = row0 & ~(SEQP - 1); seq_len = SEQP; } else { seq_start = MP + ((row0 - MP) & ~(SEQS - 1)); seq_len = SEQS; }
  const int cs = (row0 - seq_start) >> 8, nch = seq_len >> 8, cbase = seq_start >> 8;
  const bf16_t* U = (const bf16_t*)(p.ws + WS_U);
  bf16_t* X = (bf16_t*)lds;
  f32x2* comp = (f32x2*)(lds + COMP_OFF);
  float* carry = (float*)(lds + CARRY_OFF);
  f32x2* agg = (f32x2*)(p.ws + WS_AGG);
  const bf16_t* Wf = (const bf16_t*)(p.ws + WS_BRG) + (size_t)n * 4 * 4 * 8 * 64 * 8;
  char* WB = lds + WB_OFF;
#define WSRC(cg, d, wh) (Wf + ((size_t)(((2 * (d) + (wh)) * 4 + (cg)) * 8) * 64 + tid) * 8)
  bf16x8 sw0 = *(const bf16x8*)WSRC(0, 0, 0), sw1 = *(const bf16x8*)WSRC(0, 0, 1);
  { const int cg8 = (tid & 15) * 8, tg = tid >> 4; const int c0 = n * 128 + cg8;
    const float* cw = p.in[10]; const float* cb = p.in[11];
    float w[4][8], bb[8];
#pragma unroll
    for (int t = 0; t < 4; ++t) { const f32x4 a = *(const f32x4*)(cw + t * 1024 + c0), b = *(const f32x4*)(cw + t * 1024 + c0 + 4);
      w[t][0] = a[0]; w[t][1] = a[1]; w[t][2] = a[2]; w[t][3] = a[3]; w[t][4] = b[0]; w[t][5] = b[1]; w[t][6] = b[2]; w[t][7] = b[3]; }
    { const f32x4 a = *(const f32x4*)(cb + c0), b = *(const f32x4*)(cb + c0 + 4); bb[0] = a[0]; bb[1] = a[1]; bb[2] = a[2]; bb[3] = a[3]; bb[4] = b[0]; bb[5] = b[1]; bb[6] = b[2]; bb[7] = b[3]; }
    u32x4 rw[11];
#pragma unroll
    for (int rr = 0; rr < 11; ++rr) { const int grow = row0 + tg * 8 + rr - 1; const bool ok = (grow >= seq_start) && (grow < seq_start + seq_len);
      rw[rr] = ok ? *(const u32x4*)(U + (size_t)grow * LDU + UC_X + c0) : (u32x4){0u, 0u, 0u, 0u}; }
#pragma unroll
    for (int t = 0; t < 8; ++t) { float y[8];
#pragma unroll
      for (int c = 0; c < 8; ++c) y[c] = bb[c];
#pragma unroll
      for (int tp = 0; tp < 4; ++tp) { const u32x4 v = rw[t + tp];
        y[0] += w[tp][0] * bflo(v.x); y[1] += w[tp][1] * bfhi(v.x); y[2] += w[tp][2] * bflo(v.y); y[3] += w[tp][3] * bfhi(v.y);
        y[4] += w[tp][4] * bflo(v.z); y[5] += w[tp][5] * bfhi(v.z); y[6] += w[tp][6] * bflo(v.w); y[7] += w[tp][7] * bfhi(v.w); }
      u32x4 o; o.x = cvt_pk_bf16(y[0], y[1]); o.y = cvt_pk_bf16(y[2], y[3]); o.z = cvt_pk_bf16(y[4], y[5]); o.w = cvt_pk_bf16(y[6], y[7]);
      *(u32x4*)(X + (tg * 8 + t) * XROW + cg8) = o; }
  }
  if (PASS == 2 && tid < 256) { const int dir = tid >> 7, ch = tid & 127; float st = 0.f;
    const int cnt = dir ? nch - 1 - cs : cs;
    for (int k0 = 0; k0 < cnt; k0 += 16) { f32x2 ab[16];
#pragma unroll
      for (int i = 0; i < 16; ++i) { const int k = k0 + i; const bool ok = k < cnt; const int c = ok ? (dir ? nch - 1 - k : k) : cs;
        ab[i] = agg[(size_t)(dir * NCHUNK + cbase + c) * 1024 + n * 128 + ch]; if (!ok) ab[i] = (f32x2){1.f, 0.f}; }
#pragma unroll
      for (int i = 0; i < 16; ++i) st = ab[i].x * st + ab[i].y; }
    carry[dir * 128 + ch] = st; }
  *(bf16x8*)(WB + tid * 16) = sw0; *(bf16x8*)(WB + 8192 + tid * 16) = sw1;
  if (tid < 256) { const int dir = tid >> 7, ch = tid & 127;
    const float lm = p.in[16][dir * 1024 + n * 128 + ch];
    *(f32x4*)(lds + PRM_OFF + (dir * 128 + ch) * 16) = (f32x4){p.in[13][(dir * 8 + n) * 128 + ch], p.in[15][(dir * 8 + n) * 128 + ch], (8.0f * 1.4426950408889634f) * log1pf(__expf(-lm)), 0.f}; }
  __syncthreads();
  const float* lam = p.in[16];
  const bf16_t* Xw = X + (32 * wid + j) * XROW + 8 * hi;
  for (int cgp = 0; cgp < 4; ++cgp) {
    const int ch = 32 * cgp + j, gch = n * 128 + ch;
    float sum[16];
    bf16_t graw[16];
    if (PASS == 2) { int rb = row0 + 32 * wid + 4 * hi; asm volatile("" : "+v"(rb));
#pragma unroll
      for (int r = 0; r < 16; ++r) graw[r] = U[(size_t)(rb + (r & 3) + 8 * (r >> 2)) * LDU + UC_G + gch];
    }
#pragma unroll
    for (int dir = 0; dir < 2; ++dir) {
      const bool has_next = !(cgp == 3 && dir == 1);
      if (has_next) { const int ncg = dir ? cgp + 1 : cgp; sw0 = *(const bf16x8*)WSRC(ncg, dir ^ 1, 0); sw1 = *(const bf16x8*)WSRC(ncg, dir ^ 1, 1); }
      f32x16 accr = f32x16{}, acci = f32x16{};
#pragma unroll
      for (int ks = 0; ks < 8; ++ks) { const bf16x8 xa = *(const bf16x8*)(Xw + 16 * ks);
        const bf16x8 bfr = *(const bf16x8*)(WB + dir * 16384 + ks * 1024 + lane * 16);
        const bf16x8 bfi = *(const bf16x8*)(WB + dir * 16384 + 8192 + ks * 1024 + lane * 16);
        accr = __builtin_amdgcn_mfma_f32_32x32x16_bf16(xa, bfr, accr, 0, 0, 0);
        acci = __builtin_amdgcn_mfma_f32_32x32x16_bf16(xa, bfi, acci, 0, 0, 0);
        if ((ks & 3) == 3) __builtin_amdgcn_sched_barrier(0); }
      const f32x4 prm = *(const f32x4*)(lds + PRM_OFF + (dir * 128 + ch) * 16);
      const float br = prm[0], bi = prm[1], c8 = prm[2];
      float a[16], bx[16];
#pragma unroll
      for (int r = 0; r < 16; ++r) { const float xv = bf2f(X[(32 * wid + crow(r, hi)) * XROW + ch]);
        const float rg = sigmoidf_(accr[r] + br), ig = sigmoidf_(acci[r] + bi);
        const float av = __builtin_amdgcn_exp2f(-c8 * rg); a[r] = av; bx[r] = __builtin_amdgcn_sqrtf(fmaxf(1.0f - av * av, 0.f)) * ig * xv; }
      float A[4], B[4], loA[4], loB[4], hiA[4], hiB[4], start[4];
      if (dir == 0) seg_comp<false>(a, bx, A, B); else seg_comp<true>(a, bx, A, B);
#pragma unroll
      for (int q = 0; q < 4; ++q) { const float pA = __shfl_xor(A[q], 32), pB = __shfl_xor(B[q], 32);
        loA[q] = hi ? pA : A[q]; loB[q] = hi ? pB : B[q]; hiA[q] = hi ? A[q] : pA; hiB[q] = hi ? B[q] : pB; }
      float Aw = 1.f;
#pragma unroll
      for (int q = 0; q < 4; ++q) Aw *= loA[q] * hiA[q];
      const float Bw = (dir == 0) ? seg_prefix<false>(loA, loB, hiA, hiB, hi, 0.f, start) : seg_prefix<true>(loA, loB, hiA, hiB, hi, 0.f, start);
      if (hi == 0) comp[((cgp * 2 + dir) * 8 + wid) * 32 + j] = (f32x2){Aw, Bw};
      if (has_next) { *(bf16x8*)(WB + (dir ^ 1) * 16384 + tid * 16) = sw0; *(bf16x8*)(WB + (dir ^ 1) * 16384 + 8192 + tid * 16) = sw1; }
      __syncthreads();
      if (PASS == 2) {
        float st = carry[dir * 128 + ch];
        if (dir == 0) { for (int w2 = 0; w2 < wid; ++w2) { const f32x2 ab = comp[((cgp * 2 + 0) * 8 + w2) * 32 + j]; st = ab.x * st + ab.y; } }
        else { for (int w2 = 7; w2 > wid; --w2) { const f32x2 ab = comp[((cgp * 2 + 1) * 8 + w2) * 32 + j]; st = ab.x * st + ab.y; } }
        if (dir == 0) { (void)seg_prefix<false>(loA, loB, hiA, hiB, hi, st, start);
#pragma unroll
          for (int q = 0; q < 4; ++q) { float h = start[q];
#pragma unroll
            for (int e = 0; e < 4; ++e) { const int r = 4 * q + e; h = a[r] * h + bx[r]; sum[r] = h; } } }
        else { (void)seg_prefix<true>(loA, loB, hiA, hiB, hi, st, start);
#pragma unroll
          for (int q = 0; q < 4; ++q) { float h = start[q];
#pragma unroll
            for (int ee = 0; ee < 4; ++ee) { const int r = 4 * q + 3 - ee; h = a[r] * h + bx[r]; sum[r] += h; } } }
      }
    }
    if (PASS == 2) {
      bf16_t* mixed = (bf16_t*)(p.ws + WS_XB);
      int rb2 = row0 + 32 * wid + 4 * hi, lane2 = lane; asm volatile("" : "+v"(rb2), "+v"(lane2));
#pragma unroll
      for (int r = 0; r < 16; ++r) { const int row = rb2 + (r & 3) + 8 * (r >> 2);
        const float g = bf2f(graw[r]);
        const float u3 = 0.7978845608028654f * (g + 0.044715f * g * g * g);
        const float th = 1.0f - 2.0f * __builtin_amdgcn_rcpf(1.0f + __builtin_amdgcn_exp2f((2.0f * 1.4426950408889634f) * u3));
        const float val = sum[r] * (0.5f * g * (1.0f + th));
        const unsigned pk = cvt_pk_bf16(val, val); const bf16_t hv = (bf16_t)(pk & 0xffffu);
        mixed[(size_t)row * DM + 1024 + gch] = hv;
        float q = bf2f(hv); q = q * q;
        q += shflx(q, lane2, 1); q += shflx(q, lane2, 2); q += shflx(q, lane2, 4); q += shflx(q, lane2, 8); q += shflx(q, lane2, 16);
        if ((lane2 & 31) == 0) atomicAdd(ssq_l + row, q); }
    }
  }
  if (PASS == 1) {
    __syncthreads();
    if (tid < 256) { const int dir = tid >> 7, ch = tid & 127, cgp = ch >> 5, jj = ch & 31; float A = 1.f, B = 0.f;
      if (dir == 0) { for (int w2 = 0; w2 < 8; ++w2) { const f32x2 ab = comp[((cgp * 2 + 0) * 8 + w2) * 32 + jj]; B = ab.x * B + ab.y; A *= ab.x; } }
      else { for (int w2 = 7; w2 >= 0; --w2) { const f32x2 ab = comp[((cgp * 2 + 1) * 8 + w2) * 32 + jj]; B = ab.x * B + ab.y; A *= ab.x; } }
      agg[(size_t)(dir * NCHUNK + chunk) * 1024 + n * 128 + ch] = (f32x2){A, B}; }
  }
  __syncthreads();
#undef WSRC
}
}

__device__ __forceinline__ void tr_item(const float* W, int ldw, int K, int srccol0, const float* gk, bf16_t* dst, int k0, LAS float* scr, int lane) {
  { const int n4 = (lane & 7) * 4; f32x4 v[8];
#pragma unroll
    for (int i = 0; i < 8; ++i) { const int kk = 8 * i + (lane >> 3); v[i] = (f32x4){0.f, 0.f, 0.f, 0.f};
      if (srccol0 >= 0) { v[i] = *(const f32x4*)(W + (size_t)(k0 + kk) * ldw + srccol0 + n4); if (gk) v[i] = v[i] * gk[kk]; } }
#pragma unroll
    for (int i = 0; i < 8; ++i) { const int kk = 8 * i + (lane >> 3); LAS float* d = scr + kk * 33 + n4; d[0] = v[i][0]; d[1] = v[i][1]; d[2] = v[i][2]; d[3] = v[i][3]; } }
  asm volatile("s_waitcnt lgkmcnt(0)" ::: "memory");
  const int c = lane & 7;
#pragma unroll
  for (int jq = 0; jq < 4; ++jq) { const int nn = (lane >> 3) + 8 * jq; const LAS float* s = scr + (8 * c) * 33 + nn;
    u32x4 o; o.x = cvt_pk_bf16(s[0 * 33], s[1 * 33]); o.y = cvt_pk_bf16(s[2 * 33], s[3 * 33]); o.z = cvt_pk_bf16(s[4 * 33], s[5 * 33]); o.w = cvt_pk_bf16(s[6 * 33], s[7 * 33]);
    *(u32x4*)(dst + (size_t)nn * K + k0 + 8 * c) = o; }
  asm volatile("s_waitcnt lgkmcnt(0)" ::: "memory");
}

__device__ __forceinline__ void p0_prologue(const Params& p, LAS unsigned char* lds, int vcu, int G) {
  int tid_ = threadIdx.x; asm volatile("" : "+v"(tid_));
  const int tid = tid_, lane = tid & 63, wave = __builtin_amdgcn_readfirstlane(tid >> 6);
  const int gw = vcu * 8 + wave, NGW = G * 8;
  const size_t gt = (size_t)blockIdx.x * 512 + tid, NGT = (size_t)G * 512;
  unsigned char* ws = p.ws;
  { float* z = (float*)(ws + WS_ZERO); for (size_t i = gt; i < ZERO_BYTES / 4; i += NGT) z[i] = 0.f; }
  { f32x2* rt = (f32x2*)(ws + WS_ROPE);
    for (size_t i = gt; i < (size_t)SEQP * 32; i += NGT) { const int s = (int)(i >> 5), f = (int)(i & 31);
      double rev = (double)s * INV_FREQ[f] * 0.15915494309189535; rev -= __builtin_rint(rev); const float r = (float)rev;
      rt[i] = (f32x2){__builtin_amdgcn_cosf(r), __builtin_amdgcn_sinf(r)}; } }
  { bf16_t* wf = (bf16_t*)(ws + WS_BRG);
    for (size_t ci = gt; ci < 65536; ci += NGT) { const int ln = (int)(ci & 63), ks = (int)((ci >> 6) & 7), cgp = (int)((ci >> 9) & 3), dw = (int)((ci >> 11) & 3), n = (int)(ci >> 13);
      const int jj = ln & 31, kg = ln >> 5, dir = dw >> 1, wh = dw & 1;
      const float* src = (wh ? p.in[14] : p.in[12]) + (size_t)(dir * 8 + n) * 128 * 128 + (size_t)(16 * ks + 8 * kg) * 128 + 32 * cgp + jj;
      u32x4 o; o.x = cvt_pk_bf16(src[0], src[128]); o.y = cvt_pk_bf16(src[256], src[384]); o.z = cvt_pk_bf16(src[512], src[640]); o.w = cvt_pk_bf16(src[768], src[896]);
      *(u32x4*)(wf + ci * 8) = o; } }
  { bf16_t* xb = (bf16_t*)(ws + WS_XB); float* rs1 = (float*)(ws + WS_RS1);
    for (int m0 = gw; m0 < M; m0 += 4 * NGW) {
      int mr[4]; const float* xr[4]; f32x4 v[4][8]; float ss[4];
#pragma unroll
      for (int t = 0; t < 4; ++t) { mr[t] = (m0 + t * NGW < M) ? m0 + t * NGW : m0; xr[t] = (mr[t] < MP) ? p.in[0] + (size_t)mr[t] * DM : p.in[1] + (size_t)(mr[t] - MP) * DM; }
#pragma unroll
      for (int q = 0; q < 8; ++q)
#pragma unroll
        for (int t = 0; t < 4; ++t) v[t][q] = *(const f32x4*)(xr[t] + q * 256 + lane * 4);
#pragma unroll
      for (int t = 0; t < 4; ++t) { float a = 0.f;
#pragma unroll
        for (int q = 0; q < 8; ++q) a += (v[t][q][0] * v[t][q][0] + v[t][q][1] * v[t][q][1]) + (v[t][q][2] * v[t][q][2] + v[t][q][3] * v[t][q][3]);
        ss[t] = wave_sum(a); }
      if (lane == 0) {
#pragma unroll
        for (int t = 0; t < 4; ++t) rs1[mr[t]] = 1.0f / sqrtf(ss[t] * (1.0f / DM) + EPS); }
#pragma unroll
      for (int t = 0; t < 4; ++t)
#pragma unroll
        for (int q = 0; q < 8; ++q) { u32x2 w; w.x = cvt_pk_bf16(v[t][q][0], v[t][q][1]); w.y = cvt_pk_bf16(v[t][q][2], v[t][q][3]); *(u32x2*)(xb + (size_t)mr[t] * DM + q * 256 + lane * 4) = w; } } }
  LAS float* scr = (LAS float*)(lds + wave * 16384);
  constexpr int I_IN = 96 * 32, I_UQ = 64 * 8, I_UKV = 64 * 4, I_OUT = 64 * 32, I_GU = 352 * 32, I_DN = 64 * 88;
  constexpr int NITEMS = I_IN + I_UQ + I_UKV + I_OUT + I_GU + I_DN;
  for (int it = gw; it < NITEMS; it += NGW) {
    int r = it;
    if (r < I_IN) { const int ng = r >> 5, kb = r & 31, dc = ng * 32; int sc;
      if (dc < 768) sc = dc; else if (dc < 1792) sc = dc - 768 + 832; else if (dc < 2816) sc = dc - 1792 + 1856; else if (dc < 2880) sc = dc - 2816 + 768; else sc = -1;
      tr_item(p.in[3], 2880, 2048, sc, p.in[2] + kb * 64, (bf16_t*)(ws + WS_BIN) + (size_t)dc * 2048, kb * 64, scr, lane); continue; } r -= I_IN;
    if (r < I_UQ) { const int ng = r >> 3, kb = r & 7, h = ng >> 3, t0 = (ng & 7) * 32; int d;
      if (t0 < 96) d = t0; else if (t0 == 96) d = 128; else if (t0 == 128) d = 96; else if (t0 == 224) d = 160; else d = -1;
      tr_item(p.in[5], 1536, 512, d < 0 ? -1 : h * 192 + d, p.in[4] + kb * 64, (bf16_t*)(ws + WS_BUQ) + (size_t)(ng * 32) * 512, kb * 64, scr, lane); continue; } r -= I_UQ;
    if (r < I_UKV) { const int ng = r >> 2, kb = r & 3;
      tr_item(p.in[7], 2048, 256, ng * 32, p.in[6] + kb * 64, (bf16_t*)(ws + WS_BUKV) + (size_t)(ng * 32) * 256, kb * 64, scr, lane); continue; } r -= I_UKV;
    if (r < I_OUT) { const int ng = r >> 5, kb = r & 31; const float* gk = (kb < 16) ? p.in[17] + kb * 64 : p.in[18] + (kb - 16) * 64;
      tr_item(p.in[19], 2048, 2048, ng * 32, gk, (bf16_t*)(ws + WS_BOUT) + (size_t)(ng * 32) * 2048, kb * 64, scr, lane); continue; } r -= I_OUT;
    if (r < I_GU) { const int ng = r >> 5, kb = r & 31, R = ng * 32, pn = R >> 8, within = R & 255, bj = within >> 7, c = within & 127;
      tr_item(bj ? p.in[22] : p.in[21], DFF, 2048, pn * 128 + c, p.in[20] + kb * 64, (bf16_t*)(ws + WS_BGU) + (size_t)R * 2048, kb * 64, scr, lane); continue; } r -= I_GU;
    { const int ng = r / 88, kb = r % 88;
      tr_item(p.in[23], 2048, DFF, ng * 32, nullptr, (bf16_t*)(ws + WS_BDN) + (size_t)(ng * 32) * DFF, kb * 64, scr, lane); }
  }
}

__global__ void __launch_bounds__(512, 2) hymba_fwd(Params p) {
  extern __shared__ __attribute__((aligned(16))) unsigned char lds[];
  cg::grid_group grid = cg::this_grid();
  LAS unsigned char* ldsl = (LAS unsigned char*)lds;
  const int G = gridDim.x, bx = blockIdx.x;
  const int vcu = (G % 8 == 0) ? (bx % 8) * (G / 8) + bx / 8 : bx;
  unsigned char* ws = p.ws;
  float* const dummy = (float*)(ws + WS_DUMMY);
#ifndef PROBE_TA
#define PROBE_TA -1
#define PROBE_TB -1
#endif
  unsigned long long t_a = 0, t_b = 0;
#define STAMP(k) do { if (PROBE_TA >= 0) { if ((k) == PROBE_TA) t_a = __builtin_amdgcn_s_memrealtime(); if ((k) == PROBE_TB) t_b = __builtin_amdgcn_s_memrealtime(); } } while (0)
  STAMP(0);

#ifndef NO_P0
  for (int rep = 0; rep < NREP(0); ++rep) p0_prologue(p, ldsl, vcu, G);
#endif
  grid.sync(); STAMP(1);

  for (int rep = 0; rep < NREP(1); ++rep) { pg8::Gemm g{(const bf16_t*)(ws + WS_XB), (const bf16_t*)(ws + WS_BIN), DM, LDU, DM}; pg8::StaticOrder S; S.init(M, LDU, G, bx);
    pg8::EpiU E{(bf16_t*)(ws + WS_U), (const float*)(ws + WS_RS1), rep ? dummy : (float*)(ws + WS_SSQ_Q), rep ? dummy : (float*)(ws + WS_SSQ_KV), rep ? dummy : (float*)(ws + WS_SSQ_PE)};

#ifndef NO_EPIU
    pg8::gemm_phase<pg8::EpiU>(ldsl, g, S, E);
#endif
  }
  grid.sync(); STAMP(2);

  for (int rep = 0; rep < NREP(2); ++rep) {
  { pg8::Gemm g{(const bf16_t*)(ws + WS_U) + UC_Q, (const bf16_t*)(ws + WS_BUQ), LDU, 2048, 512}; pg8::StaticOrder S; S.init(M, 2048, G, bx);
    pg8::EpiQ E{(bf16_t*)(ws + WS_Q), (const float*)(ws + WS_SSQ_Q), p.in[8], (const f32x2*)(ws + WS_ROPE), (LAS float*)(ldsl + XCH_OFF)};

#ifndef NO_EPIQ
    pg8::gemm_phase<pg8::EpiQ>(ldsl, g, S, E);
#endif
  }
  { pg8::Gemm g{(const bf16_t*)(ws + WS_U) + UC_KV, (const bf16_t*)(ws + WS_BUKV), LDU, 2048, 256}; pg8::StaticOrder S; S.init(M, 2048, G, bx);
    pg8::EpiKV E{(bf16_t*)(ws + WS_K), (bf16_t*)(ws + WS_V), (const bf16_t*)(ws + WS_U), (const float*)(ws + WS_SSQ_KV), (const float*)(ws + WS_SSQ_PE), p.in[9], (const f32x2*)(ws + WS_ROPE), (LAS float*)(ldsl + XCH_OFF)};

#ifndef NO_EPIKV
    pg8::gemm_phase<pg8::EpiKV>(ldsl, g, S, E);
#endif
  }
#ifndef NO_LRU1
  for (int u = vcu; u < NCHUNK * 8; u += G) lru::unit<1>(p, u >> 3, u & 7, (char*)lds, nullptr);
#endif
  }
  grid.sync(); STAMP(3);

#ifndef NO_LRU2
  for (int rep = 0; rep < NREP(3); ++rep)
  for (int u = vcu; u < NCHUNK * 8; u += G) lru::unit<2>(p, u >> 3, u & 7, (char*)lds, rep ? dummy : (float*)(ws + WS_SSQ_L));
#endif
  STAMP(4);

#ifndef NO_ATT
  { const bf16_t* Qt = (const bf16_t*)(ws + WS_Q); const bf16_t* Kt = (const bf16_t*)(ws + WS_K); const bf16_t* Vt = (const bf16_t*)(ws + WS_V);
    bf16_t* mixed = (bf16_t*)(ws + WS_XB); float* ssq_a = (float*)(ws + WS_SSQ_A);
    float kbound; { const int ln = threadIdx.x & 63; float gm = fmaxf(fmaxf(fabsf(p.in[9][ln]), fabsf(p.in[9][64 + ln])), fabsf(p.in[9][128 + ln]));
#pragma unroll
      for (int o = 1; o < 64; o <<= 1) gm = fmaxf(gm, __shfl_xor(gm, o));
      kbound = 13.856406460551018f * 1.02f * gm; }
    const int nrp = (1024 + G - 1) / G, nrs = (256 + G - 1) / G;
    for (int rep = 0; rep < NREP(4); ++rep)
    for (int i = 0; i < nrp + nrs; ++i) { int pl, qb, seq, row0; size_t prow;
      if (i < nrp) { if (G == 256) { pl = 2 * (vcu >> 5) + (i >> 1); qb = (vcu & 31) + 32 * (i & 1); } else { const int uu = i * G + vcu; if (uu >= 1024) continue; pl = uu >> 6; qb = uu & 63; }
        prow = (size_t)pl * SEQP; seq = SEQP; row0 = (pl >> 3) * SEQP + qb * 256; }
      else { const int uu = (i - nrp) * G + vcu; if (uu >= 256) continue; pl = uu >> 3; qb = uu & 7; prow = (size_t)MP * NH + (size_t)pl * SEQS; seq = SEQS; row0 = MP + (pl >> 3) * SEQS + qb * 256; }
      const int h = pl & 7;
      att::attn_unit(Qt + (prow + qb * 256) * DK, Kt + prow * DK, Vt + prow * DV, mixed + (size_t)row0 * DM + h * 128, (rep ? dummy : ssq_a) + row0, seq, kbound, (char*)lds, ldsl); }
  }
#endif
  grid.sync(); STAMP(5);

  for (int rep = 0; rep < NREP(5); ++rep) { pg8::Gemm g{(const bf16_t*)(ws + WS_XB), (const bf16_t*)(ws + WS_BOUT), DM, DM, DM}; pg8::StaticOrder S; S.init(M, DM, G, bx);
    pg8::EpiOut E{p.in[0], p.in[1], p.out, (bf16_t*)(ws + WS_U), (const float*)(ws + WS_SSQ_A), (const float*)(ws + WS_SSQ_L), rep ? dummy : (float*)(ws + WS_SSQ_2)};

#ifndef NO_EPIOUT
    pg8::gemm_phase<pg8::EpiOut>(ldsl, g, S, E);
#endif
  }
  grid.sync(); STAMP(6);

  for (int rep = 0; rep < NREP(6); ++rep) { pg8::Gemm g{(const bf16_t*)(ws + WS_U), (const bf16_t*)(ws + WS_BGU), DM, 2 * DFF, DM}; pg8::StaticOrder S; S.init(M, 2 * DFF, G, bx);
    pg8::EpiGU E{(bf16_t*)(ws + WS_ACT), (const float*)(ws + WS_SSQ_2)};

#ifndef NO_EPIGU
    pg8::gemm_phase<pg8::EpiGU>(ldsl, g, S, E);
#endif
  }
  grid.sync(); STAMP(7);

  { pg8::Gemm g{(const bf16_t*)(ws + WS_ACT), (const bf16_t*)(ws + WS_BDN), DFF, DM, DFF}; pg8::StaticOrder S; S.init(M, DM, G, bx);
    pg8::EpiDown E{p.out};

#ifndef NO_EPIDOWN
    pg8::gemm_phase<pg8::EpiDown>(ldsl, g, S, E);
#endif
  }
  if (PROBE_TA >= 0) { grid.sync(); STAMP(8); if (bx == 0 && threadIdx.x == 0) p.out[(size_t)MP * DM + 12345] += (float)(t_b - t_a) * 1e-5f; }
}

extern "C" void kernel_launch(void* const* d_in, const int* in_sizes, int n_in, void* d_out, int out_size, void* d_ws, size_t ws_size, hipStream_t stream) {
  static int grid = 0;
  if (grid == 0) {
    if (n_in != 24 || out_size != M * DM || ws_size < WS_END) { fprintf(stderr, "kernel_launch: unexpected shapes: n_in %d out %d ws %zu (need %zu)\n", n_in, out_size, ws_size, (size_t)WS_END); grid = -1; return; }
    int dev = 0, cus = 0, per_cu = 0;
    hipGetDevice(&dev); hipDeviceGetAttribute(&cus, hipDeviceAttributeMultiprocessorCount, dev);
    if (hipFuncSetAttribute((const void*)hymba_fwd, hipFuncAttributeMaxDynamicSharedMemorySize, LDS_BYTES) != hipSuccess) { fprintf(stderr, "kernel_launch: hipFuncSetAttribute failed\n"); grid = -1; return; }
    if (hipOccupancyMaxActiveBlocksPerMultiprocessor(&per_cu, (const void*)hymba_fwd, 512, LDS_BYTES) != hipSuccess || per_cu < 1) { fprintf(stderr, "kernel_launch: occupancy query says %d\n", per_cu); per_cu = 1; }
    (void)hipGetLastError();
    grid = cus * 1;
  }
  if (grid < 0) return;
  Params p{};
  for (int i = 0; i < 24; ++i) p.in[i] = (const float*)d_in[i];
  p.out = (float*)d_out; p.ws = (unsigned char*)d_ws;
  void* args[] = {&p};
  hipError_t e = hipLaunchCooperativeKernel((const void*)hymba_fwd, dim3(grid), dim3(512), args, LDS_BYTES, stream);
  if (e != hipSuccess) fprintf(stderr, "cooperative launch failed: %s (grid %d)\n", hipGetErrorString(e), grid);
}
```

```cpp
#include <hip/hip_runtime.h>
#include <hip/hip_cooperative_groups.h>
#include <cstdio>
#include <cstdint>
namespace cg = cooperative_groups;

#define LAS __attribute__((address_space(3)))
typedef unsigned short bf16_t;
typedef short bf16x8 __attribute__((ext_vector_type(8)));
typedef short s16x4 __attribute__((ext_vector_type(4)));
typedef float f32x4 __attribute__((ext_vector_type(4)));
typedef float f32x2 __attribute__((ext_vector_type(2)));
typedef float f32x16 __attribute__((ext_vector_type(16)));
typedef unsigned u32x4 __attribute__((ext_vector_type(4)));
typedef unsigned u32x2 __attribute__((ext_vector_type(2)));

constexpr int M = 40960, MP = 32768, SEQP = 16384, SEQS = 2048, DM = 2048;
constexpr int LDU = 3072, UC_Q = 0, UC_KV = 512, UC_X = 768, UC_G = 1792, UC_PE = 2816;
constexpr int NH = 8, DK = 192, DV = 128, DFF = 5632;
constexpr float EPS = 1e-6f;
constexpr int NCHUNK = M / 256;

constexpr size_t MiB = 1u << 20, KiB = 1024;
constexpr size_t WS_RS1 = 0;
constexpr size_t WS_ZERO = 256 * KiB;
constexpr size_t WS_SSQ_Q = WS_ZERO, WS_SSQ_KV = WS_ZERO + 256 * KiB, WS_SSQ_PE = WS_ZERO + 512 * KiB, WS_SSQ_A = WS_ZERO + 768 * KiB,
                 WS_SSQ_L = WS_ZERO + 1024 * KiB, WS_SSQ_2 = WS_ZERO + 1280 * KiB;
constexpr size_t ZERO_BYTES = 1536 * KiB;
constexpr size_t WS_ROPE = 2 * MiB;
constexpr size_t WS_AGG = 6 * MiB;
constexpr size_t WS_DUMMY = 9 * MiB;
constexpr size_t WS_BIN = 16 * MiB, WS_BUQ = 28 * MiB, WS_BUKV = 30 * MiB, WS_BRG = 31 * MiB, WS_BOUT = 32 * MiB, WS_BGU = 40 * MiB, WS_BDN = 84 * MiB;
constexpr size_t WS_XB = 112 * MiB;
constexpr size_t WS_U = 272 * MiB;
constexpr size_t WS_Q = 512 * MiB, WS_K = 632 * MiB, WS_V = 752 * MiB;
constexpr size_t WS_ACT = 512 * MiB;
constexpr size_t WS_END = 952 * MiB;

constexpr int RING_BYTES = 131072, XCH_OFF = 131072, LDS_BYTES = 147456;

#ifndef PROBE_REPEAT
#define PROBE_REPEAT 0
#endif
#define NREP(bit) ((PROBE_REPEAT >> (bit)) & 1 ? 2 : 1)
struct Params {
  const float* in[24];
  float* out;
  unsigned char* ws;
};

__device__ const double INV_FREQ[32] = {1.0, 0.7498942093324559, 0.5623413251903491, 0.4216965034285822, 0.31622776601683794, 0.23713737056616552, 0.1778279410038923, 0.1333521432163324, 0.1, 0.07498942093324558, 0.05623413251903491, 0.042169650342858224, 0.03162277660168379, 0.023713737056616554, 0.01778279410038923, 0.01333521432163324, 0.01, 0.007498942093324558, 0.005623413251903491, 0.004216965034285823, 0.0031622776601683794, 0.0023713737056616554, 0.0017782794100389228, 0.001333521432163324, 0.001, 0.0007498942093324559, 0.0005623413251903491, 0.00042169650342858224, 0.00031622776601683794, 0.00023713737056616554, 0.00017782794100389227, 0.0001333521432163324};

__device__ __forceinline__ unsigned cvt_pk_bf16(float lo, float hi) { unsigned r; asm volatile("v_cvt_pk_bf16_f32 %0, %1, %2" : "=v"(r) : "v"(lo), "v"(hi)); return r; }
__device__ __forceinline__ float bf2f(bf16_t v) { return __uint_as_float(((unsigned)v) << 16); }
__device__ __forceinline__ float bflo(unsigned w) { return __uint_as_float(w << 16); }
__device__ __forceinline__ float bfhi(unsigned w) { return __uint_as_float(w & 0xffff0000u); }
__device__ __forceinline__ float wave_sum(float v) {
#pragma unroll
  for (int o = 1; o < 64; o <<= 1) v += __shfl_xor(v, o);
  return v;
}
__device__ __forceinline__ float shflx(float v, int lane, int mask) { return __int_as_float(__builtin_amdgcn_ds_bpermute((lane ^ mask) << 2, __float_as_int(v))); }
__device__ __forceinline__ float sigmoidf_(float x) { return __builtin_amdgcn_rcpf(1.0f + __builtin_amdgcn_exp2f(x * -1.4426950408889634f)); }
__device__ __forceinline__ int crow(int r, int hi) { return (r & 3) + 8 * (r >> 2) + 4 * hi; }
__device__ __forceinline__ size_t plane_row(int m, int h) {
  if (m < MP) { const int b = m >> 14, s = m & (SEQP - 1); return ((size_t)(b * NH + h) * SEQP + s); }
  const int mm = m - MP, b = mm >> 11, s = mm & (SEQS - 1); return (size_t)MP * NH + ((size_t)(b * NH + h) * SEQS + s);
}
__device__ __forceinline__ int seq_pos(int m) { return m < MP ? (m & (SEQP - 1)) : ((m - MP) & (SEQS - 1)); }

namespace pg8 {
constexpr int BM = 256, BK = 64, HALF = 128, HTB = HALF * BK * 2, STAGE_BYTES = 8 * HTB, NXCD = 8, WGM = 8;
__host__ __device__ __forceinline__ int lds_byte(int r, int c) { const int st = (r >> 4) * 2 + (c >> 5), rr = r & 15, cc = c & 31, ob = rr * 64 + cc * 2; return st * 1024 + (ob ^ (((ob >> 9) & 1) << 5)); }
__host__ __device__ __forceinline__ void stage_rc(int b, int& R, int& C) { const int st = b / 1024, sb = b % 1024, swz = sb ^ (((sb >> 9) & 1) << 5); R = (st >> 1) * 16 + swz / 64; C = (st & 1) * 32 + (swz % 64) / 2; }
__host__ __device__ __forceinline__ int perm32(int rho) { const int n = rho >> 4, i = rho & 15; return 8 * (i >> 2) + 4 * n + (i & 3); }
struct Unit { int pm, pn; };
struct Gemm { const bf16_t* A; const bf16_t* Bt; int lda, N, K; };
struct StaticOrder {
  int nM, nN, nwg, G, c;
  __device__ void init(int Mr, int N, int G_, int c_) { nM = Mr / BM; nN = N / BM; nwg = nM * nN; G = G_; c = c_; }
  __device__ bool next(int i, Unit& u) const {
    const long L = (long)i * G + c; if (L >= nwg) return false;
    int wgid = (int)L; { const int q = nwg / NXCD, r = nwg % NXCD, xcd = wgid % NXCD, off = wgid / NXCD; wgid = (xcd < r ? xcd * (q + 1) : r * (q + 1) + (xcd - r) * q) + off; }
    const int nig = WGM * nN, gid = wgid / nig, fm = gid * WGM, gsz = (nM - fm) < WGM ? (nM - fm) : WGM;
    u.pm = fm + ((wgid % nig) % gsz); u.pn = (wgid % nig) / gsz; return true;
  }
};
template <class Epi>
__device__ __forceinline__ void gemm_phase(LAS unsigned char* lds, const Gemm g, const StaticOrder& S, const Epi& E) {
  int tid_ = threadIdx.x; asm volatile("" : "+v"(tid_));
  const int tid = tid_, wid = __builtin_amdgcn_readfirstlane(tid >> 6), lane = tid & 63, wr = wid >> 2, wc = wid & 3, fr = lane & 15, fq = lane >> 4;
  const int K = g.K, nt = K / BK, lda = g.lda;
  unsigned voffA[2], voffB[2];
#pragma unroll
  for (int i = 0; i < 2; ++i) { int R, C; stage_rc(tid * 16 + i * 8192, R, C); const int Rb = Epi::PERM ? ((R & ~31) + perm32(R & 31)) : R;
    voffA[i] = (unsigned)(R * lda + C) * 2u; voffB[i] = (unsigned)(Rb * K + C) * 2u; }
  const size_t kstep = (size_t)(BK * 2);
  const size_t hstepA = (size_t)HALF * lda * 2, hstepB = (size_t)HALF * K * 2;
  const size_t tstepA = 2 * hstepA, tstepB = 2 * hstepB;
  const unsigned ldsw = (unsigned)wid * 1024u;
  const int aoff = lds_byte(wr * 64 + fr, fq * 8), boff = lds_byte(wc * 32 + fr, fq * 8);
#define PG8_SA(b, h) (((b) * 2 + (h)) * HTB)
#define PG8_SB(b, h) ((4 + (b) * 2 + (h)) * HTB)
#define PG8_STAGE(bufoff, gbase, voff) do { _Pragma("unroll") for (int _i = 0; _i < 2; ++_i) \
    __builtin_amdgcn_global_load_lds((const unsigned*)((const char*)(gbase) + (voff)[_i]), (LAS unsigned*)(lds + (bufoff) + ldsw + _i * 8192), 16, 0, 0); } while (0)
#define PG8_LDA(dst, b, h) do { _Pragma("unroll") for (int m = 0; m < 4; ++m) _Pragma("unroll") for (int k = 0; k < 2; ++k) dst[m][k] = *(const LAS bf16x8*)(lds + PG8_SA(b, h) + aoff + m * 2048 + k * 1024); } while (0)
#define PG8_LDB(dst, b, h) do { _Pragma("unroll") for (int n = 0; n < 2; ++n) _Pragma("unroll") for (int k = 0; k < 2; ++k) dst[n][k] = *(const LAS bf16x8*)(lds + PG8_SB(b, h) + boff + n * 2048 + k * 1024); } while (0)
#define PG8_MMA(ai, bj, At, Bt) do { __builtin_amdgcn_s_setprio(1); _Pragma("unroll") for (int m = 0; m < 4; ++m) _Pragma("unroll") for (int n = 0; n < 2; ++n) _Pragma("unroll") for (int k = 0; k < 2; ++k) \
    acc[ai][bj][m][n] = __builtin_amdgcn_mfma_f32_16x16x32_bf16(Bt[n][k], At[m][k], acc[ai][bj][m][n], 0, 0, 0); __builtin_amdgcn_s_setprio(0); } while (0)
#define PG8_WAIT_V(n) asm volatile("s_waitcnt vmcnt(" #n ")" ::: "memory")
#define PG8_WAIT_L(n) asm volatile("s_waitcnt lgkmcnt(" #n ")" ::: "memory")
#define PG8_BAR __builtin_amdgcn_s_barrier()
#define PG8_SCHED __builtin_amdgcn_sched_barrier(0)
  Unit cur, nxt; int ui = 0;
  if (!S.next(0, cur)) return;
  f32x4 acc[2][2][4][2];
#pragma unroll
  for (int a = 0; a < 2; ++a)
#pragma unroll
    for (int b = 0; b < 2; ++b)
#pragma unroll
      for (int m = 0; m < 4; ++m)
#pragma unroll
        for (int n = 0; n < 2; ++n) acc[a][b][m][n] = (f32x4){0.f, 0.f, 0.f, 0.f};
  bf16x8 At[4][2], B0[2][2], B1[2][2];
  const char* cA = (const char*)g.A + (size_t)cur.pm * tstepA; const char* cB = (const char*)g.Bt + (size_t)cur.pn * tstepB;
  PG8_STAGE(PG8_SB(0, 0), cB, voffB); PG8_STAGE(PG8_SB(0, 1), cB + hstepB, voffB); PG8_STAGE(PG8_SA(0, 0), cA, voffA); PG8_STAGE(PG8_SA(0, 1), cA + hstepA, voffA);
  if (wr == 1) PG8_BAR;
  PG8_WAIT_V(2); PG8_BAR;
  PG8_STAGE(PG8_SB(1, 0), cB + kstep, voffB); PG8_STAGE(PG8_SA(1, 0), cA + kstep, voffA); PG8_STAGE(PG8_SB(1, 1), cB + hstepB + kstep, voffB);
  PG8_WAIT_V(6); PG8_BAR;
  for (;;) {
    const bool has_next = S.next(ui + 1, nxt);
    const char* nA = has_next ? (const char*)g.A + (size_t)nxt.pm * tstepA : cA; const char* nB = has_next ? (const char*)g.Bt + (size_t)nxt.pn * tstepB : cB;
    for (int t = 0; t < nt; t += 2) {
      const bool last = (t == nt - 2);
      const char* a1 = cA + (size_t)(t + 1) * kstep;
      const char* a2 = last ? nA : cA + (size_t)(t + 2) * kstep; const char* b2 = last ? nB : cB + (size_t)(t + 2) * kstep;
      const char* a3 = a2 + kstep; const char* b3 = b2 + kstep;
      if constexpr (Epi::MIDK) { if (t == (nt >> 1)) E.mid(acc, cur, wr, fr); }
      PG8_LDB(B0, 0, 0); PG8_LDB(B1, 0, 1); PG8_SCHED; PG8_LDA(At, 0, 0); PG8_STAGE(PG8_SA(1, 1), a1 + hstepA, voffA);
      PG8_WAIT_V(8); PG8_WAIT_L(0); PG8_BAR; PG8_MMA(0, 0, At, B0); PG8_MMA(0, 1, At, B1); PG8_BAR; PG8_SCHED;
      PG8_LDA(At, 0, 1); PG8_STAGE(PG8_SB(0, 0), b2, voffB); PG8_STAGE(PG8_SB(0, 1), b2 + hstepB, voffB); PG8_STAGE(PG8_SA(0, 0), a2, voffA);
      PG8_WAIT_V(8); PG8_WAIT_L(0); PG8_BAR; PG8_MMA(1, 0, At, B0); PG8_MMA(1, 1, At, B1); PG8_BAR; PG8_SCHED;
      PG8_LDB(B0, 1, 0); PG8_LDB(B1, 1, 1); PG8_SCHED; PG8_LDA(At, 1, 0); PG8_STAGE(PG8_SA(0, 1), a2 + hstepA, voffA);
      PG8_WAIT_V(8); PG8_WAIT_L(0); PG8_BAR; PG8_MMA(0, 0, At, B0); PG8_MMA(0, 1, At, B1); PG8_BAR; PG8_SCHED;
      PG8_LDA(At, 1, 1); PG8_STAGE(PG8_SB(1, 0), b3, voffB); PG8_STAGE(PG8_SB(1, 1), b3 + hstepB, voffB); PG8_STAGE(PG8_SA(1, 0), a3, voffA);
      PG8_WAIT_V(8); PG8_WAIT_L(0); PG8_BAR; PG8_MMA(1, 0, At, B0); PG8_MMA(1, 1, At, B1); PG8_BAR; PG8_SCHED;
    }
    if (wr == 0) PG8_BAR;
    E(acc, cur, wr, wc, fr, fq);
    if (!has_next) break;
#pragma unroll
    for (int a = 0; a < 2; ++a)
#pragma unroll
      for (int b = 0; b < 2; ++b)
#pragma unroll
        for (int m = 0; m < 4; ++m)
#pragma unroll
          for (int n = 0; n < 2; ++n) acc[a][b][m][n] = (f32x4){0.f, 0.f, 0.f, 0.f};
    cur = nxt; cA = nA; cB = nB; ++ui;
    if (wr == 1) PG8_BAR;
  }
  PG8_WAIT_V(0);
  PG8_BAR;
#undef PG8_SA
#undef PG8_SB
#undef PG8_STAGE
#undef PG8_LDA
#undef PG8_LDB
#undef PG8_MMA
}

struct EpiU {
  static constexpr bool PERM = true, MIDK = false;
  bf16_t* U; const float* rs1; float* ssq_q; float* ssq_kv; float* ssq_pe;
  __device__ __forceinline__ void operator()(const f32x4 (&acc)[2][2][4][2], const Unit& u, int wr, int wc, int fr_, int fq_) const {
    int fr = fr_, fq = fq_; asm volatile("" : "+v"(fr), "+v"(fq));
    float* ssq = (u.pn < 2) ? ssq_q : (u.pn == 2 ? ssq_kv : (u.pn == 11 ? ssq_pe : (float*)nullptr));
    const int col0 = u.pn * BM + wc * 32 + 8 * fq;
#pragma unroll
    for (int ai = 0; ai < 2; ++ai)
#pragma unroll
      for (int m = 0; m < 4; ++m) {
        const int row = u.pm * BM + ai * HALF + wr * 64 + m * 16 + fr; const float s = rs1[row]; float q = 0.f;
        bf16_t* rowp = U + (size_t)row * LDU + col0;
#pragma unroll
        for (int bj = 0; bj < 2; ++bj) { const f32x4 v0 = acc[ai][bj][m][0] * s, v1 = acc[ai][bj][m][1] * s;
          q += (v0[0] * v0[0] + v0[1] * v0[1]) + (v0[2] * v0[2] + v0[3] * v0[3]) + (v1[0] * v1[0] + v1[1] * v1[1]) + (v1[2] * v1[2] + v1[3] * v1[3]);
          u32x4 w; w.x = cvt_pk_bf16(v0[0], v0[1]); w.y = cvt_pk_bf16(v0[2], v0[3]); w.z = cvt_pk_bf16(v1[0], v1[1]); w.w = cvt_pk_bf16(v1[2], v1[3]);
          *(u32x4*)(rowp + bj * HALF) = w; }
        if (ssq) { q += __shfl_xor(q, 16); q += __shfl_xor(q, 32); if (fq == 0) atomicAdd(ssq + row, q); }
      }
  }
};

struct EpiQ {
  static constexpr bool PERM = false, MIDK = false;
  bf16_t* Q; const float* ssq_q; const float* g_qn; const f32x2* rope; LAS float* xch;
  __device__ __forceinline__ void operator()(const f32x4 (&acc)[2][2][4][2], const Unit& u, int wr, int wc, int fr_, int fq_) const {
    int fr = fr_, fq = fq_; asm volatile("" : "+v"(fr), "+v"(fq));
    float rsq[2][4];
#pragma unroll
    for (int ai = 0; ai < 2; ++ai)
#pragma unroll
      for (int m = 0; m < 4; ++m) {
        const int rl = ai * HALF + wr * 64 + m * 16 + fr; const int row = u.pm * BM + rl;
        const float s = __builtin_amdgcn_rsqf(ssq_q[row] * (1.0f / 512.0f) + EPS); rsq[ai][m] = s; float q = 0.f;
#pragma unroll
        for (int bj = 0; bj < 2; ++bj)
#pragma unroll
          for (int n = 0; n < 2; ++n) { const f32x4 v = acc[ai][bj][m][n] * s; q += (v[0] * v[0] + v[1] * v[1]) + (v[2] * v[2] + v[3] * v[3]); }
        q += __shfl_xor(q, 16); q += __shfl_xor(q, 32);
        if (fq == 0) xch[rl * 4 + wc] = q;
      }
    asm volatile("s_waitcnt lgkmcnt(0)" ::: "memory"); __builtin_amdgcn_s_barrier(); asm volatile("" ::: "memory");
    const int h = u.pn;
#pragma unroll
    for (int ai = 0; ai < 2; ++ai)
#pragma unroll
      for (int m = 0; m < 4; ++m) {
        const int rl = ai * HALF + wr * 64 + m * 16 + fr; const int row = u.pm * BM + rl;
        const f32x4 pq = *(const LAS f32x4*)(xch + rl * 4);
        const float tot = (pq[0] + pq[1]) + (pq[2] + pq[3]);
        const float sc = rsq[ai][m] * __builtin_amdgcn_rsqf(tot * (1.0f / 192.0f) + EPS) * 0.10411754627697264f;
        bf16_t* qrow = Q + (plane_row(row, h)) * DK;
        if (wc == 3) {
          const int s = seq_pos(row);
#pragma unroll
          for (int n = 0; n < 2; ++n) { const int i0 = 16 * n + 4 * fq;
            const f32x4 g1 = *(const f32x4*)(g_qn + 128 + i0), g2 = *(const f32x4*)(g_qn + 160 + i0);
            const f32x4 x1 = acc[ai][0][m][n] * sc * g1, x2 = acc[ai][1][m][n] * sc * g2; float o1[4], o2[4];
#pragma unroll
            for (int j = 0; j < 4; ++j) { const f32x2 cs = rope[(size_t)s * 32 + i0 + j]; o1[j] = x1[j] * cs.x - x2[j] * cs.y; o2[j] = x2[j] * cs.x + x1[j] * cs.y; }
            u32x2 w1, w2; w1.x = cvt_pk_bf16(o1[0], o1[1]); w1.y = cvt_pk_bf16(o1[2], o1[3]); w2.x = cvt_pk_bf16(o2[0], o2[1]); w2.y = cvt_pk_bf16(o2[2], o2[3]);
            *(u32x2*)(qrow + 128 + i0) = w1; *(u32x2*)(qrow + 160 + i0) = w2; }
        } else {
#pragma unroll
          for (int n = 0; n < 2; ++n) { const int d = 32 * wc + 16 * n + 4 * fq;
            const f32x4 gg = *(const f32x4*)(g_qn + d); const f32x4 v = acc[ai][0][m][n] * sc * gg;
            u32x2 w; w.x = cvt_pk_bf16(v[0], v[1]); w.y = cvt_pk_bf16(v[2], v[3]); *(u32x2*)(qrow + d) = w; }
          if (wc == 0) {
#pragma unroll
            for (int n = 0; n < 2; ++n) { const int d = 96 + 16 * n + 4 * fq;
              const f32x4 gg = *(const f32x4*)(g_qn + d); const f32x4 v = acc[ai][1][m][n] * sc * gg;
              u32x2 w; w.x = cvt_pk_bf16(v[0], v[1]); w.y = cvt_pk_bf16(v[2], v[3]); *(u32x2*)(qrow + d) = w; }
          }
        }
      }
  }
};

struct EpiKV {
  static constexpr bool PERM = false, MIDK = false;
  bf16_t* Kt; bf16_t* Vt; const bf16_t* U; const float* ssq_kv; const float* ssq_pe; const float* g_kn; const f32x2* rope; LAS float* xch;
  __device__ __forceinline__ void operator()(const f32x4 (&acc)[2][2][4][2], const Unit& u, int wr, int wc, int fr_, int fq_) const {
    int fr = fr_, fq = fq_; asm volatile("" : "+v"(fr), "+v"(fq));
    float rsq[2][4];
#pragma unroll
    for (int ai = 0; ai < 2; ++ai)
#pragma unroll
      for (int m = 0; m < 4; ++m) {
        const int rl = ai * HALF + wr * 64 + m * 16 + fr; const int row = u.pm * BM + rl;
        const float s = __builtin_amdgcn_rsqf(ssq_kv[row] * (1.0f / 256.0f) + EPS); rsq[ai][m] = s; float q = 0.f;
#pragma unroll
        for (int n = 0; n < 2; ++n) { const f32x4 v = acc[ai][0][m][n] * s; q += (v[0] * v[0] + v[1] * v[1]) + (v[2] * v[2] + v[3] * v[3]); }
        q += __shfl_xor(q, 16); q += __shfl_xor(q, 32);
        if (fq == 0) xch[rl * 4 + wc] = q;
      }
    asm volatile("s_waitcnt lgkmcnt(0)" ::: "memory"); __builtin_amdgcn_s_barrier(); asm volatile("" ::: "memory");
    const int h = u.pn;
#pragma unroll
    for (int ai = 0; ai < 2; ++ai)
#pragma unroll
      for (int m = 0; m < 4; ++m) {
        const int rl = ai * HALF + wr * 64 + m * 16 + fr; const int row = u.pm * BM + rl;
        const f32x4 pq = *(const LAS f32x4*)(xch + rl * 4);
        const float tot = (pq[0] + pq[1]) + (pq[2] + pq[3]) + ssq_pe[row];
        const float rstd = __builtin_amdgcn_rsqf(tot * (1.0f / 192.0f) + EPS);
        const float sc = rsq[ai][m] * rstd;
        const size_t pr = plane_row(row, h);
        bf16_t* krow = Kt + pr * DK; bf16_t* vrow = Vt + pr * DV;
#pragma unroll
        for (int n = 0; n < 2; ++n) { const int d = 32 * wc + 16 * n + 4 * fq;
          const f32x4 gg = *(const f32x4*)(g_kn + d); const f32x4 kv = acc[ai][0][m][n] * sc * gg; const f32x4 vv = acc[ai][1][m][n] * rsq[ai][m];
          u32x2 w; w.x = cvt_pk_bf16(kv[0], kv[1]); w.y = cvt_pk_bf16(kv[2], kv[3]); *(u32x2*)(krow + d) = w;
          u32x2 wv; wv.x = cvt_pk_bf16(vv[0], vv[1]); wv.y = cvt_pk_bf16(vv[2], vv[3]); *(u32x2*)(vrow + d) = wv; }
        { const int i0 = 8 * wc + 2 * fq; const int s = seq_pos(row);
          const unsigned p1 = *(const unsigned*)(U + (size_t)row * LDU + UC_PE + i0), p2 = *(const unsigned*)(U + (size_t)row * LDU + UC_PE + 32 + i0);
          const float x1a = bflo(p1) * rstd * g_kn[128 + i0], x1b = bfhi(p1) * rstd * g_kn[128 + i0 + 1];
          const float x2a = bflo(p2) * rstd * g_kn[160 + i0], x2b = bfhi(p2) * rstd * g_kn[160 + i0 + 1];
          const f32x2 ca = rope[(size_t)s * 32 + i0], cb = rope[(size_t)s * 32 + i0 + 1];
          *(unsigned*)(krow + 128 + i0) = cvt_pk_bf16(x1a * ca.x - x2a * ca.y, x1b * cb.x - x2b * cb.y);
          *(unsigned*)(krow + 160 + i0) = cvt_pk_bf16(x2a * ca.x + x1a * ca.y, x2b * cb.x + x1b * cb.y); }
        asm volatile("" ::: "memory");
      }
  }
};

struct EpiOut {
  static constexpr bool PERM = false, MIDK = true;
  const float* xp; const float* xs; float* out; bf16_t* x1b; const float* ssq_a; const float* ssq_l; float* ssq2;
  __device__ __forceinline__ void mid(f32x4 (&acc)[2][2][4][2], const Unit& u, int wr, int fr_) const {
    int fr = fr_; asm volatile("" : "+v"(fr));
#pragma unroll
    for (int ai = 0; ai < 2; ++ai)
#pragma unroll
      for (int m = 0; m < 4; ++m) { const int row = u.pm * BM + ai * HALF + wr * 64 + m * 16 + fr;
        const float sa = __builtin_amdgcn_rsqf(ssq_a[row] * (1.0f / 1024.0f) + EPS), sl = __builtin_amdgcn_rsqf(ssq_l[row] * (1.0f / 1024.0f) + EPS);
        const float ratio = sa / sl;
#pragma unroll
        for (int bj = 0; bj < 2; ++bj)
#pragma unroll
          for (int n = 0; n < 2; ++n) acc[ai][bj][m][n] *= ratio; }
  }
  __device__ __forceinline__ void operator()(const f32x4 (&acc)[2][2][4][2], const Unit& u, int wr, int wc, int fr_, int fq_) const {
    int fr = fr_, fq = fq_; asm volatile("" : "+v"(fr), "+v"(fq));
    const int col0 = u.pn * BM + wc * 32 + 4 * fq;
#pragma unroll
    for (int ai = 0; ai < 2; ++ai)
#pragma unroll
      for (int m = 0; m < 4; ++m) { const int row = u.pm * BM + ai * HALF + wr * 64 + m * 16 + fr;
        const float sl = __builtin_amdgcn_rsqf(ssq_l[row] * (1.0f / 1024.0f) + EPS);
        const float* xrow = (row < MP) ? xp + (size_t)row * DM : xs + (size_t)(row - MP) * DM; float q = 0.f;
#pragma unroll
        for (int bj = 0; bj < 2; ++bj)
#pragma unroll
          for (int n = 0; n < 2; ++n) { const int c = col0 + bj * HALF + n * 16;
            const f32x4 xv = *(const f32x4*)(xrow + c); const f32x4 o = xv + acc[ai][bj][m][n] * sl;
            *(f32x4*)(out + (size_t)row * DM + c) = o; q += (o[0] * o[0] + o[1] * o[1]) + (o[2] * o[2] + o[3] * o[3]);
            u32x2 w; w.x = cvt_pk_bf16(o[0], o[1]); w.y = cvt_pk_bf16(o[2], o[3]); *(u32x2*)(x1b + (size_t)row * DM + c) = w; }
        q += __shfl_xor(q, 16); q += __shfl_xor(q, 32); if (fq == 0) atomicAdd(ssq2 + row, q); }
  }
};

struct EpiGU {
  static constexpr bool PERM = true, MIDK = false;
  bf16_t* act; const float* ssq2;
  __device__ __forceinline__ void operator()(const f32x4 (&acc)[2][2][4][2], const Unit& u, int wr, int wc, int fr_, int fq_) const {
    int fr = fr_, fq = fq_; asm volatile("" : "+v"(fr), "+v"(fq));
    const int col0 = u.pn * HALF + wc * 32 + 8 * fq;
#pragma unroll
    for (int ai = 0; ai < 2; ++ai)
#pragma unroll
      for (int m = 0; m < 4; ++m) { const int row = u.pm * BM + ai * HALF + wr * 64 + m * 16 + fr;
        const float rs = __builtin_amdgcn_rsqf(ssq2[row] * (1.0f / 2048.0f) + EPS);
        float r[8];
#pragma unroll
        for (int n = 0; n < 2; ++n)
#pragma unroll
          for (int j = 0; j < 4; ++j) { const float gv = acc[ai][0][m][n][j] * rs, uv = acc[ai][1][m][n][j] * rs; r[n * 4 + j] = gv * sigmoidf_(gv) * uv; }
        u32x4 w; w.x = cvt_pk_bf16(r[0], r[1]); w.y = cvt_pk_bf16(r[2], r[3]); w.z = cvt_pk_bf16(r[4], r[5]); w.w = cvt_pk_bf16(r[6], r[7]);
        *(u32x4*)(act + (size_t)row * DFF + col0) = w; }
  }
};

struct EpiDown {
  static constexpr bool PERM = false, MIDK = false;
  float* out;
  __device__ __forceinline__ void operator()(const f32x4 (&acc)[2][2][4][2], const Unit& u, int wr, int wc, int fr_, int fq_) const {
    int fr = fr_, fq = fq_; asm volatile("" : "+v"(fr), "+v"(fq));
    const int col0 = u.pn * BM + wc * 32 + 4 * fq;
#pragma unroll
    for (int ai = 0; ai < 2; ++ai)
#pragma unroll
      for (int m = 0; m < 4; ++m) { const int row = u.pm * BM + ai * HALF + wr * 64 + m * 16 + fr;
#pragma unroll
        for (int bj = 0; bj < 2; ++bj)
#pragma unroll
          for (int n = 0; n < 2; ++n) { float* p = out + (size_t)row * DM + col0 + bj * HALF + n * 16; const f32x4 xv = *(const f32x4*)p; *(f32x4*)p = xv + acc[ai][bj][m][n]; } }
  }
};
}

namespace att {
constexpr int NW = 8, QBLK = 32, KVBLK = 64;
constexpr float QSCALE = 0.10411754627697264f;
constexpr int KROWB = 400;
constexpr int SHM_V = KVBLK * DV * 2, SHM_K = KVBLK * KROWB;
constexpr int QRP = 144;
constexpr int SHM_WS = 3 * SHM_V + 2 * SHM_K, SHM_QR = SHM_WS + NW * 64 * 4, SHM_ATTN = SHM_QR + NW * 32 * QRP;
static_assert(SHM_ATTN <= LDS_BYTES, "attention LDS");
#define SBAR() __builtin_amdgcn_sched_barrier(0)
#define SGB(mask, n) __builtin_amdgcn_sched_group_barrier(mask, n, 0)
__device__ __forceinline__ void sched_qk_sm() {
  SGB(0x100, 4);
#pragma unroll
  for (int i = 0; i < 10; ++i) { SGB(0x008, 2); SGB(0x100, 2); SGB(0x402, 8); }
#pragma unroll
  for (int i = 0; i < 2; ++i) { SGB(0x008, 2); SGB(0x402, 8); }
}
typedef __bf16 bf16x2_t __attribute__((ext_vector_type(2)));
__device__ __forceinline__ unsigned cvtpk_s(float lo, float hi) { f32x2 v = {lo, hi}; bf16x2_t b = __builtin_convertvector(v, bf16x2_t); return __builtin_bit_cast(unsigned, b); }
__device__ __forceinline__ void expA(f32x16& p0) {
#pragma unroll
  for (int r = 0; r < 16; ++r) p0[r] = __builtin_amdgcn_exp2f(p0[r]);
}
__device__ __forceinline__ void finishSM(f32x16& p0, f32x16& p1, float& l_reg, bf16x8& pa0, bf16x8& pa1, bf16x8& pa2, bf16x8& pa3) {
#pragma unroll
  for (int r = 0; r < 16; ++r) p1[r] = __builtin_amdgcn_exp2f(p1[r]);
  float ps = 0;
#pragma unroll
  for (int r = 0; r < 16; ++r) ps += p0[r];
#pragma unroll
  for (int r = 0; r < 16; ++r) ps += p1[r];
  l_reg += ps;
#define PK4(P, BASE, OUT) do { unsigned a0 = cvtpk_s(P[BASE + 0], P[BASE + 1]), a1 = cvtpk_s(P[BASE + 2], P[BASE + 3]);   \
    unsigned b0 = cvtpk_s(P[BASE + 4], P[BASE + 5]), b1 = cvtpk_s(P[BASE + 6], P[BASE + 7]);                              \
    auto r0 = __builtin_amdgcn_permlane32_swap(a0, b0, false, false); auto r1 = __builtin_amdgcn_permlane32_swap(a1, b1, false, false); \
    u32x4 w = {r0[0], r1[0], r0[1], r1[1]}; OUT = *reinterpret_cast<bf16x8*>(&w); } while (0)
  PK4(p0, 0, pa0); PK4(p0, 8, pa1); PK4(p1, 0, pa2); PK4(p1, 8, pa3);
#undef PK4
}
__device__ __forceinline__ void qkt(f32x16& p0, f32x16& p1, const char* Ks, const bf16x8* qr, const char* qrl, const f32x16& negm, int r32, int hi) {
  p0 = negm; p1 = negm;
#pragma unroll
  for (int d0 = 0; d0 < 12; ++d0) { const int cb = (d0 * 16 + hi * 8) * 2;
    const bf16x8 b0 = *reinterpret_cast<const bf16x8*>(Ks + r32 * KROWB + cb);
    const bf16x8 b1 = *reinterpret_cast<const bf16x8*>(Ks + (32 + r32) * KROWB + cb);
    const bf16x8 qf = qr[d0];
    p0 = __builtin_amdgcn_mfma_f32_32x32x16_bf16(b0, qf, p0, 0, 0, 0);
    p1 = __builtin_amdgcn_mfma_f32_32x32x16_bf16(b1, qf, p1, 0, 0, 0); }
}
__device__ __forceinline__ int v_st(int k, int c) { const int kk = (k & ~0xC) | ((k & 4) << 1) | ((k & 8) >> 1); return ((kk >> 3) * 4 + (c >> 5)) * 512 + ((kk & 7) * 32 + (c & 31)) * 2; }
__device__ __forceinline__ int v_rd_base(int lane) { return ((lane & 3) << 3) | (((lane >> 2) & 3) << 6) | (((lane >> 4) & 1) << 5) | (((lane >> 5) & 1) << 8); }
constexpr int v_rd_off(int d0, int ks, int half) { return d0 * 512 + ks * 4096 + half * 2048; }
template <int OFF> __device__ __forceinline__ s16x4 tr_read(int vb) {
  s16x4 r; asm volatile("ds_read_b64_tr_b16 %0, %1 offset:%2" : "=&v"(r) : "v"(vb), "i"(OFF) : "memory"); return r;
}
template <int D0> __device__ __forceinline__ void pv_one(f32x16& od, int vb, bf16x8 pa0, bf16x8 pa1, bf16x8 pa2, bf16x8 pa3) {
  const s16x4 l0 = tr_read<v_rd_off(D0, 0, 0)>(vb), h0 = tr_read<v_rd_off(D0, 0, 1)>(vb), l1 = tr_read<v_rd_off(D0, 1, 0)>(vb), h1 = tr_read<v_rd_off(D0, 1, 1)>(vb);
  const s16x4 l2 = tr_read<v_rd_off(D0, 2, 0)>(vb), h2 = tr_read<v_rd_off(D0, 2, 1)>(vb), l3 = tr_read<v_rd_off(D0, 3, 0)>(vb), h3 = tr_read<v_rd_off(D0, 3, 1)>(vb);
  asm volatile("s_waitcnt lgkmcnt(0)" ::: "memory"); SBAR();
#define PK(L, H) (bf16x8){L[0], L[1], L[2], L[3], H[0], H[1], H[2], H[3]}
  od = __builtin_amdgcn_mfma_f32_32x32x16_bf16(pa0, PK(l0, h0), od, 0, 0, 0);
  od = __builtin_amdgcn_mfma_f32_32x32x16_bf16(pa1, PK(l1, h1), od, 0, 0, 0);
  od = __builtin_amdgcn_mfma_f32_32x32x16_bf16(pa2, PK(l2, h2), od, 0, 0, 0);
  od = __builtin_amdgcn_mfma_f32_32x32x16_bf16(pa3, PK(l3, h3), od, 0, 0, 0);
#undef PK
}
__device__ __forceinline__ void pv_d0(f32x16* o, int vb, bf16x8 pa0, bf16x8 pa1, bf16x8 pa2, bf16x8 pa3) {
  pv_one<0>(o[0], vb, pa0, pa1, pa2, pa3); pv_one<1>(o[1], vb, pa0, pa1, pa2, pa3); pv_one<2>(o[2], vb, pa0, pa1, pa2, pa3); pv_one<3>(o[3], vb, pa0, pa1, pa2, pa3);
}
__device__ __forceinline__ void attn_unit(const bf16_t* __restrict__ Qb, const bf16_t* __restrict__ Kh, const bf16_t* __restrict__ Vh, bf16_t* __restrict__ Ob, float* __restrict__ ssq, int seq, float kbound, char* lds, LAS unsigned char* ldsl) {
  int tid_ = threadIdx.x; asm volatile("" : "+v"(tid_));
  const int tid = tid_, wid = tid >> 6, lane = tid & 63, r32 = lane & 31, hi = lane >> 5;
  char* V_lds = lds; char* K_lds = lds + 3 * SHM_V;
  float* ws = (float*)(lds + SHM_WS) + wid * 64; float* li_l = ws;
  float l_reg = 0; f32x16 o[4] = {}; bf16x8 qr[12];
  const bf16_t* Qw = Qb + (size_t)(wid * QBLK + r32) * DK + hi * 8;
  float qss = 0.f;
#pragma unroll
  for (int d0 = 0; d0 < 8; ++d0) { qr[d0] = *reinterpret_cast<const bf16x8*>(Qw + d0 * 16);
#pragma unroll
    for (int e = 0; e < 8; ++e) { const float v = bf2f((bf16_t)qr[d0][e]); qss += v * v; } }
  const char* qrl = nullptr;
#pragma unroll
  for (int d0 = 8; d0 < 12; ++d0) { const bf16x8 qv = *reinterpret_cast<const bf16x8*>(Qw + d0 * 16); qr[d0] = qv;
#pragma unroll
    for (int e = 0; e < 8; ++e) { const float v = bf2f((bf16_t)qv[e]); qss += v * v; } }
  { auto rr = __builtin_amdgcn_permlane32_swap(__float_as_uint(qss), __float_as_uint(qss), false, false); qss = __uint_as_float(rr[0]) + __uint_as_float(rr[1]); }
  f32x16 negm; { const float nm = -__builtin_amdgcn_sqrtf(qss) * kbound;
#pragma unroll
    for (int r = 0; r < 16; ++r) negm[r] = nm; }
  asm volatile("" : "+v"(negm));
  const int vb0 = (int)(uintptr_t)V_lds + v_rd_base(lane);
  const int uw = __builtin_amdgcn_readfirstlane(wid);
  unsigned koff[4], voff[2];
#pragma unroll
  for (int i = 0; i < 4; ++i) { const int c = (uw + 8 * i) * 64 + lane, row = c / 25, cc = c - row * 25; koff[i] = (unsigned)(row * 384 + (cc < 24 ? cc : 23) * 16); }
#pragma unroll
  for (int i = 0; i < 2; ++i) { const int P = (uw + 8 * i) * 64 + lane, sub = P >> 5, within = P & 31, kk = (sub >> 2) * 8 + (within >> 2), c = (sub & 3) * 32 + (within & 3) * 8;
    const int k = (kk & ~0xC) | ((kk & 4) << 1) | ((kk & 8) >> 1); voff[i] = (unsigned)(k * 256 + c * 2); }
  LAS unsigned char* Vl = ldsl; LAS unsigned char* Kl = ldsl + 3 * SHM_V;
#define UNI64(p) ((const char*)((((unsigned long long)(unsigned)__builtin_amdgcn_readfirstlane((int)((unsigned long long)(p) >> 32))) << 32) | (unsigned long long)(unsigned)__builtin_amdgcn_readfirstlane((int)(unsigned)(unsigned long long)(p))))
#define GLDS16S(voff_, sbase_, ldsaddr_) do { unsigned keep_; asm volatile("s_mov_b32 %0, m0\n\ts_mov_b32 m0, %3\n\ts_nop 0\n\tglobal_load_lds_dwordx4 %1, %2\n\ts_mov_b32 m0, %0" \
    : "=&s"(keep_) : "v"(voff_), "s"(sbase_), "s"(ldsaddr_) : "memory"); } while (0)
#define DMA_TILE(t, kbuf, vbuf) do { const char* kt_ = UNI64((const char*)Kh + (size_t)(t) * (KVBLK * DK * 2)); const char* vt_ = UNI64((const char*)Vh + (size_t)(t) * (KVBLK * DV * 2)); \
    const unsigned kl_ = (unsigned)__builtin_amdgcn_readfirstlane((int)(unsigned)(unsigned long)(Kl + (kbuf) * SHM_K + uw * 1024)); \
    const unsigned vl_ = (unsigned)__builtin_amdgcn_readfirstlane((int)(unsigned)(unsigned long)(Vl + (vbuf) * SHM_V + uw * 1024)); \
    GLDS16S(koff[0], kt_, kl_); GLDS16S(koff[1], kt_, kl_ + 8 * 1024); GLDS16S(koff[2], kt_, kl_ + 16 * 1024); \
    if (uw == 0) GLDS16S(koff[3], kt_, kl_ + 24 * 1024); \
    GLDS16S(voff[0], vt_, vl_); GLDS16S(voff[1], vt_, vl_ + 8 * 1024); } while (0)
#define DMA_SYNC() do { asm volatile("s_waitcnt vmcnt(0)" ::: "memory"); __syncthreads(); } while (0)
  f32x16 pA0, pA1, pB0, pB1; bf16x8 pa0, pa1, pa2, pa3; const int NT = seq / KVBLK;
  int ip = 2, ic = 0, in = 1;
#define ROT() do { const int t_ = ip; ip = ic; ic = in; in = t_; } while (0)
  DMA_TILE(0, 0, 0); DMA_SYNC();
  DMA_TILE(1, 1, in); SBAR();
  qkt(pA0, pA1, K_lds, qr, qrl, negm, r32, hi); expA(pA0);
  DMA_SYNC(); ROT();
  for (int j = 1; j + 1 < NT; j += 2) {
    DMA_TILE(j + 1, 0, in); SBAR();
    qkt(pB0, pB1, K_lds + SHM_K, qr, qrl, negm, r32, hi);
    finishSM(pA0, pA1, l_reg, pa0, pa1, pa2, pa3); sched_qk_sm(); SBAR();
    pv_d0(o, vb0 + ip * SHM_V, pa0, pa1, pa2, pa3); expA(pB0);
    DMA_SYNC(); ROT();
    DMA_TILE(j + 2, 1, in); SBAR();
    qkt(pA0, pA1, K_lds, qr, qrl, negm, r32, hi);
    finishSM(pB0, pB1, l_reg, pa0, pa1, pa2, pa3); sched_qk_sm(); SBAR();
    pv_d0(o, vb0 + ip * SHM_V, pa0, pa1, pa2, pa3); expA(pA0);
    DMA_SYNC(); ROT();
  }
  SBAR(); qkt(pB0, pB1, K_lds + SHM_K, qr, qrl, negm, r32, hi);
  finishSM(pA0, pA1, l_reg, pa0, pa1, pa2, pa3); SBAR();
  pv_d0(o, vb0 + ip * SHM_V, pa0, pa1, pa2, pa3); expA(pB0);
  finishSM(pB0, pB1, l_reg, pa0, pa1, pa2, pa3); SBAR();
  pv_d0(o, vb0 + ic * SHM_V, pa0, pa1, pa2, pa3);
#undef ROT
#undef UNI64
#undef GLDS16S
#undef DMA_TILE
#undef DMA_SYNC
  { auto rr = __builtin_amdgcn_permlane32_swap(__float_as_uint(l_reg), __float_as_uint(l_reg), false, false); l_reg = __uint_as_float(rr[0]) + __uint_as_float(rr[1]); }
  if (hi == 0) li_l[r32] = l_reg; asm volatile("s_waitcnt lgkmcnt(0)" ::: "memory");
  int lane_e = lane; asm volatile("" : "+v"(lane_e));
  const int r32e = lane_e & 31, hie = lane_e >> 5;
  float rli[16];
#pragma unroll
  for (int r = 0; r < 16; ++r) rli[r] = __builtin_amdgcn_rcpf(li_l[crow(r, hie)]);
  __syncthreads();
  bf16_t* stg = (bf16_t*)(lds + wid * 8192);
#pragma unroll
  for (int r = 0; r < 16; ++r) { const int orow = crow(r, hie);
#pragma unroll
    for (int d0 = 0; d0 < 4; ++d0) { const float v = o[d0][r] * rli[r]; stg[orow * 128 + d0 * 32 + r32e] = (bf16_t)(cvt_pk_bf16(v, v) & 0xffffu); } }
  asm volatile("s_waitcnt lgkmcnt(0)" ::: "memory");
#pragma unroll
  for (int i = 0; i < 8; ++i) { const int row = i * 4 + (lane_e >> 4), ch = lane_e & 15;
    const u32x4 v = *(const u32x4*)(stg + row * 128 + ch * 8);
    *(u32x4*)(Ob + (size_t)(wid * QBLK + row) * DM + ch * 8) = v;
    float q = bflo(v.x) * bflo(v.x) + bfhi(v.x) * bfhi(v.x) + bflo(v.y) * bflo(v.y) + bfhi(v.y) * bfhi(v.y) + bflo(v.z) * bflo(v.z) + bfhi(v.z) * bfhi(v.z) + bflo(v.w) * bflo(v.w) + bfhi(v.w) * bfhi(v.w);
    q += shflx(q, lane_e, 1); q += shflx(q, lane_e, 2); q += shflx(q, lane_e, 4); q += shflx(q, lane_e, 8);
    if (ch == 0) atomicAdd(ssq + wid * QBLK + row, q); }
  __syncthreads();
}
#undef SBAR
}

namespace lru {
constexpr int XROW = 136;
constexpr int X_BYTES = 256 * XROW * 2;
constexpr int COMP_OFF = X_BYTES, COMP_BYTES = 4 * 2 * 8 * 32 * 8;
constexpr int CARRY_OFF = COMP_OFF + COMP_BYTES;
constexpr int PRM_OFF = CARRY_OFF + 1024 + 32768;
constexpr int WB_OFF = CARRY_OFF + 1024;
template <bool REV> __device__ __forceinline__ void seg_comp(const float (&a)[16], const float (&bx)[16], float (&A)[4], float (&B)[4]) {
#pragma unroll
  for (int q = 0; q < 4; ++q) { float Aq = 1.f, Bq = 0.f;
#pragma unroll
    for (int ee = 0; ee < 4; ++ee) { const int e = REV ? 3 - ee : ee; const int r = 4 * q + e; Bq = a[r] * Bq + bx[r]; Aq *= a[r]; }
    A[q] = Aq; B[q] = Bq; }
}
template <bool REV> __device__ __forceinline__ float seg_prefix(const float (&loA)[4], const float (&loB)[4], const float (&hiA)[4], const float (&hiB)[4], int hi, float st, float (&start)[4]) {
#pragma unroll
  for (int qq = 0; qq < 4; ++qq) { const int q = REV ? 3 - qq : qq;
    if (!REV) { const float t1 = loA[q] * st + loB[q]; start[q] = hi ? t1 : st; st = hiA[q] * t1 + hiB[q]; }
    else { const float t1 = hiA[q] * st + hiB[q]; start[q] = hi ? st : t1; st = loA[q] * t1 + loB[q]; } }
  return st;
}
template <int PASS>
__device__ __forceinline__ void unit(const Params& p, int chunk, int n, char* lds, float* ssq_l) {
  int tid_ = threadIdx.x; asm volatile("" : "+v"(tid_));
  const int tid = tid_, wid = __builtin_amdgcn_readfirstlane(tid >> 6), lane = tid & 63, j = lane & 31, hi = lane >> 5;
  const int row0 = chunk * 256;
  int seq_start, seq_len;
  if (row0 < MP) { seq_start = row0 & ~(SEQP - 1); seq_len = SEQP; } else { seq_start = MP + ((row0 - MP) & ~(SEQS - 1)); seq_len = SEQS; }
  const int cs = (row0 - seq_start) >> 8, nch = seq_len >> 8, cbase = seq_start >> 8;
  const bf16_t* U = (const bf16_t*)(p.ws + WS_U);
  bf16_t* X = (bf16_t*)lds;
  f32x2* comp = (f32x2*)(lds + COMP_OFF);
  float* carry = (float*)(lds + CARRY_OFF);
  f32x2* agg = (f32x2*)(p.ws + WS_AGG);
  const bf16_t* Wf = (const bf16_t*)(p.ws + WS_BRG) + (size_t)n * 4 * 4 * 8 * 64 * 8;
  char* WB = lds + WB_OFF;
#define WSRC(cg, d, wh) (Wf + ((size_t)(((2 * (d) + (wh)) * 4 + (cg)) * 8) * 64 + tid) * 8)
  bf16x8 sw0 = *(const bf16x8*)WSRC(0, 0, 0), sw1 = *(const bf16x8*)WSRC(0, 0, 1);
  { const int cg8 = (tid & 15) * 8, tg = tid >> 4; const int c0 = n * 128 + cg8;
    const float* cw = p.in[10]; const float* cb = p.in[11];
    float w[4][8], bb[8];
#pragma unroll
    for (int t = 0; t < 4; ++t) { const f32x4 a = *(const f32x4*)(cw + t * 1024 + c0), b = *(const f32x4*)(cw + t * 1024 + c0 + 4);
      w[t][0] = a[0]; w[t][1] = a[1]; w[t][2] = a[2]; w[t][3] = a[3]; w[t][4] = b[0]; w[t][5] = b[1]; w[t][6] = b[2]; w[t][7] = b[3]; }
    { const f32x4 a = *(const f32x4*)(cb + c0), b = *(const f32x4*)(cb + c0 + 4); bb[0] = a[0]; bb[1] = a[1]; bb[2] = a[2]; bb[3] = a[3]; bb[4] = b[0]; bb[5] = b[1]; bb[6] = b[2]; bb[7] = b[3]; }
    u32x4 rw[11];
#pragma unroll
    for (int rr = 0; rr < 11; ++rr) { const int grow = row0 + tg * 8 + rr - 1; const bool ok = (grow >= seq_start) && (grow < seq_start + seq_len);
      rw[rr] = ok ? *(const u32x4*)(U + (size_t)grow * LDU + UC_X + c0) : (u32x4){0u, 0u, 0u, 0u}; }
#pragma unroll
    for (int t = 0; t < 8; ++t) { float y[8];
#pragma unroll
      for (int c = 0; c < 8; ++c) y[c] = bb[c];
#pragma unroll
      for (int tp = 0; tp < 4; ++tp) { const u32x4 v = rw[t + tp];
        y[0] += w[tp][0] * bflo(v.x); y[1] += w[tp][1] * bfhi(v.x); y[2] += w[tp][2] * bflo(v.y); y[3] += w[tp][3] * bfhi(v.y);
        y[4] += w[tp][4] * bflo(v.z); y[5] += w[tp][5] * bfhi(v.z); y[6] += w[tp][6] * bflo(v.w); y[7] += w[tp][7] * bfhi(v.w); }
      u32x4 o; o.x = cvt_pk_bf16(y[0], y[1]); o.y = cvt_pk_bf16(y[2], y[3]); o.z = cvt_pk_bf16(y[4], y[5]); o.w = cvt_pk_bf16(y[6], y[7]);
      *(u32x4*)(X + (tg * 8 + t) * XROW + cg8) = o; }
  }
  if (PASS == 2 && tid < 256) { const int dir = tid >> 7, ch = tid & 127; float st = 0.f;
    const int cnt = dir ? nch - 1 - cs : cs;
    for (int k0 = 0; k0 < cnt; k0 += 16) { f32x2 ab[16];
#pragma unroll
      for (int i = 0; i < 16; ++i) { const int k = k0 + i; const bool ok = k < cnt; const int c = ok ? (dir ? nch - 1 - k : k) : cs;
        ab[i] = agg[(size_t)(dir * NCHUNK + cbase + c) * 1024 + n * 128 + ch]; if (!ok) ab[i] = (f32x2){1.f, 0.f}; }
#pragma unroll
      for (int i = 0; i < 16; ++i) st = ab[i].x * st + ab[i].y; }
    carry[dir * 128 + ch] = st; }
  *(bf16x8*)(WB + tid * 16) = sw0; *(bf16x8*)(WB + 8192 + tid * 16) = sw1;
  if (tid < 256) { const int dir = tid >> 7, ch = tid & 127;
    const float lm = p.in[16][dir * 1024 + n * 128 + ch];
    *(f32x4*)(lds + PRM_OFF + (dir * 128 + ch) * 16) = (f32x4){p.in[13][(dir * 8 + n) * 128 + ch], p.in[15][(dir * 8 + n) * 128 + ch], (8.0f * 1.4426950408889634f) * log1pf(__expf(-lm)), 0.f}; }
  __syncthreads();
  const float* lam = p.in[16];
  const bf16_t* Xw = X + (32 * wid + j) * XROW + 8 * hi;
  for (int cgp = 0; cgp < 4; ++cgp) {
    const int ch = 32 * cgp + j, gch = n * 128 + ch;
    float sum[16];
    bf16_t graw[16];
    if (PASS == 2) { int rb = row0 + 32 * wid + 4 * hi; asm volatile("" : "+v"(rb));
#pragma unroll
      for (int r = 0; r < 16; ++r) graw[r] = U[(size_t)(rb + (r & 3) + 8 * (r >> 2)) * LDU + UC_G + gch];
    }
#pragma unroll
    for (int dir = 0; dir < 2; ++dir) {
      const bool has_next = !(cgp == 3 && dir == 1);
      if (has_next) { const int ncg = dir ? cgp + 1 : cgp; sw0 = *(const bf16x8*)WSRC(ncg, dir ^ 1, 0); sw1 = *(const bf16x8*)WSRC(ncg, dir ^ 1, 1); }
      f32x16 accr = f32x16{}, acci = f32x16{};
#pragma unroll
      for (int ks = 0; ks < 8; ++ks) { const bf16x8 xa = *(const bf16x8*)(Xw + 16 * ks);
        const bf16x8 bfr = *(const bf16x8*)(WB + dir * 16384 + ks * 1024 + lane * 16);
        const bf16x8 bfi = *(const bf16x8*)(WB + dir * 16384 + 8192 + ks * 1024 + lane * 16);
        accr = __builtin_amdgcn_mfma_f32_32x32x16_bf16(xa, bfr, accr, 0, 0, 0);
        acci = __builtin_amdgcn_mfma_f32_32x32x16_bf16(xa, bfi, acci, 0, 0, 0);
        if ((ks & 3) == 3) __builtin_amdgcn_sched_barrier(0); }
      const f32x4 prm = *(const f32x4*)(lds + PRM_OFF + (dir * 128 + ch) * 16);
      const float br = prm[0], bi = prm[1], c8 = prm[2];
      float a[16], bx[16];
#pragma unroll
      for (int r = 0; r < 16; ++r) { const float xv = bf2f(X[(32 * wid + crow(r, hi)) * XROW + ch]);
        const float rg = sigmoidf_(accr[r] + br), ig = sigmoidf_(acci[r] + bi);
        const float av = __builtin_amdgcn_exp2f(-c8 * rg); a[r] = av; bx[r] = __builtin_amdgcn_sqrtf(fmaxf(1.0f - av * av, 0.f)) * ig * xv; }
      float A[4], B[4], loA[4], loB[4], hiA[4], hiB[4], start[4];
      if (dir == 0) seg_comp<false>(a, bx, A, B); else seg_comp<true>(a, bx, A, B);
#pragma unroll
      for (int q = 0; q < 4; ++q) { const float pA = __shfl_xor(A[q], 32), pB = __shfl_xor(B[q], 32);
        loA[q] = hi ? pA : A[q]; loB[q] = hi ? pB : B[q]; hiA[q] = hi ? A[q] : pA; hiB[q] = hi ? B[q] : pB; }
      float Aw = 1.f;
#pragma unroll
      for (int q = 0; q < 4; ++q) Aw *= loA[q] * hiA[q];
      const float Bw = (dir == 0) ? seg_prefix<false>(loA, loB, hiA, hiB, hi, 0.f, start) : seg_prefix<true>(loA, loB, hiA, hiB, hi, 0.f, start);
      if (hi == 0) comp[((cgp * 2 + dir) * 8 + wid) * 32 + j] = (f32x2){Aw, Bw};
      if (has_next) { *(bf16x8*)(WB + (dir ^ 1) * 16384 + tid * 16) = sw0; *(bf16x8*)(WB + (dir ^ 1) * 16384 + 8192 + tid * 16) = sw1; }
      __syncthreads();
      if (PASS == 2) {
        float st = carry[dir * 128 + ch];
        if (dir == 0) { for (int w2 = 0; w2 < wid; ++w2) { const f32x2 ab = comp[((cgp * 2 + 0) * 8 + w2) * 32 + j]; st = ab.x * st + ab.y; } }
        else { for (int w2 = 7; w2 > wid; --w2) { const f32x2 ab = comp[((cgp * 2 + 1) * 8 + w2) * 32 + j]; st = ab.x * st + ab.y; } }
        if (dir == 0) { (void)seg_prefix<false>(loA, loB, hiA, hiB, hi, st, start);
#pragma unroll
          for (int q = 0; q < 4; ++q) { float h = start[q];
#pragma unroll
            for (int e = 0; e < 4; ++e) { const int r = 4 * q + e; h = a[r] * h + bx[r]; sum[r] = h; } } }
        else { (void)seg_prefix<true>(loA, loB, hiA, hiB, hi, st, start);
#pragma unroll
          for (int q = 0; q < 4; ++q) { float h = start[q];
#pragma unroll
            for (int ee = 0; ee < 4; ++ee) { const int r = 4 * q + 3 - ee; h = a[r] * h + bx[r]; sum[r] += h; } } }
      }
    }
    if (PASS == 2) {
      bf16_t* mixed = (bf16_t*)(p.ws + WS_XB);
      int rb2 = row0 + 32 * wid + 4 * hi, lane2 = lane; asm volatile("" : "+v"(rb2), "+v"(lane2));
#pragma unroll
      for (int r = 0; r < 16; ++r) { const int row = rb2 + (r & 3) + 8 * (r >> 2);
        const float g = bf2f(graw[r]);
        const float u3 = 0.7978845608028654f * (g + 0.044715f * g * g * g);
        const float th = 1.0f - 2.0f * __builtin_amdgcn_rcpf(1.0f + __builtin_amdgcn_exp2f((2.0f * 1.4426950408889634f) * u3));
        const float val = sum[r] * (0.5f * g * (1.0f + th));
        const unsigned pk = cvt_pk_bf16(val, val); const bf16_t hv = (bf16_t)(pk & 0xffffu);
        mixed[(size_t)row * DM + 1024 + gch] = hv;
        float q = bf2f(hv); q = q * q;
        q += shflx(q, lane2, 1); q += shflx(q, lane2, 2); q += shflx(q, lane2, 4); q += shflx(q, lane2, 8); q += shflx(q, lane2, 16);
        if ((lane2 & 31) == 0) atomicAdd(ssq_l + row, q); }
    }
  }
  if (PASS == 1) {
    __syncthreads();
    if (tid < 256) { const int dir = tid >> 7, ch = tid & 127, cgp = ch >> 5, jj = ch & 31; float A = 1.f, B = 0.f;
      if (dir == 0) { for (int w2 = 0; w2 < 8; ++w2) { const f32x2 ab = comp[((cgp * 2 + 0) * 8 + w2) * 32 + jj]; B = ab.x * B + ab.y; A *= ab.x; } }
      else { for (int w2 = 7; w2 >= 0; --w2) { const f32x2 ab = comp[((cgp * 2 + 1) * 8 + w2) * 32 + jj]; B = ab.x * B + ab.y; A *= ab.x; } }
      agg[(size_t)(dir * NCHUNK + chunk) * 1024 + n * 128 + ch] = (f32x2){A, B}; }
  }
  __syncthreads();
#undef WSRC
}
}

__device__ __forceinline__ void tr_item(const float* W, int ldw, int K, int srccol0, const float* gk, bf16_t* dst, int k0, LAS float* scr, int lane) {
  { const int n4 = (lane & 7) * 4; f32x4 v[8];
#pragma unroll
    for (int i = 0; i < 8; ++i) { const int kk = 8 * i + (lane >> 3); v[i] = (f32x4){0.f, 0.f, 0.f, 0.f};
      if (srccol0 >= 0) { v[i] = *(const f32x4*)(W + (size_t)(k0 + kk) * ldw + srccol0 + n4); if (gk) v[i] = v[i] * gk[kk]; } }
#pragma unroll
    for (int i = 0; i < 8; ++i) { const int kk = 8 * i + (lane >> 3); LAS float* d = scr + kk * 33 + n4; d[0] = v[i][0]; d[1] = v[i][1]; d[2] = v[i][2]; d[3] = v[i][3]; } }
  asm volatile("s_waitcnt lgkmcnt(0)" ::: "memory");
  const int c = lane & 7;
#pragma unroll
  for (int jq = 0; jq < 4; ++jq) { const int nn = (lane >> 3) + 8 * jq; const LAS float* s = scr + (8 * c) * 33 + nn;
    u32x4 o; o.x = cvt_pk_bf16(s[0 * 33], s[1 * 33]); o.y = cvt_pk_bf16(s[2 * 33], s[3 * 33]); o.z = cvt_pk_bf16(s[4 * 33], s[5 * 33]); o.w = cvt_pk_bf16(s[6 * 33], s[7 * 33]);
    *(u32x4*)(dst + (size_t)nn * K + k0 + 8 * c) = o; }
  asm volatile("s_waitcnt lgkmcnt(0)" ::: "memory");
}

__device__ __forceinline__ void p0_prologue(const Params& p, LAS unsigned char* lds, int vcu, int G) {
  int tid_ = threadIdx.x; asm volatile("" : "+v"(tid_));
  const int tid = tid_, lane = tid & 63, wave = __builtin_amdgcn_readfirstlane(tid >> 6);
  const int gw = vcu * 8 + wave, NGW = G * 8;
  const size_t gt = (size_t)blockIdx.x * 512 + tid, NGT = (size_t)G * 512;
  unsigned char* ws = p.ws;
  { float* z = (float*)(ws + WS_ZERO); for (size_t i = gt; i < ZERO_BYTES / 4; i += NGT) z[i] = 0.f; }
  { f32x2* rt = (f32x2*)(ws + WS_ROPE);
    for (size_t i = gt; i < (size_t)SEQP * 32; i += NGT) { const int s = (int)(i >> 5), f = (int)(i & 31);
      double rev = (double)s * INV_FREQ[f] * 0.15915494309189535; rev -= __builtin_rint(rev); const float r = (float)rev;
      rt[i] = (f32x2){__builtin_amdgcn_cosf(r), __builtin_amdgcn_sinf(r)}; } }
  { bf16_t* wf = (bf16_t*)(ws + WS_BRG);
    for (size_t ci = gt; ci < 65536; ci += NGT) { const int ln = (int)(ci & 63), ks = (int)((ci >> 6) & 7), cgp = (int)((ci >> 9) & 3), dw = (int)((ci >> 11) & 3), n = (int)(ci >> 13);
      const int jj = ln & 31, kg = ln >> 5, dir = dw >> 1, wh = dw & 1;
      const float* src = (wh ? p.in[14] : p.in[12]) + (size_t)(dir * 8 + n) * 128 * 128 + (size_t)(16 * ks + 8 * kg) * 128 + 32 * cgp + jj;
      u32x4 o; o.x = cvt_pk_bf16(src[0], src[128]); o.y = cvt_pk_bf16(src[256], src[384]); o.z = cvt_pk_bf16(src[512], src[640]); o.w = cvt_pk_bf16(src[768], src[896]);
      *(u32x4*)(wf + ci * 8) = o; } }
  { bf16_t* xb = (bf16_t*)(ws + WS_XB); float* rs1 = (float*)(ws + WS_RS1);
    for (int m0 = gw; m0 < M; m0 += 4 * NGW) {
      int mr[4]; const float* xr[4]; f32x4 v[4][8]; float ss[4];
#pragma unroll
      for (int t = 0; t < 4; ++t) { mr[t] = (m0 + t * NGW < M) ? m0 + t * NGW : m0; xr[t] = (mr[t] < MP) ? p.in[0] + (size_t)mr[t] * DM : p.in[1] + (size_t)(mr[t] - MP) * DM; }
#pragma unroll
      for (int q = 0; q < 8; ++q)
#pragma unroll
        for (int t = 0; t < 4; ++t) v[t][q] = *(const f32x4*)(xr[t] + q * 256 + lane * 4);
#pragma unroll
      for (int t = 0; t < 4; ++t) { float a = 0.f;
#pragma unroll
        for (int q = 0; q < 8; ++q) a += (v[t][q][0] * v[t][q][0] + v[t][q][1] * v[t][q][1]) + (v[t][q][2] * v[t][q][2] + v[t][q][3] * v[t][q][3]);
        ss[t] = wave_sum(a); }
      if (lane == 0) {
#pragma unroll
        for (int t = 0; t < 4; ++t) rs1[mr[t]] = 1.0f / sqrtf(ss[t] * (1.0f / DM) + EPS); }
#pragma unroll
      for (int t = 0; t < 4; ++t)
#pragma unroll
        for (int q = 0; q < 8; ++q) { u32x2 w; w.x = cvt_pk_bf16(v[t][q][0], v[t][q][1]); w.y = cvt_pk_bf16(v[t][q][2], v[t][q][3]); *(u32x2*)(xb + (size_t)mr[t] * DM + q * 256 + lane * 4) = w; } } }
  LAS float* scr = (LAS float*)(lds + wave * 16384);
  constexpr int I_IN = 96 * 32, I_UQ = 64 * 8, I_UKV = 64 * 4, I_OUT = 64 * 32, I_GU = 352 * 32, I_DN = 64 * 88;
  constexpr int NITEMS = I_IN + I_UQ + I_UKV + I_OUT + I_GU + I_DN;
  for (int it = gw; it < NITEMS; it += NGW) {
    int r = it;
    if (r < I_IN) { const int ng = r >> 5, kb = r & 31, dc = ng * 32; int sc;
      if (dc < 768) sc = dc; else if (dc < 1792) sc = dc - 768 + 832; else if (dc < 2816) sc = dc - 1792 + 1856; else if (dc < 2880) sc = dc - 2816 + 768; else sc = -1;
      tr_item(p.in[3], 2880, 2048, sc, p.in[2] + kb * 64, (bf16_t*)(ws + WS_BIN) + (size_t)dc * 2048, kb * 64, scr, lane); continue; } r -= I_IN;
    if (r < I_UQ) { const int ng = r >> 3, kb = r & 7, h = ng >> 3, t0 = (ng & 7) * 32; int d;
      if (t0 < 96) d = t0; else if (t0 == 96) d = 128; else if (t0 == 128) d = 96; else if (t0 == 224) d = 160; else d = -1;
      tr_item(p.in[5], 1536, 512, d < 0 ? -1 : h * 192 + d, p.in[4] + kb * 64, (bf16_t*)(ws + WS_BUQ) + (size_t)(ng * 32) * 512, kb * 64, scr, lane); continue; } r -= I_UQ;
    if (r < I_UKV) { const int ng = r >> 2, kb = r & 3;
      tr_item(p.in[7], 2048, 256, ng * 32, p.in[6] + kb * 64, (bf16_t*)(ws + WS_BUKV) + (size_t)(ng * 32) * 256, kb * 64, scr, lane); continue; } r -= I_UKV;
    if (r < I_OUT) { const int ng = r >> 5, kb = r & 31; const float* gk = (kb < 16) ? p.in[17] + kb * 64 : p.in[18] + (kb - 16) * 64;
      tr_item(p.in[19], 2048, 2048, ng * 32, gk, (bf16_t*)(ws + WS_BOUT) + (size_t)(ng * 32) * 2048, kb * 64, scr, lane); continue; } r -= I_OUT;
    if (r < I_GU) { const int ng = r >> 5, kb = r & 31, R = ng * 32, pn = R >> 8, within = R & 255, bj = within >> 7, c = within & 127;
      tr_item(bj ? p.in[22] : p.in[21], DFF, 2048, pn * 128 + c, p.in[20] + kb * 64, (bf16_t*)(ws + WS_BGU) + (size_t)R * 2048, kb * 64, scr, lane); continue; } r -= I_GU;
    { const int ng = r / 88, kb = r % 88;
      tr_item(p.in[23], 2048, DFF, ng * 32, nullptr, (bf16_t*)(ws + WS_BDN) + (size_t)(ng * 32) * DFF, kb * 64, scr, lane); }
  }
}

__global__ void __launch_bounds__(512, 2) hymba_fwd(Params p) {
  extern __shared__ __attribute__((aligned(16))) unsigned char lds[];
  cg::grid_group grid = cg::this_grid();
  LAS unsigned char* ldsl = (LAS unsigned char*)lds;
  const int G = gridDim.x, bx = blockIdx.x;
  const int vcu = (G % 8 == 0) ? (bx % 8) * (G / 8) + bx / 8 : bx;
  unsigned char* ws = p.ws;
  float* const dummy = (float*)(ws + WS_DUMMY);
#ifndef PROBE_TA
#define PROBE_TA -1
#define PROBE_TB -1
#endif
  unsigned long long t_a = 0, t_b = 0;
#define STAMP(k) do { if (PROBE_TA >= 0) { if ((k) == PROBE_TA) t_a = __builtin_amdgcn_s_memrealtime(); if ((k) == PROBE_TB) t_b = __builtin_amdgcn_s_memrealtime(); } } while (0)
  STAMP(0);

#ifndef NO_P0
  for (int rep = 0; rep < NREP(0); ++rep) p0_prologue(p, ldsl, vcu, G);
#endif
  grid.sync(); STAMP(1);

  for (int rep = 0; rep < NREP(1); ++rep) { pg8::Gemm g{(const bf16_t*)(ws + WS_XB), (const bf16_t*)(ws + WS_BIN), DM, LDU, DM}; pg8::StaticOrder S; S.init(M, LDU, G, bx);
    pg8::EpiU E{(bf16_t*)(ws + WS_U), (const float*)(ws + WS_RS1), rep ? dummy : (float*)(ws + WS_SSQ_Q), rep ? dummy : (float*)(ws + WS_SSQ_KV), rep ? dummy : (float*)(ws + WS_SSQ_PE)};

#ifndef NO_EPIU
    pg8::gemm_phase<pg8::EpiU>(ldsl, g, S, E);
#endif
  }
  grid.sync(); STAMP(2);

  for (int rep = 0; rep < NREP(2); ++rep) {
  { pg8::Gemm g{(const bf16_t*)(ws + WS_U) + UC_Q, (const bf16_t*)(ws + WS_BUQ), LDU, 2048, 512}; pg8::StaticOrder S; S.init(M, 2048, G, bx);
    pg8::EpiQ E{(bf16_t*)(ws + WS_Q), (const float*)(ws + WS_SSQ_Q), p.in[8], (const f32x2*)(ws + WS_ROPE), (LAS float*)(ldsl + XCH_OFF)};

#ifndef NO_EPIQ
    pg8::gemm_phase<pg8::EpiQ>(ldsl, g, S, E);
#endif
  }
  { pg8::Gemm g{(const bf16_t*)(ws + WS_U) + UC_KV, (const bf16_t*)(ws + WS_BUKV), LDU, 2048, 256}; pg8::StaticOrder S; S.init(M, 2048, G, bx);
    pg8::EpiKV E{(bf16_t*)(ws + WS_K), (bf16_t*)(ws + WS_V), (const bf16_t*)(ws + WS_U), (const float*)(ws + WS_SSQ_KV), (const float*)(ws + WS_SSQ_PE), p.in[9], (const f32x2*)(ws + WS_ROPE), (LAS float*)(ldsl + XCH_OFF)};

#ifndef NO_EPIKV
    pg8::gemm_phase<pg8::EpiKV>(ldsl, g, S, E);
#endif
  }
#ifndef NO_LRU1
  for (int u = vcu; u < NCHUNK * 8; u += G) lru::unit<1>(p, u >> 3, u & 7, (char*)lds, nullptr);
#endif
  }
  grid.sync(); STAMP(3);

#ifndef NO_LRU2
  for (int rep = 0; rep < NREP(3); ++rep)
  for (int u = vcu; u < NCHUNK * 8; u += G) lru::unit<2>(p, u >> 3, u & 7, (char*)lds, rep ? dummy : (float*)(ws + WS_SSQ_L));
#endif
  STAMP(4);

#ifndef NO_ATT
  { const bf16_t* Qt = (const bf16_t*)(ws + WS_Q); const bf16_t* Kt = (const bf16_t*)(ws + WS_K); const bf16_t* Vt = (const bf16_t*)(ws + WS_V);
    bf16_t* mixed = (bf16_t*)(ws + WS_XB); float* ssq_a = (float*)(ws + WS_SSQ_A);
    float kbound; { const int ln = threadIdx.x & 63; float gm = fmaxf(fmaxf(fabsf(p.in[9][ln]), fabsf(p.in[9][64 + ln])), fabsf(p.in[9][128 + ln]));
#pragma unroll
      for (int o = 1; o < 64; o <<= 1) gm = fmaxf(gm, __shfl_xor(gm, o));
      kbound = 13.856406460551018f * 1.02f * gm; }
    const int nrp = (1024 + G - 1) / G, nrs = (256 + G - 1) / G;
    for (int rep = 0; rep < NREP(4); ++rep)
    for (int i = 0; i < nrp + nrs; ++i) { int pl, qb, seq, row0; size_t prow;
      if (i < nrp) { if (G == 256) { pl = 2 * (vcu >> 5) + (i >> 1); qb = (vcu & 31) + 32 * (i & 1); } else { const int uu = i * G + vcu; if (uu >= 1024) continue; pl = uu >> 6; qb = uu & 63; }
        prow = (size_t)pl * SEQP; seq = SEQP; row0 = (pl >> 3) * SEQP + qb * 256; }
      else { const int uu = (i - nrp) * G + vcu; if (uu >= 256) continue; pl = uu >> 3; qb = uu & 7; prow = (size_t)MP * NH + (size_t)pl * SEQS; seq = SEQS; row0 = MP + (pl >> 3) * SEQS + qb * 256; }
      const int h = pl & 7;
      att::attn_unit(Qt + (prow + qb * 256) * DK, Kt + prow * DK, Vt + prow * DV, mixed + (size_t)row0 * DM + h * 128, (rep ? dummy : ssq_a) + row0, seq, kbound, (char*)lds, ldsl); }
  }
#endif
  grid.sync(); STAMP(5);

  for (int rep = 0; rep < NREP(5); ++rep) { pg8::Gemm g{(const bf16_t*)(ws + WS_XB), (const bf16_t*)(ws + WS_BOUT), DM, DM, DM}; pg8::StaticOrder S; S.init(M, DM, G, bx);
    pg8::EpiOut E{p.in[0], p.in[1], p.out, (bf16_t*)(ws + WS_U), (const float*)(ws + WS_SSQ_A), (const float*)(ws + WS_SSQ_L), rep ? dummy : (float*)(ws + WS_SSQ_2)};

#ifndef NO_EPIOUT
    pg8::gemm_phase<pg8::EpiOut>(ldsl, g, S, E);
#endif
  }
  grid.sync(); STAMP(6);

  for (int rep = 0; rep < NREP(6); ++rep) { pg8::Gemm g{(const bf16_t*)(ws + WS_U), (const bf16_t*)(ws + WS_BGU), DM, 2 * DFF, DM}; pg8::StaticOrder S; S.init(M, 2 * DFF, G, bx);
    pg8::EpiGU E{(bf16_t*)(ws + WS_ACT), (const float*)(ws + WS_SSQ_2)};

#ifndef NO_EPIGU
    pg8::gemm_phase<pg8::EpiGU>(ldsl, g, S, E);
#endif
  }
  grid.sync(); STAMP(7);

  { pg8::Gemm g{(const bf16_t*)(ws + WS_ACT), (const bf16_t*)(ws + WS_BDN), DFF, DM, DFF}; pg8::StaticOrder S; S.init(M, DM, G, bx);
    pg8::EpiDown E{p.out};

#ifndef NO_EPIDOWN
    pg8::gemm_phase<pg8::EpiDown>(ldsl, g, S, E);
#endif
  }
  if (PROBE_TA >= 0) { grid.sync(); STAMP(8); if (bx == 0 && threadIdx.x == 0) p.out[(size_t)MP * DM + 12345] += (float)(t_b - t_a) * 1e-5f; }
}

extern "C" void kernel_launch(void* const* d_in, const int* in_sizes, int n_in, void* d_out, int out_size, void* d_ws, size_t ws_size, hipStream_t stream) {
  static int grid = 0;
  if (grid == 0) {
    if (n_in != 24 || out_size != M * DM || ws_size < WS_END) { fprintf(stderr, "kernel_launch: unexpected shapes: n_in %d out %d ws %zu (need %zu)\n", n_in, out_size, ws_size, (size_t)WS_END); grid = -1; return; }
    int dev = 0, cus = 0, per_cu = 0;
    hipGetDevice(&dev); hipDeviceGetAttribute(&cus, hipDeviceAttributeMultiprocessorCount, dev);
    if (hipFuncSetAttribute((const void*)hymba_fwd, hipFuncAttributeMaxDynamicSharedMemorySize, LDS_BYTES) != hipSuccess) { fprintf(stderr, "kernel_launch: hipFuncSetAttribute failed\n"); grid = -1; return; }
    if (hipOccupancyMaxActiveBlocksPerMultiprocessor(&per_cu, (const void*)hymba_fwd, 512, LDS_BYTES) != hipSuccess || per_cu < 1) { fprintf(stderr, "kernel_launch: occupancy query says %d\n", per_cu); per_cu = 1; }
    (void)hipGetLastError();
    grid = cus * 1;
  }
  if (grid < 0) return;
  Params p{};
  for (int i = 0; i < 24; ++i) p.in[i] = (const float*)d_in[i];
  p.out = (float*)d_out; p.ws = (unsigned char*)d_ws;
  void* args[] = {&p};
  hipError_t e = hipLaunchCooperativeKernel((const void*)hymba_fwd, dim3(grid), dim3(512), args, LDS_BYTES, stream);
  if (e != hipSuccess) fprintf(stderr, "cooperative launch failed: %s (grid %d)\n", hipGetErrorString(e), grid);
}
```

```cpp
#include <hip/hip_runtime.h>
#include <hip/hip_cooperative_groups.h>
#include <cstdio>
#include <cstdint>
namespace cg = cooperative_groups;

#define LAS __attribute__((address_space(3)))
typedef unsigned short bf16_t;
typedef short bf16x8 __attribute__((ext_vector_type(8)));
typedef short s16x4 __attribute__((ext_vector_type(4)));
typedef float f32x4 __attribute__((ext_vector_type(4)));
typedef float f32x2 __attribute__((ext_vector_type(2)));
typedef float f32x16 __attribute__((ext_vector_type(16)));
typedef unsigned u32x4 __attribute__((ext_vector_type(4)));
typedef unsigned u32x2 __attribute__((ext_vector_type(2)));

constexpr int M = 40960, MP = 32768, SEQP = 16384, SEQS = 2048, DM = 2048;
constexpr int LDU = 3072, UC_Q = 0, UC_KV = 512, UC_X = 768, UC_G = 1792, UC_PE = 2816;
constexpr int NH = 8, DK = 192, DV = 128, DFF = 5632;
constexpr float EPS = 1e-6f;
constexpr int NCHUNK = M / 256;

constexpr size_t MiB = 1u << 20, KiB = 1024;
constexpr size_t WS_RS1 = 0;
constexpr size_t WS_ZERO = 256 * KiB;
constexpr size_t WS_SSQ_Q = WS_ZERO, WS_SSQ_KV = WS_ZERO + 256 * KiB, WS_SSQ_PE = WS_ZERO + 512 * KiB, WS_SSQ_A = WS_ZERO + 768 * KiB,
                 WS_SSQ_L = WS_ZERO + 1024 * KiB, WS_SSQ_2 = WS_ZERO + 1280 * KiB;
constexpr size_t ZERO_BYTES = 1536 * KiB;
constexpr size_t WS_ROPE = 2 * MiB;
constexpr size_t WS_AGG = 6 * MiB;
constexpr size_t WS_DUMMY = 9 * MiB;
constexpr size_t WS_BIN = 16 * MiB, WS_BUQ = 28 * MiB, WS_BUKV = 30 * MiB, WS_BRG = 31 * MiB, WS_BOUT = 32 * MiB, WS_BGU = 40 * MiB, WS_BDN = 84 * MiB;
constexpr size_t WS_XB = 112 * MiB;
constexpr size_t WS_U = 272 * MiB;
constexpr size_t WS_Q = 512 * MiB, WS_K = 632 * MiB, WS_V = 752 * MiB;
constexpr size_t WS_ACT = 512 * MiB;
constexpr size_t WS_END = 952 * MiB;

constexpr int RING_BYTES = 131072, XCH_OFF = 131072, LDS_BYTES = 147456;

#ifndef PROBE_REPEAT
#define PROBE_REPEAT 0
#endif
#define NREP(bit) ((PROBE_REPEAT >> (bit)) & 1 ? 2 : 1)
struct Params {
  const float* in[24];
  float* out;
  unsigned char* ws;
};

__device__ const double INV_FREQ[32] = {1.0, 0.7498942093324559, 0.5623413251903491, 0.4216965034285822, 0.31622776601683794, 0.23713737056616552, 0.1778279410038923, 0.1333521432163324, 0.1, 0.07498942093324558, 0.05623413251903491, 0.042169650342858224, 0.03162277660168379, 0.023713737056616554, 0.01778279410038923, 0.01333521432163324, 0.01, 0.007498942093324558, 0.005623413251903491, 0.004216965034285823, 0.0031622776601683794, 0.0023713737056616554, 0.0017782794100389228, 0.001333521432163324, 0.001, 0.0007498942093324559, 0.0005623413251903491, 0.00042169650342858224, 0.00031622776601683794, 0.00023713737056616554, 0.00017782794100389227, 0.0001333521432163324};

__device__ __forceinline__ unsigned cvt_pk_bf16(float lo, float hi) { unsigned r; asm volatile("v_cvt_pk_bf16_f32 %0, %1, %2" : "=v"(r) : "v"(lo), "v"(hi)); return r; }
__device__ __forceinline__ float bf2f(bf16_t v) { return __uint_as_float(((unsigned)v) << 16); }
__device__ __forceinline__ float bflo(unsigned w) { return __uint_as_float(w << 16); }
__device__ __forceinline__ float bfhi(unsigned w) { return __uint_as_float(w & 0xffff0000u); }
__device__ __forceinline__ float wave_sum(float v) {
#pragma unroll
  for (int o = 1; o < 64; o <<= 1) v += __shfl_xor(v, o);
  return v;
}
__device__ __forceinline__ float shflx(float v, int lane, int mask) { return __int_as_float(__builtin_amdgcn_ds_bpermute((lane ^ mask) << 2, __float_as_int(v))); }
__device__ __forceinline__ float sigmoidf_(float x) { return __builtin_amdgcn_rcpf(1.0f + __builtin_amdgcn_exp2f(x * -1.4426950408889634f)); }
__device__ __forceinline__ int crow(int r, int hi) { return (r & 3) + 8 * (r >> 2) + 4 * hi; }
__device__ __forceinline__ size_t plane_row(int m, int h) {
  if (m < MP) { const int b = m >> 14, s = m & (SEQP - 1); return ((size_t)(b * NH + h) * SEQP + s); }
  const int mm = m - MP, b = mm >> 11, s = mm & (SEQS - 1); return (size_t)MP * NH + ((size_t)(b * NH + h) * SEQS + s);
}
__device__ __forceinline__ int seq_pos(int m) { return m < MP ? (m & (SEQP - 1)) : ((m - MP) & (SEQS - 1)); }

namespace pg8 {
constexpr int BM = 256, BK = 64, HALF = 128, HTB = HALF * BK * 2, STAGE_BYTES = 8 * HTB, NXCD = 8, WGM = 8;
__host__ __device__ __forceinline__ int lds_byte(int r, int c) { const int st = (r >> 4) * 2 + (c >> 5), rr = r & 15, cc = c & 31, ob = rr * 64 + cc * 2; return st * 1024 + (ob ^ (((ob >> 9) & 1) << 5)); }
__host__ __device__ __forceinline__ void stage_rc(int b, int& R, int& C) { const int st = b / 1024, sb = b % 1024, swz = sb ^ (((sb >> 9) & 1) << 5); R = (st >> 1) * 16 + swz / 64; C = (st & 1) * 32 + (swz % 64) / 2; }
__host__ __device__ __forceinline__ int perm32(int rho) { const int n = rho >> 4, i = rho & 15; return 8 * (i >> 2) + 4 * n + (i & 3); }
struct Unit { int pm, pn; };
struct Gemm { const bf16_t* A; const bf16_t* Bt; int lda, N, K; };
struct StaticOrder {
  int nM, nN, nwg, G, c;
  __device__ void init(int Mr, int N, int G_, int c_) { nM = Mr / BM; nN = N / BM; nwg = nM * nN; G = G_; c = c_; }
  __device__ bool next(int i, Unit& u) const {
    const long L = (long)i * G + c; if (L >= nwg) return false;
    int wgid = (int)L; { const int q = nwg / NXCD, r = nwg % NXCD, xcd = wgid % NXCD, off = wgid / NXCD; wgid = (xcd < r ? xcd * (q + 1) : r * (q + 1) + (xcd - r) * q) + off; }
    const int nig = WGM * nN, gid = wgid / nig, fm = gid * WGM, gsz = (nM - fm) < WGM ? (nM - fm) : WGM;
    u.pm = fm + ((wgid % nig) % gsz); u.pn = (wgid % nig) / gsz; return true;
  }
};
template <class Epi>
__device__ __forceinline__ void gemm_phase(LAS unsigned char* lds, const Gemm g, const StaticOrder& S, const Epi& E) {
  int tid_ = threadIdx.x; asm volatile("" : "+v"(tid_));
  const int tid = tid_, wid = __builtin_amdgcn_readfirstlane(tid >> 6), lane = tid & 63, wr = wid >> 2, wc = wid & 3, fr = lane & 15, fq = lane >> 4;
  const int K = g.K, nt = K / BK, lda = g.lda;
  unsigned voffA[2], voffB[2];
#pragma unroll
  for (int i = 0; i < 2; ++i) { int R, C; stage_rc(tid * 16 + i * 8192, R, C); const int Rb = Epi::PERM ? ((R & ~31) + perm32(R & 31)) : R;
    voffA[i] = (unsigned)(R * lda + C) * 2u; voffB[i] = (unsigned)(Rb * K + C) * 2u; }
  const size_t kstep = (size_t)(BK * 2);
  const size_t hstepA = (size_t)HALF * lda * 2, hstepB = (size_t)HALF * K * 2;
  const size_t tstepA = 2 * hstepA, tstepB = 2 * hstepB;
  const unsigned ldsw = (unsigned)wid * 1024u;
  const int aoff = lds_byte(wr * 64 + fr, fq * 8), boff = lds_byte(wc * 32 + fr, fq * 8);
#define PG8_SA(b, h) (((b) * 2 + (h)) * HTB)
#define PG8_SB(b, h) ((4 + (b) * 2 + (h)) * HTB)
#define PG8_STAGE(bufoff, gbase, voff) do { _Pragma("unroll") for (int _i = 0; _i < 2; ++_i) \
    __builtin_amdgcn_global_load_lds((const unsigned*)((const char*)(gbase) + (voff)[_i]), (LAS unsigned*)(lds + (bufoff) + ldsw + _i * 8192), 16, 0, 0); } while (0)
#define PG8_LDA(dst, b, h) do { _Pragma("unroll") for (int m = 0; m < 4; ++m) _Pragma("unroll") for (int k = 0; k < 2; ++k) dst[m][k] = *(const LAS bf16x8*)(lds + PG8_SA(b, h) + aoff + m * 2048 + k * 1024); } while (0)
#define PG8_LDB(dst, b, h) do { _Pragma("unroll") for (int n = 0; n < 2; ++n) _Pragma("unroll") for (int k = 0; k < 2; ++k) dst[n][k] = *(const LAS bf16x8*)(lds + PG8_SB(b, h) + boff + n * 2048 + k * 1024); } while (0)
#define PG8_MMA(ai, bj, At, Bt) do { __builtin_amdgcn_s_setprio(1); _Pragma("unroll") for (int m = 0; m < 4; ++m) _Pragma("unroll") for (int n = 0; n < 2; ++n) _Pragma("unroll") for (int k = 0; k < 2; ++k) \
    acc[ai][bj][m][n] = __builtin_amdgcn_mfma_f32_16x16x32_bf16(Bt[n][k], At[m][k], acc[ai][bj][m][n], 0, 0, 0); __builtin_amdgcn_s_setprio(0); } while (0)
#define PG8_WAIT_V(n) asm volatile("s_waitcnt vmcnt(" #n ")" ::: "memory")
#define PG8_WAIT_L(n) asm volatile("s_waitcnt lgkmcnt(" #n ")" ::: "memory")
#define PG8_BAR __builtin_amdgcn_s_barrier()
#define PG8_SCHED __builtin_amdgcn_sched_barrier(0)
  Unit cur, nxt; int ui = 0;
  if (!S.next(0, cur)) return;
  f32x4 acc[2][2][4][2];
#pragma unroll
  for (int a = 0; a < 2; ++a)
#pragma unroll
    for (int b = 0; b < 2; ++b)
#pragma unroll
      for (int m = 0; m < 4; ++m)
#pragma unroll
        for (int n = 0; n < 2; ++n) acc[a][b][m][n] = (f32x4){0.f, 0.f, 0.f, 0.f};
  bf16x8 At[4][2], B0[2][2], B1[2][2];
  const char* cA = (const char*)g.A + (size_t)cur.pm * tstepA; const char* cB = (const char*)g.Bt + (size_t)cur.pn * tstepB;
  PG8_STAGE(PG8_SB(0, 0), cB, voffB); PG8_STAGE(PG8_SB(0, 1), cB + hstepB, voffB); PG8_STAGE(PG8_SA(0, 0), cA, voffA); PG8_STAGE(PG8_SA(0, 1), cA + hstepA, voffA);
  if (wr == 1) PG8_BAR;
  PG8_WAIT_V(2); PG8_BAR;
  PG8_STAGE(PG8_SB(1, 0), cB + kstep, voffB); PG8_STAGE(PG8_SA(1, 0), cA + kstep, voffA); PG8_STAGE(PG8_SB(1, 1), cB + hstepB + kstep, voffB);
  PG8_WAIT_V(6); PG8_BAR;
  for (;;) {
    const bool has_next = S.next(ui + 1, nxt);
    const char* nA = has_next ? (const char*)g.A + (size_t)nxt.pm * tstepA : cA; const char* nB = has_next ? (const char*)g.Bt + (size_t)nxt.pn * tstepB : cB;
    for (int t = 0; t < nt; t += 2) {
      const bool last = (t == nt - 2);
      const char* a1 = cA + (size_t)(t + 1) * kstep;
      const char* a2 = last ? nA : cA + (size_t)(t + 2) * kstep; const char* b2 = last ? nB : cB + (size_t)(t + 2) * kstep;
      const char* a3 = a2 + kstep; const char* b3 = b2 + kstep;
      if constexpr (Epi::MIDK) { if (t == (nt >> 1)) E.mid(acc, cur, wr, fr); }
      PG8_LDB(B0, 0, 0); PG8_LDB(B1, 0, 1); PG8_SCHED; PG8_LDA(At, 0, 0); PG8_STAGE(PG8_SA(1, 1), a1 + hstepA, voffA);
      PG8_WAIT_V(8); PG8_WAIT_L(0); PG8_BAR; PG8_MMA(0, 0, At, B0); PG8_MMA(0, 1, At, B1); PG8_BAR; PG8_SCHED;
      PG8_LDA(At, 0, 1); PG8_STAGE(PG8_SB(0, 0), b2, voffB); PG8_STAGE(PG8_SB(0, 1), b2 + hstepB, voffB); PG8_STAGE(PG8_SA(0, 0), a2, voffA);
      PG8_WAIT_V(8); PG8_WAIT_L(0); PG8_BAR; PG8_MMA(1, 0, At, B0); PG8_MMA(1, 1, At, B1); PG8_BAR; PG8_SCHED;
      PG8_LDB(B0, 1, 0); PG8_LDB(B1, 1, 1); PG8_SCHED; PG8_LDA(At, 1, 0); PG8_STAGE(PG8_SA(0, 1), a2 + hstepA, voffA);
      PG8_WAIT_V(8); PG8_WAIT_L(0); PG8_BAR; PG8_MMA(0, 0, At, B0); PG8_MMA(0, 1, At, B1); PG8_BAR; PG8_SCHED;
      PG8_LDA(At, 1, 1); PG8_STAGE(PG8_SB(1, 0), b3, voffB); PG8_STAGE(PG8_SB(1, 1), b3 + hstepB, voffB); PG8_STAGE(PG8_SA(1, 0), a3, voffA);
      PG8_WAIT_V(8); PG8_WAIT_L(0); PG8_BAR; PG8_MMA(1, 0, At, B0); PG8_MMA(1, 1, At, B1); PG8_BAR; PG8_SCHED;
    }
    if (wr == 0) PG8_BAR;
    E(acc, cur, wr, wc, fr, fq);
    if (!has_next) break;
#pragma unroll
    for (int a = 0; a < 2; ++a)
#pragma unroll
      for (int b = 0; b < 2; ++b)
#pragma unroll
        for (int m = 0; m < 4; ++m)
#pragma unroll
          for (int n = 0; n < 2; ++n) acc[a][b][m][n] = (f32x4){0.f, 0.f, 0.f, 0.f};
    cur = nxt; cA = nA; cB = nB; ++ui;
    if (wr == 1) PG8_BAR;
  }
  PG8_WAIT_V(0);
  PG8_BAR;
#undef PG8_SA
#undef PG8_SB
#undef PG8_STAGE
#undef PG8_LDA
#undef PG8_LDB
#undef PG8_MMA
}

struct EpiU {
  static constexpr bool PERM = true, MIDK = false;
  bf16_t* U; const float* rs1; float* ssq_q; float* ssq_kv; float* ssq_pe;
  __device__ __forceinline__ void operator()(const f32x4 (&acc)[2][2][4][2], const Unit& u, int wr, int wc, int fr_, int fq_) const {
    int fr = fr_, fq = fq_; asm volatile("" : "+v"(fr), "+v"(fq));
    float* ssq = (u.pn < 2) ? ssq_q : (u.pn == 2 ? ssq_kv : (u.pn == 11 ? ssq_pe : (float*)nullptr));
    const int col0 = u.pn * BM + wc * 32 + 8 * fq;
#pragma unroll
    for (int ai = 0; ai < 2; ++ai)
#pragma unroll
      for (int m = 0; m < 4; ++m) {
        const int row = u.pm * BM + ai * HALF + wr * 64 + m * 16 + fr; const float s = rs1[row]; float q = 0.f;
        bf16_t* rowp = U + (size_t)row * LDU + col0;
#pragma unroll
        for (int bj = 0; bj < 2; ++bj) { const f32x4 v0 = acc[ai][bj][m][0] * s, v1 = acc[ai][bj][m][1] * s;
          q += (v0[0] * v0[0] + v0[1] * v0[1]) + (v0[2] * v0[2] + v0[3] * v0[3]) + (v1[0] * v1[0] + v1[1] * v1[1]) + (v1[2] * v1[2] + v1[3] * v1[3]);
          u32x4 w; w.x = cvt_pk_bf16(v0[0], v0[1]); w.y = cvt_pk_bf16(v0[2], v0[3]); w.z = cvt_pk_bf16(v1[0], v1[1]); w.w = cvt_pk_bf16(v1[2], v1[3]);
          *(u32x4*)(rowp + bj * HALF) = w; }
        if (ssq) { q += __shfl_xor(q, 16); q += __shfl_xor(q, 32); if (fq == 0) atomicAdd(ssq + row, q); }
      }
  }
};

struct EpiQ {
  static constexpr bool PERM = false, MIDK = false;
  bf16_t* Q; const float* ssq_q; const float* g_qn; const f32x2* rope; LAS float* xch;
  __device__ __forceinline__ void operator()(const f32x4 (&acc)[2][2][4][2], const Unit& u, int wr, int wc, int fr_, int fq_) const {
    int fr = fr_, fq = fq_; asm volatile("" : "+v"(fr), "+v"(fq));
    float rsq[2][4];
#pragma unroll
    for (int ai = 0; ai < 2; ++ai)
#pragma unroll
      for (int m = 0; m < 4; ++m) {
        const int rl = ai * HALF + wr * 64 + m * 16 + fr; const int row = u.pm * BM + rl;
        const float s = __builtin_amdgcn_rsqf(ssq_q[row] * (1.0f / 512.0f) + EPS); rsq[ai][m] = s; float q = 0.f;
#pragma unroll
        for (int bj = 0; bj < 2; ++bj)
#pragma unroll
          for (int n = 0; n < 2; ++n) { const f32x4 v = acc[ai][bj][m][n] * s; q += (v[0] * v[0] + v[1] * v[1]) + (v[2] * v[2] + v[3] * v[3]); }
        q += __shfl_xor(q, 16); q += __shfl_xor(q, 32);
        if (fq == 0) xch[rl * 4 + wc] = q;
      }
    asm volatile("s_waitcnt lgkmcnt(0)" ::: "memory"); __builtin_amdgcn_s_barrier(); asm volatile("" ::: "memory");
    const int h = u.pn;
#pragma unroll
    for (int ai = 0; ai < 2; ++ai)
#pragma unroll
      for (int m = 0; m < 4; ++m) {
        const int rl = ai * HALF + wr * 64 + m * 16 + fr; const int row = u.pm * BM + rl;
        const f32x4 pq = *(const LAS f32x4*)(xch + rl * 4);
        const float tot = (pq[0] + pq[1]) + (pq[2] + pq[3]);
        const float sc = rsq[ai][m] * __builtin_amdgcn_rsqf(tot * (1.0f / 192.0f) + EPS) * 0.10411754627697264f;
        bf16_t* qrow = Q + (plane_row(row, h)) * DK;
        if (wc == 3) {
          const int s = seq_pos(row);
#pragma unroll
          for (int n = 0; n < 2; ++n) { const int i0 = 16 * n + 4 * fq;
            const f32x4 g1 = *(const f32x4*)(g_qn + 128 + i0), g2 = *(const f32x4*)(g_qn + 160 + i0);
            const f32x4 x1 = acc[ai][0][m][n] * sc * g1, x2 = acc[ai][1][m][n] * sc * g2; float o1[4], o2[4];
#pragma unroll
            for (int j = 0; j < 4; ++j) { const f32x2 cs = rope[(size_t)s * 32 + i0 + j]; o1[j] = x1[j] * cs.x - x2[j] * cs.y; o2[j] = x2[j] * cs.x + x1[j] * cs.y; }
            u32x2 w1, w2; w1.x = cvt_pk_bf16(o1[0], o1[1]); w1.y = cvt_pk_bf16(o1[2], o1[3]); w2.x = cvt_pk_bf16(o2[0], o2[1]); w2.y = cvt_pk_bf16(o2[2], o2[3]);
            *(u32x2*)(qrow + 128 + i0) = w1; *(u32x2*)(qrow + 160 + i0) = w2; }
        } else {
#pragma unroll
          for (int n = 0; n < 2; ++n) { const int d = 32 * wc + 16 * n + 4 * fq;
            const f32x4 gg = *(const f32x4*)(g_qn + d); const f32x4 v = acc[ai][0][m][n] * sc * gg;
            u32x2 w; w.x = cvt_pk_bf16(v[0], v[1]); w.y = cvt_pk_bf16(v[2], v[3]); *(u32x2*)(qrow + d) = w; }
          if (wc == 0) {
#pragma unroll
            for (int n = 0; n < 2; ++n) { const int d = 96 + 16 * n + 4 * fq;
              const f32x4 gg = *(const f32x4*)(g_qn + d); const f32x4 v = acc[ai][1][m][n] * sc * gg;
              u32x2 w; w.x = cvt_pk_bf16(v[0], v[1]); w.y = cvt_pk_bf16(v[2], v[3]); *(u32x2*)(qrow + d) = w; }
          }
        }
      }
  }
};

struct EpiKV {
  static constexpr bool PERM = false, MIDK = false;
  bf16_t* Kt; bf16_t* Vt; const bf16_t* U; const float* ssq_kv; const float* ssq_pe; const float* g_kn; const f32x2* rope; LAS float* xch;
  __device__ __forceinline__ void operator()(const f32x4 (&acc)[2][2][4][2], const Unit& u, int wr, int wc, int fr_, int fq_) const {
    int fr = fr_, fq = fq_; asm volatile("" : "+v"(fr), "+v"(fq));
    float rsq[2][4];
#pragma unroll
    for (int ai = 0; ai < 2; ++ai)
#pragma unroll
      for (int m = 0; m < 4; ++m) {
        const int rl = ai * HALF + wr * 64 + m * 16 + fr; const int row = u.pm * BM + rl;
        const float s = __builtin_amdgcn_rsqf(ssq_kv[row] * (1.0f / 256.0f) + EPS); rsq[ai][m] = s; float q = 0.f;
#pragma unroll
        for (int n = 0; n < 2; ++n) { const f32x4 v = acc[ai][0][m][n] * s; q += (v[0] * v[0] + v[1] * v[1]) + (v[2] * v[2] + v[3] * v[3]); }
        q += __shfl_xor(q, 16); q += __shfl_xor(q, 32);
        if (fq == 0) xch[rl * 4 + wc] = q;
      }
    asm volatile("s_waitcnt lgkmcnt(0)" ::: "memory"); __builtin_amdgcn_s_barrier(); asm volatile("" ::: "memory");
    const int h = u.pn;
#pragma unroll
    for (int ai = 0; ai < 2; ++ai)
#pragma unroll
      for (int m = 0; m < 4; ++m) {
        const int rl = ai * HALF + wr * 64 + m * 16 + fr; const int row = u.pm * BM + rl;
        const f32x4 pq = *(const LAS f32x4*)(xch + rl * 4);
        const float tot = (pq[0] + pq[1]) + (pq[2] + pq[3]) + ssq_pe[row];
        const float rstd = __builtin_amdgcn_rsqf(tot * (1.0f / 192.0f) + EPS);
        const float sc = rsq[ai][m] * rstd;
        const size_t pr = plane_row(row, h);
        bf16_t* krow = Kt + pr * DK; bf16_t* vrow = Vt + pr * DV;
#pragma unroll
        for (int n = 0; n < 2; ++n) { const int d = 32 * wc + 16 * n + 4 * fq;
          const f32x4 gg = *(const f32x4*)(g_kn + d); const f32x4 kv = acc[ai][0][m][n] * sc * gg; const f32x4 vv = acc[ai][1][m][n] * rsq[ai][m];
          u32x2 w; w.x = cvt_pk_bf16(kv[0], kv[1]); w.y = cvt_pk_bf16(kv[2], kv[3]); *(u32x2*)(krow + d) = w;
          u32x2 wv; wv.x = cvt_pk_bf16(vv[0], vv[1]); wv.y = cvt_pk_bf16(vv[2], vv[3]); *(u32x2*)(vrow + d) = wv; }
        { const int i0 = 8 * wc + 2 * fq; const int s = seq_pos(row);
          const unsigned p1 = *(const unsigned*)(U + (size_t)row * LDU + UC_PE + i0), p2 = *(const unsigned*)(U + (size_t)row * LDU + UC_PE + 32 + i0);
          const float x1a = bflo(p1) * rstd * g_kn[128 + i0], x1b = bfhi(p1) * rstd * g_kn[128 + i0 + 1];
          const float x2a = bflo(p2) * rstd * g_kn[160 + i0], x2b = bfhi(p2) * rstd * g_kn[160 + i0 + 1];
          const f32x2 ca = rope[(size_t)s * 32 + i0], cb = rope[(size_t)s * 32 + i0 + 1];
          *(unsigned*)(krow + 128 + i0) = cvt_pk_bf16(x1a * ca.x - x2a * ca.y, x1b * cb.x - x2b * cb.y);
          *(unsigned*)(krow + 160 + i0) = cvt_pk_bf16(x2a * ca.x + x1a * ca.y, x2b * cb.x + x1b * cb.y); }
        asm volatile("" ::: "memory");
      }
  }
};

struct EpiOut {
  static constexpr bool PERM = false, MIDK = true;
  const float* xp; const float* xs; float* out; bf16_t* x1b; const float* ssq_a; const float* ssq_l; float* ssq2;
  __device__ __forceinline__ void mid(f32x4 (&acc)[2][2][4][2], const Unit& u, int wr, int fr_) const {
    int fr = fr_; asm volatile("" : "+v"(fr));
#pragma unroll
    for (int ai = 0; ai < 2; ++ai)
#pragma unroll
      for (int m = 0; m < 4; ++m) { const int row = u.pm * BM + ai * HALF + wr * 64 + m * 16 + fr;
        const float sa = __builtin_amdgcn_rsqf(ssq_a[row] * (1.0f / 1024.0f) + EPS), sl = __builtin_amdgcn_rsqf(ssq_l[row] * (1.0f / 1024.0f) + EPS);
        const float ratio = sa / sl;
#pragma unroll
        for (int bj = 0; bj < 2; ++bj)
#pragma unroll
          for (int n = 0; n < 2; ++n) acc[ai][bj][m][n] *= ratio; }
  }
  __device__ __forceinline__ void operator()(const f32x4 (&acc)[2][2][4][2], const Unit& u, int wr, int wc, int fr_, int fq_) const {
    int fr = fr_, fq = fq_; asm volatile("" : "+v"(fr), "+v"(fq));
    const int col0 = u.pn * BM + wc * 32 + 4 * fq;
#pragma unroll
    for (int ai = 0; ai < 2; ++ai)
#pragma unroll
      for (int m = 0; m < 4; ++m) { const int row = u.pm * BM + ai * HALF + wr * 64 + m * 16 + fr;
        const float sl = __builtin_amdgcn_rsqf(ssq_l[row] * (1.0f / 1024.0f) + EPS);
        const float* xrow = (row < MP) ? xp + (size_t)row * DM : xs + (size_t)(row - MP) * DM; float q = 0.f;
#pragma unroll
        for (int bj = 0; bj < 2; ++bj)
#pragma unroll
          for (int n = 0; n < 2; ++n) { const int c = col0 + bj * HALF + n * 16;
            const f32x4 xv = *(const f32x4*)(xrow + c); const f32x4 o = xv + acc[ai][bj][m][n] * sl;
            *(f32x4*)(out + (size_t)row * DM + c) = o; q += (o[0] * o[0] + o[1] * o[1]) + (o[2] * o[2] + o[3] * o[3]);
            u32x2 w; w.x = cvt_pk_bf16(o[0], o[1]); w.y = cvt_pk_bf16(o[2], o[3]); *(u32x2*)(x1b + (size_t)row * DM + c) = w; }
        q += __shfl_xor(q, 16); q += __shfl_xor(q, 32); if (fq == 0) atomicAdd(ssq2 + row, q); }
  }
};

struct EpiGU {
  static constexpr bool PERM = true, MIDK = false;
  bf16_t* act; const float* ssq2;
  __device__ __forceinline__ void operator()(const f32x4 (&acc)[2][2][4][2], const Unit& u, int wr, int wc, int fr_, int fq_) const {
    int fr = fr_, fq = fq_; asm volatile("" : "+v"(fr), "+v"(fq));
    const int col0 = u.pn * HALF + wc * 32 + 8 * fq;
#pragma unroll
    for (int ai = 0; ai < 2; ++ai)
#pragma unroll
      for (int m = 0; m < 4; ++m) { const int row = u.pm * BM + ai * HALF + wr * 64 + m * 16 + fr;
        const float rs = __builtin_amdgcn_rsqf(ssq2[row] * (1.0f / 2048.0f) + EPS);
        float r[8];
#pragma unroll
        for (int n = 0; n < 2; ++n)
#pragma unroll
          for (int j = 0; j < 4; ++j) { const float gv = acc[ai][0][m][n][j] * rs, uv = acc[ai][1][m][n][j] * rs; r[n * 4 + j] = gv * sigmoidf_(gv) * uv; }
        u32x4 w; w.x = cvt_pk_bf16(r[0], r[1]); w.y = cvt_pk_bf16(r[2], r[3]); w.z = cvt_pk_bf16(r[4], r[5]); w.w = cvt_pk_bf16(r[6], r[7]);
        *(u32x4*)(act + (size_t)row * DFF + col0) = w; }
  }
};

struct EpiDown {
  static constexpr bool PERM = false, MIDK = false;
  float* out;
  __device__ __forceinline__ void operator()(const f32x4 (&acc)[2][2][4][2], const Unit& u, int wr, int wc, int fr_, int fq_) const {
    int fr = fr_, fq = fq_; asm volatile("" : "+v"(fr), "+v"(fq));
    const int col0 = u.pn * BM + wc * 32 + 4 * fq;
#pragma unroll
    for (int ai = 0; ai < 2; ++ai)
#pragma unroll
      for (int m = 0; m < 4; ++m) { const int row = u.pm * BM + ai * HALF + wr * 64 + m * 16 + fr;
#pragma unroll
        for (int bj = 0; bj < 2; ++bj)
#pragma unroll
          for (int n = 0; n < 2; ++n) { float* p = out + (size_t)row * DM + col0 + bj * HALF + n * 16; const f32x4 xv = *(const f32x4*)p; *(f32x4*)p = xv + acc[ai][bj][m][n]; } }
  }
};
}

namespace att {
constexpr int NW = 8, QBLK = 32, KVBLK = 64;
constexpr float QSCALE = 0.10411754627697264f;
constexpr int KROWB = 400;
constexpr int SHM_V = KVBLK * DV * 2, SHM_K = KVBLK * KROWB;
constexpr int QRP = 144;
constexpr int SHM_WS = 3 * SHM_V + 2 * SHM_K, SHM_QR = SHM_WS + NW * 64 * 4, SHM_ATTN = SHM_QR + NW * 32 * QRP;
static_assert(SHM_ATTN <= LDS_BYTES, "attention LDS");
#define SBAR() __builtin_amdgcn_sched_barrier(0)
#define SGB(mask, n) __builtin_amdgcn_sched_group_barrier(mask, n, 0)
__device__ __forceinline__ void sched_qk_sm() {
  SGB(0x100, 4);
#pragma unroll
  for (int i = 0; i < 10; ++i) { SGB(0x008, 2); SGB(0x100, 2); SGB(0x402, 8); }
#pragma unroll
  for (int i = 0; i < 2; ++i) { SGB(0x008, 2); SGB(0x402, 8); }
}
typedef __bf16 bf16x2_t __attribute__((ext_vector_type(2)));
__device__ __forceinline__ unsigned cvtpk_s(float lo, float hi) { f32x2 v = {lo, hi}; bf16x2_t b = __builtin_convertvector(v, bf16x2_t); return __builtin_bit_cast(unsigned, b); }
__device__ __forceinline__ void expA(f32x16& p0) {
#pragma unroll
  for (int r = 0; r < 16; ++r) p0[r] = __builtin_amdgcn_exp2f(p0[r]);
}
__device__ __forceinline__ void finishSM(f32x16& p0, f32x16& p1, float& l_reg, bf16x8& pa0, bf16x8& pa1, bf16x8& pa2, bf16x8& pa3) {
#pragma unroll
  for (int r = 0; r < 16; ++r) p1[r] = __builtin_amdgcn_exp2f(p1[r]);
  float ps = 0;
#pragma unroll
  for (int r = 0; r < 16; ++r) ps += p0[r];
#pragma unroll
  for (int r = 0; r < 16; ++r) ps += p1[r];
  l_reg += ps;
#define PK4(P, BASE, OUT) do { u32x4 w = {cvtpk_s(P[BASE + 0], P[BASE + 1]), cvtpk_s(P[BASE + 2], P[BASE + 3]), cvtpk_s(P[BASE + 4], P[BASE + 5]), cvtpk_s(P[BASE + 6], P[BASE + 7])}; \
    OUT = *reinterpret_cast<bf16x8*>(&w); } while (0)
  PK4(p0, 0, pa0); PK4(p0, 8, pa1); PK4(p1, 0, pa2); PK4(p1, 8, pa3);
#undef PK4
}
__device__ __forceinline__ void qkt(f32x16& p0, f32x16& p1, const char* Ks, const bf16x8* qr, const char* qrl, const f32x16& negm, int r32, int hi) {
  p0 = negm; p1 = negm;
#pragma unroll
  for (int d0 = 0; d0 < 12; ++d0) { const int cb = (d0 * 16 + hi * 8) * 2;
    const bf16x8 b0 = *reinterpret_cast<const bf16x8*>(Ks + r32 * KROWB + cb);
    const bf16x8 b1 = *reinterpret_cast<const bf16x8*>(Ks + (32 + r32) * KROWB + cb);
    const bf16x8 qf = qr[d0];
    p0 = __builtin_amdgcn_mfma_f32_32x32x16_bf16(b0, qf, p0, 0, 0, 0);
    p1 = __builtin_amdgcn_mfma_f32_32x32x16_bf16(b1, qf, p1, 0, 0, 0); }
}
__device__ __forceinline__ int v_st(int k, int c) { const int kk = (k & ~0xC) | ((k & 4) << 1) | ((k & 8) >> 1); return ((kk >> 3) * 4 + (c >> 5)) * 512 + ((kk & 7) * 32 + (c & 31)) * 2; }
__device__ __forceinline__ int v_rd_base(int lane) { return ((lane & 3) << 3) | (((lane >> 2) & 3) << 6) | (((lane >> 4) & 1) << 5) | (((lane >> 5) & 1) << 8); }
constexpr int v_rd_off(int d0, int ks, int half) { return d0 * 512 + ks * 4096 + half * 2048; }
template <int OFF> __device__ __forceinline__ s16x4 tr_read(int vb) {
  s16x4 r; asm volatile("ds_read_b64_tr_b16 %0, %1 offset:%2" : "=&v"(r) : "v"(vb), "i"(OFF) : "memory"); return r;
}
template <int D0> __device__ __forceinline__ void pv_one(f32x16& od, int vb, bf16x8 pa0, bf16x8 pa1, bf16x8 pa2, bf16x8 pa3) {
  const s16x4 l0 = tr_read<v_rd_off(D0, 0, 0)>(vb), h0 = tr_read<v_rd_off(D0, 0, 1)>(vb), l1 = tr_read<v_rd_off(D0, 1, 0)>(vb), h1 = tr_read<v_rd_off(D0, 1, 1)>(vb);
  const s16x4 l2 = tr_read<v_rd_off(D0, 2, 0)>(vb), h2 = tr_read<v_rd_off(D0, 2, 1)>(vb), l3 = tr_read<v_rd_off(D0, 3, 0)>(vb), h3 = tr_read<v_rd_off(D0, 3, 1)>(vb);
  asm volatile("s_waitcnt lgkmcnt(0)" ::: "memory"); SBAR();
#define PK(L, H) (bf16x8){L[0], L[1], L[2], L[3], H[0], H[1], H[2], H[3]}
  od = __builtin_amdgcn_mfma_f32_32x32x16_bf16(pa0, PK(l0, h0), od, 0, 0, 0);
  od = __builtin_amdgcn_mfma_f32_32x32x16_bf16(pa1, PK(l1, h1), od, 0, 0, 0);
  od = __builtin_amdgcn_mfma_f32_32x32x16_bf16(pa2, PK(l2, h2), od, 0, 0, 0);
  od = __builtin_amdgcn_mfma_f32_32x32x16_bf16(pa3, PK(l3, h3), od, 0, 0, 0);
#undef PK
}
__device__ __forceinline__ void pv_d0(f32x16* o, int vb, bf16x8 pa0, bf16x8 pa1, bf16x8 pa2, bf16x8 pa3) {
  pv_one<0>(o[0], vb, pa0, pa1, pa2, pa3); pv_one<1>(o[1], vb, pa0, pa1, pa2, pa3); pv_one<2>(o[2], vb, pa0, pa1, pa2, pa3); pv_one<3>(o[3], vb, pa0, pa1, pa2, pa3);
}
__device__ __forceinline__ void attn_unit(const bf16_t* __restrict__ Qb, const bf16_t* __restrict__ Kh, const bf16_t* __restrict__ Vh, bf16_t* __restrict__ Ob, float* __restrict__ ssq, int seq, float kbound, char* lds, LAS unsigned char* ldsl) {
  int tid_ = threadIdx.x; asm volatile("" : "+v"(tid_));
  const int tid = tid_, wid = tid >> 6, lane = tid & 63, r32 = lane & 31, hi = lane >> 5;
  char* V_lds = lds; char* K_lds = lds + 3 * SHM_V;
  float* ws = (float*)(lds + SHM_WS) + wid * 64; float* li_l = ws;
  float l_reg = 0; f32x16 o[4] = {}; bf16x8 qr[12];
  const bf16_t* Qw = Qb + (size_t)(wid * QBLK + r32) * DK + hi * 8;
  float qss = 0.f;
#pragma unroll
  for (int d0 = 0; d0 < 8; ++d0) { qr[d0] = *reinterpret_cast<const bf16x8*>(Qw + d0 * 16);
#pragma unroll
    for (int e = 0; e < 8; ++e) { const float v = bf2f((bf16_t)qr[d0][e]); qss += v * v; } }
  const char* qrl = nullptr;
#pragma unroll
  for (int d0 = 8; d0 < 12; ++d0) { const bf16x8 qv = *reinterpret_cast<const bf16x8*>(Qw + d0 * 16); qr[d0] = qv;
#pragma unroll
    for (int e = 0; e < 8; ++e) { const float v = bf2f((bf16_t)qv[e]); qss += v * v; } }
  { auto rr = __builtin_amdgcn_permlane32_swap(__float_as_uint(qss), __float_as_uint(qss), false, false); qss = __uint_as_float(rr[0]) + __uint_as_float(rr[1]); }
  f32x16 negm; { const float nm = -__builtin_amdgcn_sqrtf(qss) * kbound;
#pragma unroll
    for (int r = 0; r < 16; ++r) negm[r] = nm; }
  asm volatile("" : "+v"(negm));
  const int vb0 = (int)(uintptr_t)V_lds + v_rd_base(lane);
  const int uw = __builtin_amdgcn_readfirstlane(wid);
  unsigned koff[4], voff[2];
#pragma unroll
  for (int i = 0; i < 4; ++i) { const int c = (uw + 8 * i) * 64 + lane, row = c / 25, cc = c - row * 25; koff[i] = (unsigned)(row * 384 + (cc < 24 ? cc : 23) * 16); }
#pragma unroll
  for (int i = 0; i < 2; ++i) { const int P = (uw + 8 * i) * 64 + lane, sub = P >> 5, within = P & 31, kk = (sub >> 2) * 8 + (within >> 2), c = (sub & 3) * 32 + (within & 3) * 8;
    const int k = kk;
    voff[i] = (unsigned)(k * 256 + c * 2); }
  LAS unsigned char* Vl = ldsl; LAS unsigned char* Kl = ldsl + 3 * SHM_V;
#define UNI64(p) ((const char*)((((unsigned long long)(unsigned)__builtin_amdgcn_readfirstlane((int)((unsigned long long)(p) >> 32))) << 32) | (unsigned long long)(unsigned)__builtin_amdgcn_readfirstlane((int)(unsigned)(unsigned long long)(p))))
#define GLDS16S(voff_, sbase_, ldsaddr_) do { unsigned keep_; asm volatile("s_mov_b32 %0, m0\n\ts_mov_b32 m0, %3\n\ts_nop 0\n\tglobal_load_lds_dwordx4 %1, %2\n\ts_mov_b32 m0, %0" \
    : "=&s"(keep_) : "v"(voff_), "s"(sbase_), "s"(ldsaddr_) : "memory"); } while (0)
#define DMA_TILE(t, kbuf, vbuf) do { const char* kt_ = UNI64((const char*)Kh + (size_t)(t) * (KVBLK * DK * 2)); const char* vt_ = UNI64((const char*)Vh + (size_t)(t) * (KVBLK * DV * 2)); \
    const unsigned kl_ = (unsigned)__builtin_amdgcn_readfirstlane((int)(unsigned)(unsigned long)(Kl + (kbuf) * SHM_K + uw * 1024)); \
    const unsigned vl_ = (unsigned)__builtin_amdgcn_readfirstlane((int)(unsigned)(unsigned long)(Vl + (vbuf) * SHM_V + uw * 1024)); \
    GLDS16S(koff[0], kt_, kl_); GLDS16S(koff[1], kt_, kl_ + 8 * 1024); GLDS16S(koff[2], kt_, kl_ + 16 * 1024); \
    if (uw == 0) GLDS16S(koff[3], kt_, kl_ + 24 * 1024); \
    GLDS16S(voff[0], vt_, vl_); GLDS16S(voff[1], vt_, vl_ + 8 * 1024); } while (0)
#define DMA_SYNC() do { asm volatile("s_waitcnt vmcnt(0)" ::: "memory"); __syncthreads(); } while (0)
  f32x16 pA0, pA1, pB0, pB1; bf16x8 pa0, pa1, pa2, pa3; const int NT = seq / KVBLK;
  int ip = 2, ic = 0, in = 1;
#define ROT() do { const int t_ = ip; ip = ic; ic = in; in = t_; } while (0)
  DMA_TILE(0, 0, 0); DMA_SYNC();
  DMA_TILE(1, 1, in); SBAR();
  qkt(pA0, pA1, K_lds, qr, qrl, negm, r32, hi); expA(pA0);
  DMA_SYNC(); ROT();
  for (int j = 1; j + 1 < NT; j += 2) {
    DMA_TILE(j + 1, 0, in); SBAR();
    qkt(pB0, pB1, K_lds + SHM_K, qr, qrl, negm, r32, hi);
    finishSM(pA0, pA1, l_reg, pa0, pa1, pa2, pa3); sched_qk_sm(); SBAR();
    pv_d0(o, vb0 + ip * SHM_V, pa0, pa1, pa2, pa3); expA(pB0);
    DMA_SYNC(); ROT();
    DMA_TILE(j + 2, 1, in); SBAR();
    qkt(pA0, pA1, K_lds, qr, qrl, negm, r32, hi);
    finishSM(pB0, pB1, l_reg, pa0, pa1, pa2, pa3); sched_qk_sm(); SBAR();
    pv_d0(o, vb0 + ip * SHM_V, pa0, pa1, pa2, pa3); expA(pA0);
    DMA_SYNC(); ROT();
  }
  SBAR(); qkt(pB0, pB1, K_lds + SHM_K, qr, qrl, negm, r32, hi);
  finishSM(pA0, pA1, l_reg, pa0, pa1, pa2, pa3); SBAR();
  pv_d0(o, vb0 + ip * SHM_V, pa0, pa1, pa2, pa3); expA(pB0);
  finishSM(pB0, pB1, l_reg, pa0, pa1, pa2, pa3); SBAR();
  pv_d0(o, vb0 + ic * SHM_V, pa0, pa1, pa2, pa3);
#undef ROT
#undef UNI64
#undef GLDS16S
#undef DMA_TILE
#undef DMA_SYNC
  { auto rr = __builtin_amdgcn_permlane32_swap(__float_as_uint(l_reg), __float_as_uint(l_reg), false, false); l_reg = __uint_as_float(rr[0]) + __uint_as_float(rr[1]); }
  if (hi == 0) li_l[r32] = l_reg; asm volatile("s_waitcnt lgkmcnt(0)" ::: "memory");
  int lane_e = lane; asm volatile("" : "+v"(lane_e));
  const int r32e = lane_e & 31, hie = lane_e >> 5;
  float rli[16];
#pragma unroll
  for (int r = 0; r < 16; ++r) rli[r] = __builtin_amdgcn_rcpf(li_l[crow(r, hie)]);
  __syncthreads();
  bf16_t* stg = (bf16_t*)(lds + wid * 8192);
#pragma unroll
  for (int r = 0; r < 16; ++r) { const int orow = crow(r, hie);
#pragma unroll
    for (int d0 = 0; d0 < 4; ++d0) { const float v = o[d0][r] * rli[r]; stg[orow * 128 + d0 * 32 + r32e] = (bf16_t)(cvt_pk_bf16(v, v) & 0xffffu); } }
  asm volatile("s_waitcnt lgkmcnt(0)" ::: "memory");
#pragma unroll
  for (int i = 0; i < 8; ++i) { const int row = i * 4 + (lane_e >> 4), ch = lane_e & 15;
    const u32x4 v = *(const u32x4*)(stg + row * 128 + ch * 8);
    *(u32x4*)(Ob + (size_t)(wid * QBLK + row) * DM + ch * 8) = v;
    float q = bflo(v.x) * bflo(v.x) + bfhi(v.x) * bfhi(v.x) + bflo(v.y) * bflo(v.y) + bfhi(v.y) * bfhi(v.y) + bflo(v.z) * bflo(v.z) + bfhi(v.z) * bfhi(v.z) + bflo(v.w) * bflo(v.w) + bfhi(v.w) * bfhi(v.w);
    q += shflx(q, lane_e, 1); q += shflx(q, lane_e, 2); q += shflx(q, lane_e, 4); q += shflx(q, lane_e, 8);
    if (ch == 0) atomicAdd(ssq + wid * QBLK + row, q); }
  __syncthreads();
}
#undef SBAR
}

namespace lru {
constexpr int XROW = 136;
constexpr int X_BYTES = 256 * XROW * 2;
constexpr int COMP_OFF = X_BYTES, COMP_BYTES = 4 * 2 * 8 * 32 * 8;
constexpr int CARRY_OFF = COMP_OFF + COMP_BYTES;
constexpr int PRM_OFF = CARRY_OFF + 1024 + 32768;
constexpr int WB_OFF = CARRY_OFF + 1024;
template <bool REV> __device__ __forceinline__ void seg_comp(const float (&a)[16], const float (&bx)[16], float (&A)[4], float (&B)[4]) {
#pragma unroll
  for (int q = 0; q < 4; ++q) { float Aq = 1.f, Bq = 0.f;
#pragma unroll
    for (int ee = 0; ee < 4; ++ee) { const int e = REV ? 3 - ee : ee; const int r = 4 * q + e; Bq = a[r] * Bq + bx[r]; Aq *= a[r]; }
    A[q] = Aq; B[q] = Bq; }
}
template <bool REV> __device__ __forceinline__ float seg_prefix(const float (&loA)[4], const float (&loB)[4], const float (&hiA)[4], const float (&hiB)[4], int hi, float st, float (&start)[4]) {
#pragma unroll
  for (int qq = 0; qq < 4; ++qq) { const int q = REV ? 3 - qq : qq;
    if (!REV) { const float t1 = loA[q] * st + loB[q]; start[q] = hi ? t1 : st; st = hiA[q] * t1 + hiB[q]; }
    else { const float t1 = hiA[q] * st + hiB[q]; start[q] = hi ? st : t1; st = loA[q] * t1 + loB[q]; } }
  return st;
}
template <int PASS>
__device__ __forceinline__ void unit(const Params& p, int chunk, int n, char* lds, float* ssq_l) {
  int tid_ = threadIdx.x; asm volatile("" : "+v"(tid_));
  const int tid = tid_, wid = __builtin_amdgcn_readfirstlane(tid >> 6), lane = tid & 63, j = lane & 31, hi = lane >> 5;
  const int row0 = chunk * 256;
  int seq_start, seq_len;
  if (row0 < MP) { seq_start = row0 & ~(SEQP - 1); seq_len = SEQP; } else { seq_start = MP + ((row0 - MP) & ~(SEQS - 1)); seq_len = SEQS; }
  const int cs = (row0 - seq_start) >> 8, nch = seq_len >> 8, cbase = seq_start >> 8;
  const bf16_t* U = (const bf16_t*)(p.ws + WS_U);
  bf16_t* X = (bf16_t*)lds;
  f32x2* comp = (f32x2*)(lds + COMP_OFF);
  float* carry = (float*)(lds + CARRY_OFF);
  f32x2* agg = (f32x2*)(p.ws + WS_AGG);
  const bf16_t* Wf = (const bf16_t*)(p.ws + WS_BRG) + (size_t)n * 4 * 4 * 8 * 64 * 8;
  char* WB = lds + WB_OFF;
#define WSRC(cg, d, wh) (Wf + ((size_t)(((2 * (d) + (wh)) * 4 + (cg)) * 8) * 64 + tid) * 8)
  bf16x8 sw0 = *(const bf16x8*)WSRC(0, 0, 0), sw1 = *(const bf16x8*)WSRC(0, 0, 1);
  { const int cg8 = (tid & 15) * 8, tg = tid >> 4; const int c0 = n * 128 + cg8;
    const float* cw = p.in[10]; const float* cb = p.in[11];
    float w[4][8], bb[8];
#pragma unroll
    for (int t = 0; t < 4; ++t) { const f32x4 a = *(const f32x4*)(cw + t * 1024 + c0), b = *(const f32x4*)(cw + t * 1024 + c0 + 4);
      w[t][0] = a[0]; w[t][1] = a[1]; w[t][2] = a[2]; w[t][3] = a[3]; w[t][4] = b[0]; w[t][5] = b[1]; w[t][6] = b[2]; w[t][7] = b[3]; }
    { const f32x4 a = *(const f32x4*)(cb + c0), b = *(const f32x4*)(cb + c0 + 4); bb[0] = a[0]; bb[1] = a[1]; bb[2] = a[2]; bb[3] = a[3]; bb[4] = b[0]; bb[5] = b[1]; bb[6] = b[2]; bb[7] = b[3]; }
    u32x4 rw[11];
#pragma unroll
    for (int rr = 0; rr < 11; ++rr) { const int grow = row0 + tg * 8 + rr - 1; const bool ok = (grow >= seq_start) && (grow < seq_start + seq_len);
      rw[rr] = ok ? *(const u32x4*)(U + (size_t)grow * LDU + UC_X + c0) : (u32x4){0u, 0u, 0u, 0u}; }
#pragma unroll
    for (int t = 0; t < 8; ++t) { float y[8];
#pragma unroll
      for (int c = 0; c < 8; ++c) y[c] = bb[c];
#pragma unroll
      for (int tp = 0; tp < 4; ++tp) { const u32x4 v = rw[t + tp];
        y[0] += w[tp][0] * bflo(v.x); y[1] += w[tp][1] * bfhi(v.x); y[2] += w[tp][2] * bflo(v.y); y[3] += w[tp][3] * bfhi(v.y);
        y[4] += w[tp][4] * bflo(v.z); y[5] += w[tp][5] * bfhi(v.z); y[6] += w[tp][6] * bflo(v.w); y[7] += w[tp][7] * bfhi(v.w); }
      u32x4 o; o.x = cvt_pk_bf16(y[0], y[1]); o.y = cvt_pk_bf16(y[2], y[3]); o.z = cvt_pk_bf16(y[4], y[5]); o.w = cvt_pk_bf16(y[6], y[7]);
      *(u32x4*)(X + (tg * 8 + t) * XROW + cg8) = o; }
  }
  if (PASS == 2 && tid < 256) { const int dir = tid >> 7, ch = tid & 127; float st = 0.f;
    const int cnt = dir ? nch - 1 - cs : cs;
    for (int k0 = 0; k0 < cnt; k0 += 16) { f32x2 ab[16];
#pragma unroll
      for (int i = 0; i < 16; ++i) { const int k = k0 + i; const bool ok = k < cnt; const int c = ok ? (dir ? nch - 1 - k : k) : cs;
        ab[i] = agg[(size_t)(dir * NCHUNK + cbase + c) * 1024 + n * 128 + ch]; if (!ok) ab[i] = (f32x2){1.f, 0.f}; }
#pragma unroll
      for (int i = 0; i < 16; ++i) st = ab[i].x * st + ab[i].y; }
    carry[dir * 128 + ch] = st; }
  *(bf16x8*)(WB + tid * 16) = sw0; *(bf16x8*)(WB + 8192 + tid * 16) = sw1;
  if (tid < 256) { const int dir = tid >> 7, ch = tid & 127;
    const float lm = p.in[16][dir * 1024 + n * 128 + ch];
    *(f32x4*)(lds + PRM_OFF + (dir * 128 + ch) * 16) = (f32x4){p.in[13][(dir * 8 + n) * 128 + ch], p.in[15][(dir * 8 + n) * 128 + ch], (8.0f * 1.4426950408889634f) * log1pf(__expf(-lm)), 0.f}; }
  __syncthreads();
  const float* lam = p.in[16];
  const bf16_t* Xw = X + (32 * wid + j) * XROW + 8 * hi;
  for (int cgp = 0; cgp < 4; ++cgp) {
    const int ch = 32 * cgp + j, gch = n * 128 + ch;
    float sum[16];
    bf16_t graw[16];
    if (PASS == 2) { int rb = row0 + 32 * wid + 4 * hi; asm volatile("" : "+v"(rb));
#pragma unroll
      for (int r = 0; r < 16; ++r) graw[r] = U[(size_t)(rb + (r & 3) + 8 * (r >> 2)) * LDU + UC_G + gch];
    }
#pragma unroll
    for (int dir = 0; dir < 2; ++dir) {
      const bool has_next = !(cgp == 3 && dir == 1);
      if (has_next) { const int ncg = dir ? cgp + 1 : cgp; sw0 = *(const bf16x8*)WSRC(ncg, dir ^ 1, 0); sw1 = *(const bf16x8*)WSRC(ncg, dir ^ 1, 1); }
      f32x16 accr = f32x16{}, acci = f32x16{};
#pragma unroll
      for (int ks = 0; ks < 8; ++ks) { const bf16x8 xa = *(const bf16x8*)(Xw + 16 * ks);
        const bf16x8 bfr = *(const bf16x8*)(WB + dir * 16384 + ks * 1024 + lane * 16);
        const bf16x8 bfi = *(const bf16x8*)(WB + dir * 16384 + 8192 + ks * 1024 + lane * 16);
        accr = __builtin_amdgcn_mfma_f32_32x32x16_bf16(xa, bfr, accr, 0, 0, 0);
        acci = __builtin_amdgcn_mfma_f32_32x32x16_bf16(xa, bfi, acci, 0, 0, 0);
        if ((ks & 3) == 3) __builtin_amdgcn_sched_barrier(0); }
      const f32x4 prm = *(const f32x4*)(lds + PRM_OFF + (dir * 128 + ch) * 16);
      const float br = prm[0], bi = prm[1], c8 = prm[2];
      float a[16], bx[16];
#pragma unroll
      for (int r = 0; r < 16; ++r) { const float xv = bf2f(X[(32 * wid + crow(r, hi)) * XROW + ch]);
        const float rg = sigmoidf_(accr[r] + br), ig = sigmoidf_(acci[r] + bi);
        const float av = __builtin_amdgcn_exp2f(-c8 * rg); a[r] = av; bx[r] = __builtin_amdgcn_sqrtf(fmaxf(1.0f - av * av, 0.f)) * ig * xv; }
      float A[4], B[4], loA[4], loB[4], hiA[4], hiB[4], start[4];
      if (dir == 0) seg_comp<false>(a, bx, A, B); else seg_comp<true>(a, bx, A, B);
#pragma unroll
      for (int q = 0; q < 4; ++q) { const float pA = __shfl_xor(A[q], 32), pB = __shfl_xor(B[q], 32);
        loA[q] = hi ? pA : A[q]; loB[q] = hi ? pB : B[q]; hiA[q] = hi ? A[q] : pA; hiB[q] = hi ? B[q] : pB; }
      float Aw = 1.f;
#pragma unroll
      for (int q = 0; q < 4; ++q) Aw *= loA[q] * hiA[q];
      const float Bw = (dir == 0) ? seg_prefix<false>(loA, loB, hiA, hiB, hi, 0.f, start) : seg_prefix<true>(loA, loB, hiA, hiB, hi, 0.f, start);
      if (hi == 0) comp[((cgp * 2 + dir) * 8 + wid) * 32 + j] = (f32x2){Aw, Bw};
      if (has_next) { *(bf16x8*)(WB + (dir ^ 1) * 16384 + tid * 16) = sw0; *(bf16x8*)(WB + (dir ^ 1) * 16384 + 8192 + tid * 16) = sw1; }
      __syncthreads();
      if (PASS == 2) {
        float st = carry[dir * 128 + ch];
        if (dir == 0) { for (int w2 = 0; w2 < wid; ++w2) { const f32x2 ab = comp[((cgp * 2 + 0) * 8 + w2) * 32 + j]; st = ab.x * st + ab.y; } }
        else { for (int w2 = 7; w2 > wid; --w2) { const f32x2 ab = comp[((cgp * 2 + 1) * 8 + w2) * 32 + j]; st = ab.x * st + ab.y; } }
        if (dir == 0) { (void)seg_prefix<false>(loA, loB, hiA, hiB, hi, st, start);
#pragma unroll
          for (int q = 0; q < 4; ++q) { float h = start[q];
#pragma unroll
            for (int e = 0; e < 4; ++e) { const int r = 4 * q + e; h = a[r] * h + bx[r]; sum[r] = h; } } }
        else { (void)seg_prefix<true>(loA, loB, hiA, hiB, hi, st, start);
#pragma unroll
          for (int q = 0; q < 4; ++q) { float h = start[q];
#pragma unroll
            for (int ee = 0; ee < 4; ++ee) { const int r = 4 * q + 3 - ee; h = a[r] * h + bx[r]; sum[r] += h; } } }
      }
    }
    if (PASS == 2) {
      bf16_t* mixed = (bf16_t*)(p.ws + WS_XB);
      int rb2 = row0 + 32 * wid + 4 * hi, lane2 = lane; asm volatile("" : "+v"(rb2), "+v"(lane2));
#pragma unroll
      for (int r = 0; r < 16; ++r) { const int row = rb2 + (r & 3) + 8 * (r >> 2);
        const float g = bf2f(graw[r]);
        const float u3 = 0.7978845608028654f * (g + 0.044715f * g * g * g);
        const float th = 1.0f - 2.0f * __builtin_amdgcn_rcpf(1.0f + __builtin_amdgcn_exp2f((2.0f * 1.4426950408889634f) * u3));
        const float val = sum[r] * (0.5f * g * (1.0f + th));
        const unsigned pk = cvt_pk_bf16(val, val); const bf16_t hv = (bf16_t)(pk & 0xffffu);
        mixed[(size_t)row * DM + 1024 + gch] = hv;
        float q = bf2f(hv); q = q * q;
        q += shflx(q, lane2, 1); q += shflx(q, lane2, 2); q += shflx(q, lane2, 4); q += shflx(q, lane2, 8); q += shflx(q, lane2, 16);
        if ((lane2 & 31) == 0) atomicAdd(ssq_l + row, q); }
    }
  }
  if (PASS == 1) {
    __syncthreads();
    if (tid < 256) { const int dir = tid >> 7, ch = tid & 127, cgp = ch >> 5, jj = ch & 31; float A = 1.f, B = 0.f;
      if (dir == 0) { for (int w2 = 0; w2 < 8; ++w2) { const f32x2 ab = comp[((cgp * 2 + 0) * 8 + w2) * 32 + jj]; B = ab.x * B + ab.y; A *= ab.x; } }
      else { for (int w2 = 7; w2 >= 0; --w2) { const f32x2 ab = comp[((cgp * 2 + 1) * 8 + w2) * 32 + jj]; B = ab.x * B + ab.y; A *= ab.x; } }
      agg[(size_t)(dir * NCHUNK + chunk) * 1024 + n * 128 + ch] = (f32x2){A, B}; }
  }
  __syncthreads();
#undef WSRC
}
}

__device__ __forceinline__ void tr_item(const float* W, int ldw, int K, int srccol0, const float* gk, bf16_t* dst, int k0, LAS float* scr, int lane) {
  { const int n4 = (lane & 7) * 4; f32x4 v[8];
#pragma unroll
    for (int i = 0; i < 8; ++i) { const int kk = 8 * i + (lane >> 3); v[i] = (f32x4){0.f, 0.f, 0.f, 0.f};
      if (srccol0 >= 0) { v[i] = *(const f32x4*)(W + (size_t)(k0 + kk) * ldw + srccol0 + n4); if (gk) v[i] = v[i] * gk[kk]; } }
#pragma unroll
    for (int i = 0; i < 8; ++i) { const int kk = 8 * i + (lane >> 3); LAS float* d = scr + kk * 33 + n4; d[0] = v[i][0]; d[1] = v[i][1]; d[2] = v[i][2]; d[3] = v[i][3]; } }
  asm volatile("s_waitcnt lgkmcnt(0)" ::: "memory");
  const int c = lane & 7;
#pragma unroll
  for (int jq = 0; jq < 4; ++jq) { const int nn = (lane >> 3) + 8 * jq; const LAS float* s = scr + (8 * c) * 33 + nn;
    u32x4 o; o.x = cvt_pk_bf16(s[0 * 33], s[1 * 33]); o.y = cvt_pk_bf16(s[2 * 33], s[3 * 33]); o.z = cvt_pk_bf16(s[4 * 33], s[5 * 33]); o.w = cvt_pk_bf16(s[6 * 33], s[7 * 33]);
    *(u32x4*)(dst + (size_t)nn * K + k0 + 8 * c) = o; }
  asm volatile("s_waitcnt lgkmcnt(0)" ::: "memory");
}

__device__ __forceinline__ void p0_prologue(const Params& p, LAS unsigned char* lds, int vcu, int G) {
  int tid_ = threadIdx.x; asm volatile("" : "+v"(tid_));
  const int tid = tid_, lane = tid & 63, wave = __builtin_amdgcn_readfirstlane(tid >> 6);
  const int gw = vcu * 8 + wave, NGW = G * 8;
  const size_t gt = (size_t)blockIdx.x * 512 + tid, NGT = (size_t)G * 512;
  unsigned char* ws = p.ws;
  { float* z = (float*)(ws + WS_ZERO); for (size_t i = gt; i < ZERO_BYTES / 4; i += NGT) z[i] = 0.f; }
  { f32x2* rt = (f32x2*)(ws + WS_ROPE);
    for (size_t i = gt; i < (size_t)SEQP * 32; i += NGT) { const int s = (int)(i >> 5), f = (int)(i & 31);
      double rev = (double)s * INV_FREQ[f] * 0.15915494309189535; rev -= __builtin_rint(rev); const float r = (float)rev;
      rt[i] = (f32x2){__builtin_amdgcn_cosf(r), __builtin_amdgcn_sinf(r)}; } }
  { bf16_t* wf = (bf16_t*)(ws + WS_BRG);
    for (size_t ci = gt; ci < 65536; ci += NGT) { const int ln = (int)(ci & 63), ks = (int)((ci >> 6) & 7), cgp = (int)((ci >> 9) & 3), dw = (int)((ci >> 11) & 3), n = (int)(ci >> 13);
      const int jj = ln & 31, kg = ln >> 5, dir = dw >> 1, wh = dw & 1;
      const float* src = (wh ? p.in[14] : p.in[12]) + (size_t)(dir * 8 + n) * 128 * 128 + (size_t)(16 * ks + 8 * kg) * 128 + 32 * cgp + jj;
      u32x4 o; o.x = cvt_pk_bf16(src[0], src[128]); o.y = cvt_pk_bf16(src[256], src[384]); o.z = cvt_pk_bf16(src[512], src[640]); o.w = cvt_pk_bf16(src[768], src[896]);
      *(u32x4*)(wf + ci * 8) = o; } }
  { bf16_t* xb = (bf16_t*)(ws + WS_XB); float* rs1 = (float*)(ws + WS_RS1);
    for (int m0 = gw; m0 < M; m0 += 4 * NGW) {
      int mr[4]; const float* xr[4]; f32x4 v[4][8]; float ss[4];
#pragma unroll
      for (int t = 0; t < 4; ++t) { mr[t] = (m0 + t * NGW < M) ? m0 + t * NGW : m0; xr[t] = (mr[t] < MP) ? p.in[0] + (size_t)mr[t] * DM : p.in[1] + (size_t)(mr[t] - MP) * DM; }
#pragma unroll
      for (int q = 0; q < 8; ++q)
#pragma unroll
        for (int t = 0; t < 4; ++t) v[t][q] = *(const f32x4*)(xr[t] + q * 256 + lane * 4);
#pragma unroll
      for (int t = 0; t < 4; ++t) { float a = 0.f;
#pragma unroll
        for (int q = 0; q < 8; ++q) a += (v[t][q][0] * v[t][q][0] + v[t][q][1] * v[t][q][1]) + (v[t][q][2] * v[t][q][2] + v[t][q][3] * v[t][q][3]);
        ss[t] = wave_sum(a); }
      if (lane == 0) {
#pragma unroll
        for (int t = 0; t < 4; ++t) rs1[mr[t]] = 1.0f / sqrtf(ss[t] * (1.0f / DM) + EPS); }
#pragma unroll
      for (int t = 0; t < 4; ++t)
#pragma unroll
        for (int q = 0; q < 8; ++q) { u32x2 w; w.x = cvt_pk_bf16(v[t][q][0], v[t][q][1]); w.y = cvt_pk_bf16(v[t][q][2], v[t][q][3]); *(u32x2*)(xb + (size_t)mr[t] * DM + q * 256 + lane * 4) = w; } } }
  LAS float* scr = (LAS float*)(lds + wave * 16384);
  constexpr int I_IN = 96 * 32, I_UQ = 64 * 8, I_UKV = 64 * 4, I_OUT = 64 * 32, I_GU = 352 * 32, I_DN = 64 * 88;
  constexpr int NITEMS = I_IN + I_UQ + I_UKV + I_OUT + I_GU + I_DN;
  for (int it = gw; it < NITEMS; it += NGW) {
    int r = it;
    if (r < I_IN) { const int ng = r >> 5, kb = r & 31, dc = ng * 32; int sc;
      if (dc < 768) sc = dc; else if (dc < 1792) sc = dc - 768 + 832; else if (dc < 2816) sc = dc - 1792 + 1856; else if (dc < 2880) sc = dc - 2816 + 768; else sc = -1;
      tr_item(p.in[3], 2880, 2048, sc, p.in[2] + kb * 64, (bf16_t*)(ws + WS_BIN) + (size_t)dc * 2048, kb * 64, scr, lane); continue; } r -= I_IN;
    if (r < I_UQ) { const int ng = r >> 3, kb = r & 7, h = ng >> 3, t0 = (ng & 7) * 32; int d;
      if (t0 < 96) d = t0; else if (t0 == 96) d = 128; else if (t0 == 128) d = 96; else if (t0 == 224) d = 160; else d = -1;
      tr_item(p.in[5], 1536, 512, d < 0 ? -1 : h * 192 + d, p.in[4] + kb * 64, (bf16_t*)(ws + WS_BUQ) + (size_t)(ng * 32) * 512, kb * 64, scr, lane); continue; } r -= I_UQ;
    if (r < I_UKV) { const int ng = r >> 2, kb = r & 3;
      tr_item(p.in[7], 2048, 256, ng * 32, p.in[6] + kb * 64, (bf16_t*)(ws + WS_BUKV) + (size_t)(ng * 32) * 256, kb * 64, scr, lane); continue; } r -= I_UKV;
    if (r < I_OUT) { const int ng = r >> 5, kb = r & 31; const float* gk = (kb < 16) ? p.in[17] + kb * 64 : p.in[18] + (kb - 16) * 64;
      tr_item(p.in[19], 2048, 2048, ng * 32, gk, (bf16_t*)(ws + WS_BOUT) + (size_t)(ng * 32) * 2048, kb * 64, scr, lane); continue; } r -= I_OUT;
    if (r < I_GU) { const int ng = r >> 5, kb = r & 31, R = ng * 32, pn = R >> 8, within = R & 255, bj = within >> 7, c = within & 127;
      tr_item(bj ? p.in[22] : p.in[21], DFF, 2048, pn * 128 + c, p.in[20] + kb * 64, (bf16_t*)(ws + WS_BGU) + (size_t)R * 2048, kb * 64, scr, lane); continue; } r -= I_GU;
    { const int ng = r / 88, kb = r % 88;
      tr_item(p.in[23], 2048, DFF, ng * 32, nullptr, (bf16_t*)(ws + WS_BDN) + (size_t)(ng * 32) * DFF, kb * 64, scr, lane); }
  }
}

__global__ void __launch_bounds__(512, 2) hymba_fwd(Params p) {
  extern __shared__ __attribute__((aligned(16))) unsigned char lds[];
  cg::grid_group grid = cg::this_grid();
  LAS unsigned char* ldsl = (LAS unsigned char*)lds;
  const int G = gridDim.x, bx = blockIdx.x;
  const int vcu = (G % 8 == 0) ? (bx % 8) * (G / 8) + bx / 8 : bx;
  unsigned char* ws = p.ws;
  float* const dummy = (float*)(ws + WS_DUMMY);
#ifndef PROBE_TA
#define PROBE_TA -1
#define PROBE_TB -1
#endif
  unsigned long long t_a = 0, t_b = 0;
#define STAMP(k) do { if (PROBE_TA >= 0) { if ((k) == PROBE_TA) t_a = __builtin_amdgcn_s_memrealtime(); if ((k) == PROBE_TB) t_b = __builtin_amdgcn_s_memrealtime(); } } while (0)
  STAMP(0);

#ifndef NO_P0
  for (int rep = 0; rep < NREP(0); ++rep) p0_prologue(p, ldsl, vcu, G);
#endif
  grid.sync(); STAMP(1);

  for (int rep = 0; rep < NREP(1); ++rep) { pg8::Gemm g{(const bf16_t*)(ws + WS_XB), (const bf16_t*)(ws + WS_BIN), DM, LDU, DM}; pg8::StaticOrder S; S.init(M, LDU, G, bx);
    pg8::EpiU E{(bf16_t*)(ws + WS_U), (const float*)(ws + WS_RS1), rep ? dummy : (float*)(ws + WS_SSQ_Q), rep ? dummy : (float*)(ws + WS_SSQ_KV), rep ? dummy : (float*)(ws + WS_SSQ_PE)};

#ifndef NO_EPIU
    pg8::gemm_phase<pg8::EpiU>(ldsl, g, S, E);
#endif
  }
  grid.sync(); STAMP(2);

  for (int rep = 0; rep < NREP(2); ++rep) {
  { pg8::Gemm g{(const bf16_t*)(ws + WS_U) + UC_Q, (const bf16_t*)(ws + WS_BUQ), LDU, 2048, 512}; pg8::StaticOrder S; S.init(M, 2048, G, bx);
    pg8::EpiQ E{(bf16_t*)(ws + WS_Q), (const float*)(ws + WS_SSQ_Q), p.in[8], (const f32x2*)(ws + WS_ROPE), (LAS float*)(ldsl + XCH_OFF)};

#ifndef NO_EPIQ
    pg8::gemm_phase<pg8::EpiQ>(ldsl, g, S, E);
#endif
  }
  { pg8::Gemm g{(const bf16_t*)(ws + WS_U) + UC_KV, (const bf16_t*)(ws + WS_BUKV), LDU, 2048, 256}; pg8::StaticOrder S; S.init(M, 2048, G, bx);
    pg8::EpiKV E{(bf16_t*)(ws + WS_K), (bf16_t*)(ws + WS_V), (const bf16_t*)(ws + WS_U), (const float*)(ws + WS_SSQ_KV), (const float*)(ws + WS_SSQ_PE), p.in[9], (const f32x2*)(ws + WS_ROPE), (LAS float*)(ldsl + XCH_OFF)};

#ifndef NO_EPIKV
    pg8::gemm_phase<pg8::EpiKV>(ldsl, g, S, E);
#endif
  }
#ifndef NO_LRU1
  for (int u = vcu; u < NCHUNK * 8; u += G) lru::unit<1>(p, u >> 3, u & 7, (char*)lds, nullptr);
#endif
  }
  grid.sync(); STAMP(3);

#ifndef NO_LRU2
  for (int rep = 0; rep < NREP(3); ++rep)
  for (int u = vcu; u < NCHUNK * 8; u += G) lru::unit<2>(p, u >> 3, u & 7, (char*)lds, rep ? dummy : (float*)(ws + WS_SSQ_L));
#endif
  STAMP(4);

#ifndef NO_ATT
  { const bf16_t* Qt = (const bf16_t*)(ws + WS_Q); const bf16_t* Kt = (const bf16_t*)(ws + WS_K); const bf16_t* Vt = (const bf16_t*)(ws + WS_V);
    bf16_t* mixed = (bf16_t*)(ws + WS_XB); float* ssq_a = (float*)(ws + WS_SSQ_A);
    float kbound; { const int ln = threadIdx.x & 63; float gm = fmaxf(fmaxf(fabsf(p.in[9][ln]), fabsf(p.in[9][64 + ln])), fabsf(p.in[9][128 + ln]));
#pragma unroll
      for (int o = 1; o < 64; o <<= 1) gm = fmaxf(gm, __shfl_xor(gm, o));
      kbound = 13.856406460551018f * 1.02f * gm; }
    const int nrp = (1024 + G - 1) / G, nrs = (256 + G - 1) / G;
    for (int rep = 0; rep < NREP(4); ++rep)
    for (int i = 0; i < nrp + nrs; ++i) { int pl, qb, seq, row0; size_t prow;
      if (i < nrp) { if (G == 256) { pl = 2 * (vcu >> 5) + (i >> 1); qb = (vcu & 31) + 32 * (i & 1); } else { const int uu = i * G + vcu; if (uu >= 1024) continue; pl = uu >> 6; qb = uu & 63; }
        prow = (size_t)pl * SEQP; seq = SEQP; row0 = (pl >> 3) * SEQP + qb * 256; }
      else { const int uu = (i - nrp) * G + vcu; if (uu >= 256) continue; pl = uu >> 3; qb = uu & 7; prow = (size_t)MP * NH + (size_t)pl * SEQS; seq = SEQS; row0 = MP + (pl >> 3) * SEQS + qb * 256; }
      const int h = pl & 7;
      att::attn_unit(Qt + (prow + qb * 256) * DK, Kt + prow * DK, Vt + prow * DV, mixed + (size_t)row0 * DM + h * 128, (rep ? dummy : ssq_a) + row0, seq, kbound, (char*)lds, ldsl); }
  }
#endif
  grid.sync(); STAMP(5);

  for (int rep = 0; rep < NREP(5); ++rep) { pg8::Gemm g{(const bf16_t*)(ws + WS_XB), (const bf16_t*)(ws + WS_BOUT), DM, DM, DM}; pg8::StaticOrder S; S.init(M, DM, G, bx);
    pg8::EpiOut E{p.in[0], p.in[1], p.out, (bf16_t*)(ws + WS_U), (const float*)(ws + WS_SSQ_A), (const float*)(ws + WS_SSQ_L), rep ? dummy : (float*)(ws + WS_SSQ_2)};

#ifndef NO_EPIOUT
    pg8::gemm_phase<pg8::EpiOut>(ldsl, g, S, E);
#endif
  }
  grid.sync(); STAMP(6);

  for (int rep = 0; rep < NREP(6); ++rep) { pg8::Gemm g{(const bf16_t*)(ws + WS_U), (const bf16_t*)(ws + WS_BGU), DM, 2 * DFF, DM}; pg8::StaticOrder S; S.init(M, 2 * DFF, G, bx);
    pg8::EpiGU E{(bf16_t*)(ws + WS_ACT), (const float*)(ws + WS_SSQ_2)};

#ifndef NO_EPIGU
    pg8::gemm_phase<pg8::EpiGU>(ldsl, g, S, E);
#endif
  }
  grid.sync(); STAMP(7);

  { pg8::Gemm g{(const bf16_t*)(ws + WS_ACT), (const bf16_t*)(ws + WS_BDN), DFF, DM, DFF}; pg8::StaticOrder S; S.init(M, DM, G, bx);
    pg8::EpiDown E{p.out};

#ifndef NO_EPIDOWN
    pg8::gemm_phase<pg8::EpiDown>(ldsl, g, S, E);
#endif
  }
  if (PROBE_TA >= 0) { grid.sync(); STAMP(8); if (bx == 0 && threadIdx.x == 0) p.out[(size_t)MP * DM + 12345] += (float)(t_b - t_a) * 1e-5f; }
}

extern "C" void kernel_launch(void* const* d_in, const int* in_sizes, int n_in, void* d_out, int out_size, void* d_ws, size_t ws_size, hipStream_t stream) {
  static int grid = 0;
  if (grid == 0) {
    if (n_in != 24 || out_size != M * DM || ws_size < WS_END) { fprintf(stderr, "kernel_launch: unexpected shapes: n_in %d out %d ws %zu (need %zu)\n", n_in, out_size, ws_size, (size_t)WS_END); grid = -1; return; }
    int dev = 0, cus = 0, per_cu = 0;
    hipGetDevice(&dev); hipDeviceGetAttribute(&cus, hipDeviceAttributeMultiprocessorCount, dev);
    if (hipFuncSetAttribute((const void*)hymba_fwd, hipFuncAttributeMaxDynamicSharedMemorySize, LDS_BYTES) != hipSuccess) { fprintf(stderr, "kernel_launch: hipFuncSetAttribute failed\n"); grid = -1; return; }
    if (hipOccupancyMaxActiveBlocksPerMultiprocessor(&per_cu, (const void*)hymba_fwd, 512, LDS_BYTES) != hipSuccess || per_cu < 1) { fprintf(stderr, "kernel_launch: occupancy query says %d\n", per_cu); per_cu = 1; }
    (void)hipGetLastError();
    grid = cus * 1;
  }
  if (grid < 0) return;
  Params p{};
  for (int i = 0; i < 24; ++i) p.in[i] = (const float*)d_in[i];
  p.out = (float*)d_out; p.ws = (unsigned char*)d_ws;
  void* args[] = {&p};
  hipError_t e = hipLaunchCooperativeKernel((const void*)hymba_fwd, dim3(grid), dim3(512), args, LDS_BYTES, stream);
  if (e != hipSuccess) fprintf(stderr, "cooperative launch failed: %s (grid %d)\n", hipGetErrorString(e), grid);
}
```

```cpp
#include <hip/hip_runtime.h>
#include <hip/hip_cooperative_groups.h>
#include <cstdio>
#include <cstdint>
namespace cg = cooperative_groups;

#define LAS __attribute__((address_space(3)))
typedef unsigned short bf16_t;
typedef short bf16x8 __attribute__((ext_vector_type(8)));
typedef short s16x4 __attribute__((ext_vector_type(4)));
typedef float f32x4 __attribute__((ext_vector_type(4)));
typedef float f32x2 __attribute__((ext_vector_type(2)));
typedef float f32x16 __attribute__((ext_vector_type(16)));
typedef unsigned u32x4 __attribute__((ext_vector_type(4)));
typedef unsigned u32x2 __attribute__((ext_vector_type(2)));

constexpr int M = 40960, MP = 32768, SEQP = 16384, SEQS = 2048, DM = 2048;
constexpr int LDU = 3072, UC_Q = 0, UC_KV = 512, UC_X = 768, UC_G = 1792, UC_PE = 2816;
constexpr int NH = 8, DK = 192, DV = 128, DFF = 5632;
constexpr float EPS = 1e-6f;
constexpr int NCHUNK = M / 256;

constexpr size_t MiB = 1u << 20, KiB = 1024;
constexpr size_t WS_RS1 = 0;
constexpr size_t WS_ZERO = 256 * KiB;
constexpr size_t WS_SSQ_Q = WS_ZERO, WS_SSQ_KV = WS_ZERO + 256 * KiB, WS_SSQ_PE = WS_ZERO + 512 * KiB, WS_SSQ_A = WS_ZERO + 768 * KiB,
                 WS_SSQ_L = WS_ZERO + 1024 * KiB, WS_SSQ_2 = WS_ZERO + 1280 * KiB;
constexpr size_t ZERO_BYTES = 1536 * KiB;
constexpr size_t WS_ROPE = 2 * MiB;
constexpr size_t WS_AGG = 6 * MiB;
constexpr size_t WS_DUMMY = 9 * MiB;
constexpr size_t WS_BIN = 16 * MiB, WS_BUQ = 28 * MiB, WS_BUKV = 30 * MiB, WS_BRG = 31 * MiB, WS_BOUT = 32 * MiB, WS_BGU = 40 * MiB, WS_BDN = 84 * MiB;
constexpr size_t WS_XB = 112 * MiB;
constexpr size_t WS_U = 272 * MiB;
constexpr size_t WS_Q = 512 * MiB, WS_K = 632 * MiB, WS_V = 752 * MiB;
constexpr size_t WS_ACT = 512 * MiB;
constexpr size_t WS_END = 952 * MiB;

constexpr int RING_BYTES = 131072, XCH_OFF = 131072, LDS_BYTES = 147456;

#ifndef PROBE_REPEAT
#define PROBE_REPEAT 0
#endif
#define NREP(bit) ((PROBE_REPEAT >> (bit)) & 1 ? 2 : 1)
struct Params {
  const float* in[24];
  float* out;
  unsigned char* ws;
};

__device__ const double INV_FREQ[32] = {1.0, 0.7498942093324559, 0.5623413251903491, 0.4216965034285822, 0.31622776601683794, 0.23713737056616552, 0.1778279410038923, 0.1333521432163324, 0.1, 0.07498942093324558, 0.05623413251903491, 0.042169650342858224, 0.03162277660168379, 0.023713737056616554, 0.01778279410038923, 0.01333521432163324, 0.01, 0.007498942093324558, 0.005623413251903491, 0.004216965034285823, 0.0031622776601683794, 0.0023713737056616554, 0.0017782794100389228, 0.001333521432163324, 0.001, 0.0007498942093324559, 0.0005623413251903491, 0.00042169650342858224, 0.00031622776601683794, 0.00023713737056616554, 0.00017782794100389227, 0.0001333521432163324};

typedef __bf16 bf16x2_v __attribute__((ext_vector_type(2)));
__device__ __forceinline__ unsigned cvt_pk_bf16(float lo, float hi) { f32x2 v = {lo, hi}; bf16x2_v b = __builtin_convertvector(v, bf16x2_v); return __builtin_bit_cast(unsigned, b); }
__device__ __forceinline__ float bf2f(bf16_t v) { return __uint_as_float(((unsigned)v) << 16); }
__device__ __forceinline__ float bflo(unsigned w) { return __uint_as_float(w << 16); }
__device__ __forceinline__ float bfhi(unsigned w) { return __uint_as_float(w & 0xffff0000u); }
__device__ __forceinline__ float wave_sum(float v) {
#pragma unroll
  for (int o = 1; o < 64; o <<= 1) v += __shfl_xor(v, o);
  return v;
}
__device__ __forceinline__ float shflx(float v, int lane, int mask) { return __int_as_float(__builtin_amdgcn_ds_bpermute((lane ^ mask) << 2, __float_as_int(v))); }
__device__ __forceinline__ float sigmoidf_(float x) { return __builtin_amdgcn_rcpf(1.0f + __builtin_amdgcn_exp2f(x * -1.4426950408889634f)); }
__device__ __forceinline__ int crow(int r, int hi) { return (r & 3) + 8 * (r >> 2) + 4 * hi; }
__device__ __forceinline__ size_t plane_row(int m, int h) {
  if (m < MP) { const int b = m >> 14, s = m & (SEQP - 1); return ((size_t)(b * NH + h) * SEQP + s); }
  const int mm = m - MP, b = mm >> 11, s = mm & (SEQS - 1); return (size_t)MP * NH + ((size_t)(b * NH + h) * SEQS + s);
}
__device__ __forceinline__ int seq_pos(int m) { return m < MP ? (m & (SEQP - 1)) : ((m - MP) & (SEQS - 1)); }

namespace pg8 {
constexpr int BM = 256, BK = 64, HALF = 128, HTB = HALF * BK * 2, STAGE_BYTES = 8 * HTB, NXCD = 8, WGM = 8;
__host__ __device__ __forceinline__ int lds_byte(int r, int c) { const int st = (r >> 4) * 2 + (c >> 5), rr = r & 15, cc = c & 31, ob = rr * 64 + cc * 2; return st * 1024 + (ob ^ (((ob >> 9) & 1) << 5)); }
__host__ __device__ __forceinline__ void stage_rc(int b, int& R, int& C) { const int st = b / 1024, sb = b % 1024, swz = sb ^ (((sb >> 9) & 1) << 5); R = (st >> 1) * 16 + swz / 64; C = (st & 1) * 32 + (swz % 64) / 2; }
__host__ __device__ __forceinline__ int perm32(int rho) { const int n = rho >> 4, i = rho & 15; return 8 * (i >> 2) + 4 * n + (i & 3); }
struct Unit { int pm, pn; };
struct Gemm { const bf16_t* A; const bf16_t* Bt; int lda, N, K; };
struct StaticOrder {
  int nM, nN, nwg, G, c;
  __device__ void init(int Mr, int N, int G_, int c_) { nM = Mr / BM; nN = N / BM; nwg = nM * nN; G = G_; c = c_; }
  __device__ bool next(int i, Unit& u) const {
    const long L = (long)i * G + c; if (L >= nwg) return false;
    int wgid = (int)L; { const int q = nwg / NXCD, r = nwg % NXCD, xcd = wgid % NXCD, off = wgid / NXCD; wgid = (xcd < r ? xcd * (q + 1) : r * (q + 1) + (xcd - r) * q) + off; }
    const int nig = WGM * nN, gid = wgid / nig, fm = gid * WGM, gsz = (nM - fm) < WGM ? (nM - fm) : WGM;
    u.pm = fm + ((wgid % nig) % gsz); u.pn = (wgid % nig) / gsz; return true;
  }
};
template <class Epi>
__device__ __forceinline__ void gemm_phase(LAS unsigned char* lds, const Gemm g, const StaticOrder& S, const Epi& E) {
  int tid_ = threadIdx.x; asm volatile("" : "+v"(tid_));
  const int tid = tid_, wid = __builtin_amdgcn_readfirstlane(tid >> 6), lane = tid & 63, wr = wid >> 2, wc = wid & 3, fr = lane & 15, fq = lane >> 4;
  const int K = g.K, nt = K / BK, lda = g.lda;
  unsigned voffA[2], voffB[2];
#pragma unroll
  for (int i = 0; i < 2; ++i) { int R, C; stage_rc(tid * 16 + i * 8192, R, C); const int Rb = Epi::PERM ? ((R & ~31) + perm32(R & 31)) : R;
    voffA[i] = (unsigned)(R * lda + C) * 2u; voffB[i] = (unsigned)(Rb * K + C) * 2u; }
  const size_t kstep = (size_t)(BK * 2);
  const size_t hstepA = (size_t)HALF * lda * 2, hstepB = (size_t)HALF * K * 2;
  const size_t tstepA = 2 * hstepA, tstepB = 2 * hstepB;
  const unsigned ldsw = (unsigned)wid * 1024u;
  const int aoff = lds_byte(wr * 64 + fr, fq * 8), boff = lds_byte(wc * 32 + fr, fq * 8);
#define PG8_SA(b, h) (((b) * 2 + (h)) * HTB)
#define PG8_SB(b, h) ((4 + (b) * 2 + (h)) * HTB)
#define PG8_STAGE(bufoff, gbase, voff) do { _Pragma("unroll") for (int _i = 0; _i < 2; ++_i) \
    __builtin_amdgcn_global_load_lds((const unsigned*)((const char*)(gbase) + (voff)[_i]), (LAS unsigned*)(lds + (bufoff) + ldsw + _i * 8192), 16, 0, 0); } while (0)
#define PG8_LDA(dst, b, h) do { _Pragma("unroll") for (int m = 0; m < 4; ++m) _Pragma("unroll") for (int k = 0; k < 2; ++k) dst[m][k] = *(const LAS bf16x8*)(lds + PG8_SA(b, h) + aoff + m * 2048 + k * 1024); } while (0)
#define PG8_LDB(dst, b, h) do { _Pragma("unroll") for (int n = 0; n < 2; ++n) _Pragma("unroll") for (int k = 0; k < 2; ++k) dst[n][k] = *(const LAS bf16x8*)(lds + PG8_SB(b, h) + boff + n * 2048 + k * 1024); } while (0)
#define PG8_MMA(ai, bj, At, Bt) do { __builtin_amdgcn_s_setprio(1); _Pragma("unroll") for (int m = 0; m < 4; ++m) _Pragma("unroll") for (int n = 0; n < 2; ++n) _Pragma("unroll") for (int k = 0; k < 2; ++k) \
    acc[ai][bj][m][n] = __builtin_amdgcn_mfma_f32_16x16x32_bf16(Bt[n][k], At[m][k], acc[ai][bj][m][n], 0, 0, 0); __builtin_amdgcn_s_setprio(0); } while (0)
#define PG8_WAIT_V(n) asm volatile("s_waitcnt vmcnt(" #n ")" ::: "memory")
#define PG8_WAIT_L(n) asm volatile("s_waitcnt lgkmcnt(" #n ")" ::: "memory")
#define PG8_BAR __builtin_amdgcn_s_barrier()
#define PG8_SCHED __builtin_amdgcn_sched_barrier(0)
  Unit cur, nxt; int ui = 0;
  if (!S.next(0, cur)) return;
  f32x4 acc[2][2][4][2];
#pragma unroll
  for (int a = 0; a < 2; ++a)
#pragma unroll
    for (int b = 0; b < 2; ++b)
#pragma unroll
      for (int m = 0; m < 4; ++m)
#pragma unroll
        for (int n = 0; n < 2; ++n) acc[a][b][m][n] = (f32x4){0.f, 0.f, 0.f, 0.f};
  bf16x8 At[4][2], B0[2][2], B1[2][2];
  const char* cA = (const char*)g.A + (size_t)cur.pm * tstepA; const char* cB = (const char*)g.Bt + (size_t)cur.pn * tstepB;
  PG8_STAGE(PG8_SB(0, 0), cB, voffB); PG8_STAGE(PG8_SB(0, 1), cB + hstepB, voffB); PG8_STAGE(PG8_SA(0, 0), cA, voffA); PG8_STAGE(PG8_SA(0, 1), cA + hstepA, voffA);
  if (wr == 1) PG8_BAR;
  PG8_WAIT_V(2); PG8_BAR;
  PG8_STAGE(PG8_SB(1, 0), cB + kstep, voffB); PG8_STAGE(PG8_SA(1, 0), cA + kstep, voffA); PG8_STAGE(PG8_SB(1, 1), cB + hstepB + kstep, voffB);
  PG8_WAIT_V(6); PG8_BAR;
  for (;;) {
    const bool has_next = S.next(ui + 1, nxt);
    const char* nA = has_next ? (const char*)g.A + (size_t)nxt.pm * tstepA : cA; const char* nB = has_next ? (const char*)g.Bt + (size_t)nxt.pn * tstepB : cB;
    for (int t = 0; t < nt; t += 2) {
      const bool last = (t == nt - 2);
      const char* a1 = cA + (size_t)(t + 1) * kstep;
      const char* a2 = last ? nA : cA + (size_t)(t + 2) * kstep; const char* b2 = last ? nB : cB + (size_t)(t + 2) * kstep;
      const char* a3 = a2 + kstep; const char* b3 = b2 + kstep;
      if constexpr (Epi::MIDK) { if (t == (nt >> 1)) E.mid(acc, cur, wr, fr); }
      PG8_LDB(B0, 0, 0); PG8_LDB(B1, 0, 1); PG8_SCHED; PG8_LDA(At, 0, 0); PG8_STAGE(PG8_SA(1, 1), a1 + hstepA, voffA);
      PG8_WAIT_V(8); PG8_WAIT_L(0); PG8_BAR; PG8_MMA(0, 0, At, B0); PG8_MMA(0, 1, At, B1); PG8_BAR; PG8_SCHED;
      PG8_LDA(At, 0, 1); PG8_STAGE(PG8_SB(0, 0), b2, voffB); PG8_STAGE(PG8_SB(0, 1), b2 + hstepB, voffB); PG8_STAGE(PG8_SA(0, 0), a2, voffA);
      PG8_WAIT_V(8); PG8_WAIT_L(0); PG8_BAR; PG8_MMA(1, 0, At, B0); PG8_MMA(1, 1, At, B1); PG8_BAR; PG8_SCHED;
      PG8_LDB(B0, 1, 0); PG8_LDB(B1, 1, 1); PG8_SCHED; PG8_LDA(At, 1, 0); PG8_STAGE(PG8_SA(0, 1), a2 + hstepA, voffA);
      PG8_WAIT_V(8); PG8_WAIT_L(0); PG8_BAR; PG8_MMA(0, 0, At, B0); PG8_MMA(0, 1, At, B1); PG8_BAR; PG8_SCHED;
      PG8_LDA(At, 1, 1); PG8_STAGE(PG8_SB(1, 0), b3, voffB); PG8_STAGE(PG8_SB(1, 1), b3 + hstepB, voffB); PG8_STAGE(PG8_SA(1, 0), a3, voffA);
      PG8_WAIT_V(8); PG8_WAIT_L(0); PG8_BAR; PG8_MMA(1, 0, At, B0); PG8_MMA(1, 1, At, B1); PG8_BAR; PG8_SCHED;
    }
    if (wr == 0) PG8_BAR;
    E(acc, cur, wr, wc, fr, fq);
    if (!has_next) break;
#pragma unroll
    for (int a = 0; a < 2; ++a)
#pragma unroll
      for (int b = 0; b < 2; ++b)
#pragma unroll
        for (int m = 0; m < 4; ++m)
#pragma unroll
          for (int n = 0; n < 2; ++n) acc[a][b][m][n] = (f32x4){0.f, 0.f, 0.f, 0.f};
    cur = nxt; cA = nA; cB = nB; ++ui;
    if (wr == 1) PG8_BAR;
  }
  PG8_WAIT_V(0);
  PG8_BAR;
#undef PG8_SA
#undef PG8_SB
#undef PG8_STAGE
#undef PG8_LDA
#undef PG8_LDB
#undef PG8_MMA
}

struct EpiU {
  static constexpr bool PERM = true, MIDK = false;
  bf16_t* U; const float* rs1; float* ssq_q; float* ssq_kv; float* ssq_pe;
  __device__ __forceinline__ void operator()(const f32x4 (&acc)[2][2][4][2], const Unit& u, int wr, int wc, int fr_, int fq_) const {
    int fr = fr_, fq = fq_; asm volatile("" : "+v"(fr), "+v"(fq));
    float* ssq = (u.pn < 2) ? ssq_q : (u.pn == 2 ? ssq_kv : (u.pn == 11 ? ssq_pe : (float*)nullptr));
    const int col0 = u.pn * BM + wc * 32 + 8 * fq;
#pragma unroll
    for (int ai = 0; ai < 2; ++ai)
#pragma unroll
      for (int m = 0; m < 4; ++m) {
        const int row = u.pm * BM + ai * HALF + wr * 64 + m * 16 + fr; const float s = rs1[row]; float q = 0.f;
        bf16_t* rowp = U + (size_t)row * LDU + col0;
#pragma unroll
        for (int bj = 0; bj < 2; ++bj) { const f32x4 v0 = acc[ai][bj][m][0] * s, v1 = acc[ai][bj][m][1] * s;
          q += (v0[0] * v0[0] + v0[1] * v0[1]) + (v0[2] * v0[2] + v0[3] * v0[3]) + (v1[0] * v1[0] + v1[1] * v1[1]) + (v1[2] * v1[2] + v1[3] * v1[3]);
          u32x4 w; w.x = cvt_pk_bf16(v0[0], v0[1]); w.y = cvt_pk_bf16(v0[2], v0[3]); w.z = cvt_pk_bf16(v1[0], v1[1]); w.w = cvt_pk_bf16(v1[2], v1[3]);
          *(u32x4*)(rowp + bj * HALF) = w; }
        if (ssq) { q += __shfl_xor(q, 16); q += __shfl_xor(q, 32); if (fq == 0) atomicAdd(ssq + row, q); }
      }
  }
};

struct EpiQ {
  static constexpr bool PERM = false, MIDK = false;
  bf16_t* Q; const float* ssq_q; const float* g_qn; const f32x2* rope; LAS float* xch;
  __device__ __forceinline__ void operator()(const f32x4 (&acc)[2][2][4][2], const Unit& u, int wr, int wc, int fr_, int fq_) const {
    int fr = fr_, fq = fq_; asm volatile("" : "+v"(fr), "+v"(fq));
    float rsq[2][4];
#pragma unroll
    for (int ai = 0; ai < 2; ++ai)
#pragma unroll
      for (int m = 0; m < 4; ++m) {
        const int rl = ai * HALF + wr * 64 + m * 16 + fr; const int row = u.pm * BM + rl;
        const float s = __builtin_amdgcn_rsqf(ssq_q[row] * (1.0f / 512.0f) + EPS); rsq[ai][m] = s; float q = 0.f;
#pragma unroll
        for (int bj = 0; bj < 2; ++bj)
#pragma unroll
          for (int n = 0; n < 2; ++n) { const f32x4 v = acc[ai][bj][m][n] * s; q += (v[0] * v[0] + v[1] * v[1]) + (v[2] * v[2] + v[3] * v[3]); }
        q += __shfl_xor(q, 16); q += __shfl_xor(q, 32);
        if (fq == 0) xch[rl * 4 + wc] = q;
      }
    asm volatile("s_waitcnt lgkmcnt(0)" ::: "memory"); __builtin_amdgcn_s_barrier(); asm volatile("" ::: "memory");
    const int h = u.pn;
#pragma unroll
    for (int ai = 0; ai < 2; ++ai)
#pragma unroll
      for (int m = 0; m < 4; ++m) {
        const int rl = ai * HALF + wr * 64 + m * 16 + fr; const int row = u.pm * BM + rl;
        const f32x4 pq = *(const LAS f32x4*)(xch + rl * 4);
        const float tot = (pq[0] + pq[1]) + (pq[2] + pq[3]);
        const float sc = rsq[ai][m] * __builtin_amdgcn_rsqf(tot * (1.0f / 192.0f) + EPS) * 0.10411754627697264f;
        bf16_t* qrow = Q + (plane_row(row, h)) * DK;
        if (wc == 3) {
          const int s = seq_pos(row);
#pragma unroll
          for (int n = 0; n < 2; ++n) { const int i0 = 16 * n + 4 * fq;
            const f32x4 g1 = *(const f32x4*)(g_qn + 128 + i0), g2 = *(const f32x4*)(g_qn + 160 + i0);
            const f32x4 x1 = acc[ai][0][m][n] * sc * g1, x2 = acc[ai][1][m][n] * sc * g2; float o1[4], o2[4];
#pragma unroll
            for (int j = 0; j < 4; ++j) { const f32x2 cs = rope[(size_t)s * 32 + i0 + j]; o1[j] = x1[j] * cs.x - x2[j] * cs.y; o2[j] = x2[j] * cs.x + x1[j] * cs.y; }
            u32x2 w1, w2; w1.x = cvt_pk_bf16(o1[0], o1[1]); w1.y = cvt_pk_bf16(o1[2], o1[3]); w2.x = cvt_pk_bf16(o2[0], o2[1]); w2.y = cvt_pk_bf16(o2[2], o2[3]);
            *(u32x2*)(qrow + 128 + i0) = w1; *(u32x2*)(qrow + 160 + i0) = w2; }
        } else {
#pragma unroll
          for (int n = 0; n < 2; ++n) { const int d = 32 * wc + 16 * n + 4 * fq;
            const f32x4 gg = *(const f32x4*)(g_qn + d); const f32x4 v = acc[ai][0][m][n] * sc * gg;
            u32x2 w; w.x = cvt_pk_bf16(v[0], v[1]); w.y = cvt_pk_bf16(v[2], v[3]); *(u32x2*)(qrow + d) = w; }
          if (wc == 0) {
#pragma unroll
            for (int n = 0; n < 2; ++n) { const int d = 96 + 16 * n + 4 * fq;
              const f32x4 gg = *(const f32x4*)(g_qn + d); const f32x4 v = acc[ai][1][m][n] * sc * gg;
              u32x2 w; w.x = cvt_pk_bf16(v[0], v[1]); w.y = cvt_pk_bf16(v[2], v[3]); *(u32x2*)(qrow + d) = w; }
          }
        }
      }
  }
};

struct EpiKV {
  static constexpr bool PERM = false, MIDK = false;
  bf16_t* Kt; bf16_t* Vt; const bf16_t* U; const float* ssq_kv; const float* ssq_pe; const float* g_kn; const f32x2* rope; LAS float* xch;
  __device__ __forceinline__ void operator()(const f32x4 (&acc)[2][2][4][2], const Unit& u, int wr, int wc, int fr_, int fq_) const {
    int fr = fr_, fq = fq_; asm volatile("" : "+v"(fr), "+v"(fq));
    float rsq[2][4];
#pragma unroll
    for (int ai = 0; ai < 2; ++ai)
#pragma unroll
      for (int m = 0; m < 4; ++m) {
        const int rl = ai * HALF + wr * 64 + m * 16 + fr; const int row = u.pm * BM + rl;
        const float s = __builtin_amdgcn_rsqf(ssq_kv[row] * (1.0f / 256.0f) + EPS); rsq[ai][m] = s; float q = 0.f;
#pragma unroll
        for (int n = 0; n < 2; ++n) { const f32x4 v = acc[ai][0][m][n] * s; q += (v[0] * v[0] + v[1] * v[1]) + (v[2] * v[2] + v[3] * v[3]); }
        q += __shfl_xor(q, 16); q += __shfl_xor(q, 32);
        if (fq == 0) xch[rl * 4 + wc] = q;
      }
    asm volatile("s_waitcnt lgkmcnt(0)" ::: "memory"); __builtin_amdgcn_s_barrier(); asm volatile("" ::: "memory");
    const int h = u.pn;
#pragma unroll
    for (int ai = 0; ai < 2; ++ai)
#pragma unroll
      for (int m = 0; m < 4; ++m) {
        const int rl = ai * HALF + wr * 64 + m * 16 + fr; const int row = u.pm * BM + rl;
        const f32x4 pq = *(const LAS f32x4*)(xch + rl * 4);
        const float tot = (pq[0] + pq[1]) + (pq[2] + pq[3]) + ssq_pe[row];
        const float rstd = __builtin_amdgcn_rsqf(tot * (1.0f / 192.0f) + EPS);
        const float sc = rsq[ai][m] * rstd;
        const size_t pr = plane_row(row, h);
        bf16_t* krow = Kt + pr * DK; bf16_t* vrow = Vt + pr * DV;
#pragma unroll
        for (int n = 0; n < 2; ++n) { const int d = 32 * wc + 16 * n + 4 * fq;
          const f32x4 gg = *(const f32x4*)(g_kn + d); const f32x4 kv = acc[ai][0][m][n] * sc * gg; const f32x4 vv = acc[ai][1][m][n] * rsq[ai][m];
          u32x2 w; w.x = cvt_pk_bf16(kv[0], kv[1]); w.y = cvt_pk_bf16(kv[2], kv[3]); *(u32x2*)(krow + d) = w;
          u32x2 wv; wv.x = cvt_pk_bf16(vv[0], vv[1]); wv.y = cvt_pk_bf16(vv[2], vv[3]); *(u32x2*)(vrow + d) = wv; }
        { const int i0 = 8 * wc + 2 * fq; const int s = seq_pos(row);
          const unsigned p1 = *(const unsigned*)(U + (size_t)row * LDU + UC_PE + i0), p2 = *(const unsigned*)(U + (size_t)row * LDU + UC_PE + 32 + i0);
          const float x1a = bflo(p1) * rstd * g_kn[128 + i0], x1b = bfhi(p1) * rstd * g_kn[128 + i0 + 1];
          const float x2a = bflo(p2) * rstd * g_kn[160 + i0], x2b = bfhi(p2) * rstd * g_kn[160 + i0 + 1];
          const f32x2 ca = rope[(size_t)s * 32 + i0], cb = rope[(size_t)s * 32 + i0 + 1];
          *(unsigned*)(krow + 128 + i0) = cvt_pk_bf16(x1a * ca.x - x2a * ca.y, x1b * cb.x - x2b * cb.y);
          *(unsigned*)(krow + 160 + i0) = cvt_pk_bf16(x2a * ca.x + x1a * ca.y, x2b * cb.x + x1b * cb.y); }
        asm volatile("" ::: "memory");
      }
  }
};

struct EpiOut {
  static constexpr bool PERM = false, MIDK = true;
  const float* xp; const float* xs; float* out; bf16_t* x1b; const float* ssq_a; const float* ssq_l; float* ssq2;
  __device__ __forceinline__ void mid(f32x4 (&acc)[2][2][4][2], const Unit& u, int wr, int fr_) const {
    int fr = fr_; asm volatile("" : "+v"(fr));
#pragma unroll
    for (int ai = 0; ai < 2; ++ai)
#pragma unroll
      for (int m = 0; m < 4; ++m) { const int row = u.pm * BM + ai * HALF + wr * 64 + m * 16 + fr;
        const float sa = __builtin_amdgcn_rsqf(ssq_a[row] * (1.0f / 1024.0f) + EPS), sl = __builtin_amdgcn_rsqf(ssq_l[row] * (1.0f / 1024.0f) + EPS);
        const float ratio = sa / sl;
#pragma unroll
        for (int bj = 0; bj < 2; ++bj)
#pragma unroll
          for (int n = 0; n < 2; ++n) acc[ai][bj][m][n] *= ratio; }
  }
  __device__ __forceinline__ void operator()(const f32x4 (&acc)[2][2][4][2], const Unit& u, int wr, int wc, int fr_, int fq_) const {
    int fr = fr_, fq = fq_; asm volatile("" : "+v"(fr), "+v"(fq));
    const int col0 = u.pn * BM + wc * 32 + 4 * fq;
#pragma unroll
    for (int ai = 0; ai < 2; ++ai)
#pragma unroll
      for (int m = 0; m < 4; ++m) { const int row = u.pm * BM + ai * HALF + wr * 64 + m * 16 + fr;
        const float sl = __builtin_amdgcn_rsqf(ssq_l[row] * (1.0f / 1024.0f) + EPS);
        const float* xrow = (row < MP) ? xp + (size_t)row * DM : xs + (size_t)(row - MP) * DM; float q = 0.f;
#pragma unroll
        for (int bj = 0; bj < 2; ++bj)
#pragma unroll
          for (int n = 0; n < 2; ++n) { const int c = col0 + bj * HALF + n * 16;
            const f32x4 xv = *(const f32x4*)(xrow + c); const f32x4 o = xv + acc[ai][bj][m][n] * sl;
            *(f32x4*)(out + (size_t)row * DM + c) = o; q += (o[0] * o[0] + o[1] * o[1]) + (o[2] * o[2] + o[3] * o[3]);
            u32x2 w; w.x = cvt_pk_bf16(o[0], o[1]); w.y = cvt_pk_bf16(o[2], o[3]); *(u32x2*)(x1b + (size_t)row * DM + c) = w; }
        q += __shfl_xor(q, 16); q += __shfl_xor(q, 32); if (fq == 0) atomicAdd(ssq2 + row, q); }
  }
};

struct EpiGU {
  static constexpr bool PERM = true, MIDK = false;
  bf16_t* act; const float* ssq2;
  __device__ __forceinline__ void operator()(const f32x4 (&acc)[2][2][4][2], const Unit& u, int wr, int wc, int fr_, int fq_) const {
    int fr = fr_, fq = fq_; asm volatile("" : "+v"(fr), "+v"(fq));
    const int col0 = u.pn * HALF + wc * 32 + 8 * fq;
#pragma unroll
    for (int ai = 0; ai < 2; ++ai)
#pragma unroll
      for (int m = 0; m < 4; ++m) { const int row = u.pm * BM + ai * HALF + wr * 64 + m * 16 + fr;
        const float rs = __builtin_amdgcn_rsqf(ssq2[row] * (1.0f / 2048.0f) + EPS);
        float r[8];
#pragma unroll
        for (int n = 0; n < 2; ++n)
#pragma unroll
          for (int j = 0; j < 4; ++j) { const float gv = acc[ai][0][m][n][j] * rs, uv = acc[ai][1][m][n][j] * rs; r[n * 4 + j] = gv * sigmoidf_(gv) * uv; }
        u32x4 w; w.x = cvt_pk_bf16(r[0], r[1]); w.y = cvt_pk_bf16(r[2], r[3]); w.z = cvt_pk_bf16(r[4], r[5]); w.w = cvt_pk_bf16(r[6], r[7]);
        *(u32x4*)(act + (size_t)row * DFF + col0) = w; }
  }
};

struct EpiDown {
  static constexpr bool PERM = false, MIDK = false;
  float* out;
  __device__ __forceinline__ void operator()(const f32x4 (&acc)[2][2][4][2], const Unit& u, int wr, int wc, int fr_, int fq_) const {
    int fr = fr_, fq = fq_; asm volatile("" : "+v"(fr), "+v"(fq));
    const int col0 = u.pn * BM + wc * 32 + 4 * fq;
#pragma unroll
    for (int ai = 0; ai < 2; ++ai)
#pragma unroll
      for (int m = 0; m < 4; ++m) { const int row = u.pm * BM + ai * HALF + wr * 64 + m * 16 + fr;
#pragma unroll
        for (int bj = 0; bj < 2; ++bj)
#pragma unroll
          for (int n = 0; n < 2; ++n) { float* p = out + (size_t)row * DM + col0 + bj * HALF + n * 16; const f32x4 xv = *(const f32x4*)p; *(f32x4*)p = xv + acc[ai][bj][m][n]; } }
  }
};
}

namespace att {
constexpr int NW = 8, QBLK = 32, KVBLK = 64;
constexpr float QSCALE = 0.10411754627697264f;
constexpr int KROWB = 400;
constexpr int SHM_V = KVBLK * DV * 2, SHM_K = KVBLK * KROWB;
constexpr int QRP = 144;
constexpr int SHM_WS = 3 * SHM_V + 2 * SHM_K, SHM_QR = SHM_WS + NW * 64 * 4, SHM_ATTN = SHM_QR + NW * 32 * QRP;
static_assert(SHM_ATTN <= LDS_BYTES, "attention LDS");
#define SBAR() __builtin_amdgcn_sched_barrier(0)
#define SGB(mask, n) __builtin_amdgcn_sched_group_barrier(mask, n, 0)
__device__ __forceinline__ void sched_qk_sm() {
  SGB(0x100, 4);
#pragma unroll
  for (int i = 0; i < 10; ++i) { SGB(0x008, 2); SGB(0x100, 2); SGB(0x402, 8); }
#pragma unroll
  for (int i = 0; i < 2; ++i) { SGB(0x008, 2); SGB(0x402, 8); }
}
typedef __bf16 bf16x2_t __attribute__((ext_vector_type(2)));
__device__ __forceinline__ unsigned cvtpk_s(float lo, float hi) { f32x2 v = {lo, hi}; bf16x2_t b = __builtin_convertvector(v, bf16x2_t); return __builtin_bit_cast(unsigned, b); }
__device__ __forceinline__ void expA(f32x16& p0) {
#pragma unroll
  for (int r = 0; r < 16; ++r) p0[r] = __builtin_amdgcn_exp2f(p0[r]);
}
__device__ __forceinline__ void finishSM(f32x16& p0, f32x16& p1, float& l_reg, bf16x8& pa0, bf16x8& pa1, bf16x8& pa2, bf16x8& pa3) {
#pragma unroll
  for (int r = 0; r < 16; ++r) p1[r] = __builtin_amdgcn_exp2f(p1[r]);
  float ps = 0;
#pragma unroll
  for (int r = 0; r < 16; ++r) ps += p0[r];
#pragma unroll
  for (int r = 0; r < 16; ++r) ps += p1[r];
  l_reg += ps;
#define PK4(P, BASE, OUT) do { u32x4 w = {cvtpk_s(P[BASE + 0], P[BASE + 1]), cvtpk_s(P[BASE + 2], P[BASE + 3]), cvtpk_s(P[BASE + 4], P[BASE + 5]), cvtpk_s(P[BASE + 6], P[BASE + 7])}; \
    OUT = *reinterpret_cast<bf16x8*>(&w); } while (0)
  PK4(p0, 0, pa0); PK4(p0, 8, pa1); PK4(p1, 0, pa2); PK4(p1, 8, pa3);
#undef PK4
}
__device__ __forceinline__ void qkt(f32x16& p0, f32x16& p1, const char* Ks, const bf16x8* qr, const char* qrl, const f32x16& negm, int r32, int hi) {
  p0 = negm; p1 = negm;
#pragma unroll
  for (int d0 = 0; d0 < 12; ++d0) { const int cb = (d0 * 16 + hi * 8) * 2;
    const bf16x8 b0 = *reinterpret_cast<const bf16x8*>(Ks + r32 * KROWB + cb);
    const bf16x8 b1 = *reinterpret_cast<const bf16x8*>(Ks + (32 + r32) * KROWB + cb);
    const bf16x8 qf = qr[d0];
    p0 = __builtin_amdgcn_mfma_f32_32x32x16_bf16(b0, qf, p0, 0, 0, 0);
    p1 = __builtin_amdgcn_mfma_f32_32x32x16_bf16(b1, qf, p1, 0, 0, 0); }
}
__device__ __forceinline__ int v_st(int k, int c) { const int kk = (k & ~0xC) | ((k & 4) << 1) | ((k & 8) >> 1); return ((kk >> 3) * 4 + (c >> 5)) * 512 + ((kk & 7) * 32 + (c & 31)) * 2; }
__device__ __forceinline__ int v_rd_base(int lane) { return ((lane & 3) << 3) | (((lane >> 2) & 3) << 6) | (((lane >> 4) & 1) << 5) | (((lane >> 5) & 1) << 8); }
constexpr int v_rd_off(int d0, int ks, int half) { return d0 * 512 + ks * 4096 + half * 2048; }
template <int OFF> __device__ __forceinline__ s16x4 tr_read(int vb) {
  s16x4 r; asm volatile("ds_read_b64_tr_b16 %0, %1 offset:%2" : "=&v"(r) : "v"(vb), "i"(OFF) : "memory"); return r;
}
template <int D0> __device__ __forceinline__ void pv_one(f32x16& od, int vb, bf16x8 pa0, bf16x8 pa1, bf16x8 pa2, bf16x8 pa3) {
  const s16x4 l0 = tr_read<v_rd_off(D0, 0, 0)>(vb), h0 = tr_read<v_rd_off(D0, 0, 1)>(vb), l1 = tr_read<v_rd_off(D0, 1, 0)>(vb), h1 = tr_read<v_rd_off(D0, 1, 1)>(vb);
  const s16x4 l2 = tr_read<v_rd_off(D0, 2, 0)>(vb), h2 = tr_read<v_rd_off(D0, 2, 1)>(vb), l3 = tr_read<v_rd_off(D0, 3, 0)>(vb), h3 = tr_read<v_rd_off(D0, 3, 1)>(vb);
  asm volatile("s_waitcnt lgkmcnt(0)" ::: "memory"); SBAR();
#define PK(L, H) (bf16x8){L[0], L[1], L[2], L[3], H[0], H[1], H[2], H[3]}
  od = __builtin_amdgcn_mfma_f32_32x32x16_bf16(pa0, PK(l0, h0), od, 0, 0, 0);
  od = __builtin_amdgcn_mfma_f32_32x32x16_bf16(pa1, PK(l1, h1), od, 0, 0, 0);
  od = __builtin_amdgcn_mfma_f32_32x32x16_bf16(pa2, PK(l2, h2), od, 0, 0, 0);
  od = __builtin_amdgcn_mfma_f32_32x32x16_bf16(pa3, PK(l3, h3), od, 0, 0, 0);
#undef PK
}
__device__ __forceinline__ void pv_d0(f32x16* o, int vb, bf16x8 pa0, bf16x8 pa1, bf16x8 pa2, bf16x8 pa3) {
  pv_one<0>(o[0], vb, pa0, pa1, pa2, pa3); pv_one<1>(o[1], vb, pa0, pa1, pa2, pa3); pv_one<2>(o[2], vb, pa0, pa1, pa2, pa3); pv_one<3>(o[3], vb, pa0, pa1, pa2, pa3);
}
__device__ __forceinline__ void attn_unit(const bf16_t* __restrict__ Qb, const bf16_t* __restrict__ Kh, const bf16_t* __restrict__ Vh, bf16_t* __restrict__ Ob, float* __restrict__ ssq, int seq, float kbound, char* lds, LAS unsigned char* ldsl) {
  int tid_ = threadIdx.x; asm volatile("" : "+v"(tid_));
  const int tid = tid_, wid = tid >> 6, lane = tid & 63, r32 = lane & 31, hi = lane >> 5;
  char* V_lds = lds; char* K_lds = lds + 3 * SHM_V;
  float* ws = (float*)(lds + SHM_WS) + wid * 64; float* li_l = ws;
  float l_reg = 0; f32x16 o[4] = {}; bf16x8 qr[12];
  const bf16_t* Qw = Qb + (size_t)(wid * QBLK + r32) * DK + hi * 8;
  float qss = 0.f;
#pragma unroll
  for (int d0 = 0; d0 < 8; ++d0) { qr[d0] = *reinterpret_cast<const bf16x8*>(Qw + d0 * 16);
#pragma unroll
    for (int e = 0; e < 8; ++e) { const float v = bf2f((bf16_t)qr[d0][e]); qss += v * v; } }
  const char* qrl = nullptr;
#pragma unroll
  for (int d0 = 8; d0 < 12; ++d0) { const bf16x8 qv = *reinterpret_cast<const bf16x8*>(Qw + d0 * 16); qr[d0] = qv;
#pragma unroll
    for (int e = 0; e < 8; ++e) { const float v = bf2f((bf16_t)qv[e]); qss += v * v; } }
  { auto rr = __builtin_amdgcn_permlane32_swap(__float_as_uint(qss), __float_as_uint(qss), false, false); qss = __uint_as_float(rr[0]) + __uint_as_float(rr[1]); }
  f32x16 negm; { const float nm = -__builtin_amdgcn_sqrtf(qss) * kbound;
#pragma unroll
    for (int r = 0; r < 16; ++r) negm[r] = nm; }
  asm volatile("" : "+v"(negm));
  const int vb0 = (int)(uintptr_t)V_lds + v_rd_base(lane);
  const int uw = __builtin_amdgcn_readfirstlane(wid);
  unsigned koff[4], voff[2];
#pragma unroll
  for (int i = 0; i < 4; ++i) { const int c = (uw + 8 * i) * 64 + lane, row = c / 25, cc = c - row * 25; koff[i] = (unsigned)(row * 384 + (cc < 24 ? cc : 23) * 16); }
#pragma unroll
  for (int i = 0; i < 2; ++i) { const int P = (uw + 8 * i) * 64 + lane, sub = P >> 5, within = P & 31, kk = (sub >> 2) * 8 + (within >> 2), c = (sub & 3) * 32 + (within & 3) * 8;
    const int k = kk;
    voff[i] = (unsigned)(k * 256 + c * 2); }
  LAS unsigned char* Vl = ldsl; LAS unsigned char* Kl = ldsl + 3 * SHM_V;
#define UNI64(p) ((const char*)((((unsigned long long)(unsigned)__builtin_amdgcn_readfirstlane((int)((unsigned long long)(p) >> 32))) << 32) | (unsigned long long)(unsigned)__builtin_amdgcn_readfirstlane((int)(unsigned)(unsigned long long)(p))))
#define GLDS16S(voff_, sbase_, ldsaddr_) do { unsigned keep_; asm volatile("s_mov_b32 %0, m0\n\ts_mov_b32 m0, %3\n\ts_nop 0\n\tglobal_load_lds_dwordx4 %1, %2\n\ts_mov_b32 m0, %0" \
    : "=&s"(keep_) : "v"(voff_), "s"(sbase_), "s"(ldsaddr_) : "memory"); } while (0)
#define DMA_TILE(t, kbuf, vbuf) do { const char* kt_ = UNI64((const char*)Kh + (size_t)(t) * (KVBLK * DK * 2)); const char* vt_ = UNI64((const char*)Vh + (size_t)(t) * (KVBLK * DV * 2)); \
    const unsigned kl_ = (unsigned)__builtin_amdgcn_readfirstlane((int)(unsigned)(unsigned long)(Kl + (kbuf) * SHM_K + uw * 1024)); \
    const unsigned vl_ = (unsigned)__builtin_amdgcn_readfirstlane((int)(unsigned)(unsigned long)(Vl + (vbuf) * SHM_V + uw * 1024)); \
    GLDS16S(koff[0], kt_, kl_); GLDS16S(koff[1], kt_, kl_ + 8 * 1024); GLDS16S(koff[2], kt_, kl_ + 16 * 1024); \
    if (uw == 0) GLDS16S(koff[3], kt_, kl_ + 24 * 1024); \
    GLDS16S(voff[0], vt_, vl_); GLDS16S(voff[1], vt_, vl_ + 8 * 1024); } while (0)
#define DMA_SYNC() do { asm volatile("s_waitcnt vmcnt(0)" ::: "memory"); __syncthreads(); } while (0)
  f32x16 pA0, pA1, pB0, pB1; bf16x8 pa0, pa1, pa2, pa3; const int NT = seq / KVBLK;
  int ip = 2, ic = 0, in = 1;
#define ROT() do { const int t_ = ip; ip = ic; ic = in; in = t_; } while (0)
  DMA_TILE(0, 0, 0); DMA_SYNC();
  DMA_TILE(1, 1, in); SBAR();
  qkt(pA0, pA1, K_lds, qr, qrl, negm, r32, hi); expA(pA0);
  DMA_SYNC(); ROT();
  for (int j = 1; j + 1 < NT; j += 2) {
    DMA_TILE(j + 1, 0, in); SBAR();
    qkt(pB0, pB1, K_lds + SHM_K, qr, qrl, negm, r32, hi);
    finishSM(pA0, pA1, l_reg, pa0, pa1, pa2, pa3); sched_qk_sm(); SBAR();
    pv_d0(o, vb0 + ip * SHM_V, pa0, pa1, pa2, pa3); expA(pB0);
    DMA_SYNC(); ROT();
    DMA_TILE(j + 2, 1, in); SBAR();
    qkt(pA0, pA1, K_lds, qr, qrl, negm, r32, hi);
    finishSM(pB0, pB1, l_reg, pa0, pa1, pa2, pa3); sched_qk_sm(); SBAR();
    pv_d0(o, vb0 + ip * SHM_V, pa0, pa1, pa2, pa3); expA(pA0);
    DMA_SYNC(); ROT();
  }
  SBAR(); qkt(pB0, pB1, K_lds + SHM_K, qr, qrl, negm, r32, hi);
  finishSM(pA0, pA1, l_reg, pa0, pa1, pa2, pa3); SBAR();
  pv_d0(o, vb0 + ip * SHM_V, pa0, pa1, pa2, pa3); expA(pB0);
  finishSM(pB0, pB1, l_reg, pa0, pa1, pa2, pa3); SBAR();
  pv_d0(o, vb0 + ic * SHM_V, pa0, pa1, pa2, pa3);
#undef ROT
#undef UNI64
#undef GLDS16S
#undef DMA_TILE
#undef DMA_SYNC
  { auto rr = __builtin_amdgcn_permlane32_swap(__float_as_uint(l_reg), __float_as_uint(l_reg), false, false); l_reg = __uint_as_float(rr[0]) + __uint_as_float(rr[1]); }
  if (hi == 0) li_l[r32] = l_reg; asm volatile("s_waitcnt lgkmcnt(0)" ::: "memory");
  int lane_e = lane; asm volatile("" : "+v"(lane_e));
  const int r32e = lane_e & 31, hie = lane_e >> 5;
  float rli[16];
#pragma unroll
  for (int r = 0; r < 16; ++r) rli[r] = __builtin_amdgcn_rcpf(li_l[crow(r, hie)]);
  __syncthreads();
  bf16_t* stg = (bf16_t*)(lds + wid * 8192);
#pragma unroll
  for (int r = 0; r < 16; ++r) { const int orow = crow(r, hie);
#pragma unroll
    for (int d0 = 0; d0 < 4; ++d0) { const float v = o[d0][r] * rli[r]; stg[orow * 128 + d0 * 32 + r32e] = (bf16_t)(cvt_pk_bf16(v, v) & 0xffffu); } }
  asm volatile("s_waitcnt lgkmcnt(0)" ::: "memory");
#pragma unroll
  for (int i = 0; i < 8; ++i) { const int row = i * 4 + (lane_e >> 4), ch = lane_e & 15;
    const u32x4 v = *(const u32x4*)(stg + row * 128 + ch * 8);
    *(u32x4*)(Ob + (size_t)(wid * QBLK + row) * DM + ch * 8) = v;
    float q = bflo(v.x) * bflo(v.x) + bfhi(v.x) * bfhi(v.x) + bflo(v.y) * bflo(v.y) + bfhi(v.y) * bfhi(v.y) + bflo(v.z) * bflo(v.z) + bfhi(v.z) * bfhi(v.z) + bflo(v.w) * bflo(v.w) + bfhi(v.w) * bfhi(v.w);
    q += shflx(q, lane_e, 1); q += shflx(q, lane_e, 2); q += shflx(q, lane_e, 4); q += shflx(q, lane_e, 8);
    if (ch == 0) atomicAdd(ssq + wid * QBLK + row, q); }
  __syncthreads();
}
#undef SBAR
}

namespace lru {
constexpr int XROW = 136;
constexpr int X_BYTES = 256 * XROW * 2;
constexpr int COMP_OFF = X_BYTES, COMP_BYTES = 4 * 2 * 8 * 32 * 8;
constexpr int CARRY_OFF = COMP_OFF + COMP_BYTES;
constexpr int PRM_OFF = CARRY_OFF + 1024 + 32768;
constexpr int WB_OFF = CARRY_OFF + 1024;
template <bool REV> __device__ __forceinline__ void seg_comp(const float (&a)[16], const float (&bx)[16], float (&A)[4], float (&B)[4]) {
#pragma unroll
  for (int q = 0; q < 4; ++q) { float Aq = 1.f, Bq = 0.f;
#pragma unroll
    for (int ee = 0; ee < 4; ++ee) { const int e = REV ? 3 - ee : ee; const int r = 4 * q + e; Bq = a[r] * Bq + bx[r]; Aq *= a[r]; }
    A[q] = Aq; B[q] = Bq; }
}
template <bool REV> __device__ __forceinline__ float seg_prefix(const float (&loA)[4], const float (&loB)[4], const float (&hiA)[4], const float (&hiB)[4], int hi, float st, float (&start)[4]) {
#pragma unroll
  for (int qq = 0; qq < 4; ++qq) { const int q = REV ? 3 - qq : qq;
    if (!REV) { const float t1 = loA[q] * st + loB[q]; start[q] = hi ? t1 : st; st = hiA[q] * t1 + hiB[q]; }
    else { const float t1 = hiA[q] * st + hiB[q]; start[q] = hi ? st : t1; st = loA[q] * t1 + loB[q]; } }
  return st;
}
template <int PASS>
__device__ __forceinline__ void unit(const Params& p, int chunk, int n, char* lds, float* ssq_l) {
  int tid_ = threadIdx.x; asm volatile("" : "+v"(tid_));
  const int tid = tid_, wid = __builtin_amdgcn_readfirstlane(tid >> 6), lane = tid & 63, j = lane & 31, hi = lane >> 5;
  const int row0 = chunk * 256;
  int seq_start, seq_len;
  if (row0 < MP) { seq_start = row0 & ~(SEQP - 1); seq_len = SEQP; } else { seq_start = MP + ((row0 - MP) & ~(SEQS - 1)); seq_len = SEQS; }
  const int cs = (row0 - seq_start) >> 8, nch = seq_len >> 8, cbase = seq_start >> 8;
  const bf16_t* U = (const bf16_t*)(p.ws + WS_U);
  bf16_t* X = (bf16_t*)lds;
  f32x2* comp = (f32x2*)(lds + COMP_OFF);
  float* carry = (float*)(lds + CARRY_OFF);
  f32x2* agg = (f32x2*)(p.ws + WS_AGG);
  const bf16_t* Wf = (const bf16_t*)(p.ws + WS_BRG) + (size_t)n * 4 * 4 * 8 * 64 * 8;
  char* WB = lds + WB_OFF;
#define WSRC(cg, d, wh) (Wf + ((size_t)(((2 * (d) + (wh)) * 4 + (cg)) * 8) * 64 + tid) * 8)
  bf16x8 sw0 = *(const bf16x8*)WSRC(0, 0, 0), sw1 = *(const bf16x8*)WSRC(0, 0, 1);
  { const int cg8 = (tid & 15) * 8, tg = tid >> 4; const int c0 = n * 128 + cg8;
    const float* cw = p.in[10]; const float* cb = p.in[11];
    float w[4][8], bb[8];
#pragma unroll
    for (int t = 0; t < 4; ++t) { const f32x4 a = *(const f32x4*)(cw + t * 1024 + c0), b = *(const f32x4*)(cw + t * 1024 + c0 + 4);
      w[t][0] = a[0]; w[t][1] = a[1]; w[t][2] = a[2]; w[t][3] = a[3]; w[t][4] = b[0]; w[t][5] = b[1]; w[t][6] = b[2]; w[t][7] = b[3]; }
    { const f32x4 a = *(const f32x4*)(cb + c0), b = *(const f32x4*)(cb + c0 + 4); bb[0] = a[0]; bb[1] = a[1]; bb[2] = a[2]; bb[3] = a[3]; bb[4] = b[0]; bb[5] = b[1]; bb[6] = b[2]; bb[7] = b[3]; }
    u32x4 rw[11];
#pragma unroll
    for (int rr = 0; rr < 11; ++rr) { const int grow = row0 + tg * 8 + rr - 1; const bool ok = (grow >= seq_start) && (grow < seq_start + seq_len);
      rw[rr] = ok ? *(const u32x4*)(U + (size_t)grow * LDU + UC_X + c0) : (u32x4){0u, 0u, 0u, 0u}; }
#pragma unroll
    for (int t = 0; t < 8; ++t) { float y[8];
#pragma unroll
      for (int c = 0; c < 8; ++c) y[c] = bb[c];
#pragma unroll
      for (int tp = 0; tp < 4; ++tp) { const u32x4 v = rw[t + tp];
        y[0] += w[tp][0] * bflo(v.x); y[1] += w[tp][1] * bfhi(v.x); y[2] += w[tp][2] * bflo(v.y); y[3] += w[tp][3] * bfhi(v.y);
        y[4] += w[tp][4] * bflo(v.z); y[5] += w[tp][5] * bfhi(v.z); y[6] += w[tp][6] * bflo(v.w); y[7] += w[tp][7] * bfhi(v.w); }
      u32x4 o; o.x = cvt_pk_bf16(y[0], y[1]); o.y = cvt_pk_bf16(y[2], y[3]); o.z = cvt_pk_bf16(y[4], y[5]); o.w = cvt_pk_bf16(y[6], y[7]);
      *(u32x4*)(X + (tg * 8 + t) * XROW + cg8) = o; }
  }
  if (PASS == 2 && tid < 256) { const int dir = tid >> 7, ch = tid & 127; float st = 0.f;
    const int cnt = dir ? nch - 1 - cs : cs;
    for (int k0 = 0; k0 < cnt; k0 += 16) { f32x2 ab[16];
#pragma unroll
      for (int i = 0; i < 16; ++i) { const int k = k0 + i; const bool ok = k < cnt; const int c = ok ? (dir ? nch - 1 - k : k) : cs;
        ab[i] = agg[(size_t)(dir * NCHUNK + cbase + c) * 1024 + n * 128 + ch]; if (!ok) ab[i] = (f32x2){1.f, 0.f}; }
#pragma unroll
      for (int i = 0; i < 16; ++i) st = ab[i].x * st + ab[i].y; }
    carry[dir * 128 + ch] = st; }
  *(bf16x8*)(WB + tid * 16) = sw0; *(bf16x8*)(WB + 8192 + tid * 16) = sw1;
  if (tid < 256) { const int dir = tid >> 7, ch = tid & 127;
    const float lm = p.in[16][dir * 1024 + n * 128 + ch];
    *(f32x4*)(lds + PRM_OFF + (dir * 128 + ch) * 16) = (f32x4){p.in[13][(dir * 8 + n) * 128 + ch], p.in[15][(dir * 8 + n) * 128 + ch], (8.0f * 1.4426950408889634f) * log1pf(__expf(-lm)), 0.f}; }
  __syncthreads();
  const float* lam = p.in[16];
  const bf16_t* Xw = X + (32 * wid + j) * XROW + 8 * hi;
  for (int cgp = 0; cgp < 4; ++cgp) {
    const int ch = 32 * cgp + j, gch = n * 128 + ch;
    float sum[16];
    bf16_t graw[16];
    if (PASS == 2) { int rb = row0 + 32 * wid + 4 * hi; asm volatile("" : "+v"(rb));
#pragma unroll
      for (int r = 0; r < 16; ++r) graw[r] = U[(size_t)(rb + (r & 3) + 8 * (r >> 2)) * LDU + UC_G + gch];
    }
#pragma unroll
    for (int dir = 0; dir < 2; ++dir) {
      const bool has_next = !(cgp == 3 && dir == 1);
      if (has_next) { const int ncg = dir ? cgp + 1 : cgp; sw0 = *(const bf16x8*)WSRC(ncg, dir ^ 1, 0); sw1 = *(const bf16x8*)WSRC(ncg, dir ^ 1, 1); }
      f32x16 accr = f32x16{}, acci = f32x16{};
#pragma unroll
      for (int ks = 0; ks < 8; ++ks) { const bf16x8 xa = *(const bf16x8*)(Xw + 16 * ks);
        const bf16x8 bfr = *(const bf16x8*)(WB + dir * 16384 + ks * 1024 + lane * 16);
        const bf16x8 bfi = *(const bf16x8*)(WB + dir * 16384 + 8192 + ks * 1024 + lane * 16);
        accr = __builtin_amdgcn_mfma_f32_32x32x16_bf16(xa, bfr, accr, 0, 0, 0);
        acci = __builtin_amdgcn_mfma_f32_32x32x16_bf16(xa, bfi, acci, 0, 0, 0);
        if ((ks & 3) == 3) __builtin_amdgcn_sched_barrier(0); }
      const f32x4 prm = *(const f32x4*)(lds + PRM_OFF + (dir * 128 + ch) * 16);
      const float br = prm[0], bi = prm[1], c8 = prm[2];
      float a[16], bx[16];
#pragma unroll
      for (int r = 0; r < 16; ++r) { const float xv = bf2f(X[(32 * wid + crow(r, hi)) * XROW + ch]);
        const float rg = sigmoidf_(accr[r] + br), ig = sigmoidf_(acci[r] + bi);
        const float av = __builtin_amdgcn_exp2f(-c8 * rg); a[r] = av; bx[r] = __builtin_amdgcn_sqrtf(fmaxf(1.0f - av * av, 0.f)) * ig * xv; }
      float A[4], B[4], loA[4], loB[4], hiA[4], hiB[4], start[4];
      if (dir == 0) seg_comp<false>(a, bx, A, B); else seg_comp<true>(a, bx, A, B);
#pragma unroll
      for (int q = 0; q < 4; ++q) { const float pA = __shfl_xor(A[q], 32), pB = __shfl_xor(B[q], 32);
        loA[q] = hi ? pA : A[q]; loB[q] = hi ? pB : B[q]; hiA[q] = hi ? A[q] : pA; hiB[q] = hi ? B[q] : pB; }
      float Aw = 1.f;
#pragma unroll
      for (int q = 0; q < 4; ++q) Aw *= loA[q] * hiA[q];
      const float Bw = (dir == 0) ? seg_prefix<false>(loA, loB, hiA, hiB, hi, 0.f, start) : seg_prefix<true>(loA, loB, hiA, hiB, hi, 0.f, start);
      if (hi == 0) comp[((cgp * 2 + dir) * 8 + wid) * 32 + j] = (f32x2){Aw, Bw};
      if (has_next) { *(bf16x8*)(WB + (dir ^ 1) * 16384 + tid * 16) = sw0; *(bf16x8*)(WB + (dir ^ 1) * 16384 + 8192 + tid * 16) = sw1; }
      __syncthreads();
      if (PASS == 2) {
        float st = carry[dir * 128 + ch];
        if (dir == 0) { for (int w2 = 0; w2 < wid; ++w2) { const f32x2 ab = comp[((cgp * 2 + 0) * 8 + w2) * 32 + j]; st = ab.x * st + ab.y; } }
        else { for (int w2 = 7; w2 > wid; --w2) { const f32x2 ab = comp[((cgp * 2 + 1) * 8 + w2) * 32 + j]; st = ab.x * st + ab.y; } }
        if (dir == 0) { (void)seg_prefix<false>(loA, loB, hiA, hiB, hi, st, start);
#pragma unroll
          for (int q = 0; q < 4; ++q) { float h = start[q];
#pragma unroll
            for (int e = 0; e < 4; ++e) { const int r = 4 * q + e; h = a[r] * h + bx[r]; sum[r] = h; } } }
        else { (void)seg_prefix<true>(loA, loB, hiA, hiB, hi, st, start);
#pragma unroll
          for (int q = 0; q < 4; ++q) { float h = start[q];
#pragma unroll
            for (int ee = 0; ee < 4; ++ee) { const int r = 4 * q + 3 - ee; h = a[r] * h + bx[r]; sum[r] += h; } } }
      }
    }
    if (PASS == 2) {
      bf16_t* mixed = (bf16_t*)(p.ws + WS_XB);
      int rb2 = row0 + 32 * wid + 4 * hi, lane2 = lane; asm volatile("" : "+v"(rb2), "+v"(lane2));
#pragma unroll
      for (int r = 0; r < 16; ++r) { const int row = rb2 + (r & 3) + 8 * (r >> 2);
        const float g = bf2f(graw[r]);
        const float u3 = 0.7978845608028654f * (g + 0.044715f * g * g * g);
        const float th = 1.0f - 2.0f * __builtin_amdgcn_rcpf(1.0f + __builtin_amdgcn_exp2f((2.0f * 1.4426950408889634f) * u3));
        const float val = sum[r] * (0.5f * g * (1.0f + th));
        const unsigned pk = cvt_pk_bf16(val, val); const bf16_t hv = (bf16_t)(pk & 0xffffu);
        mixed[(size_t)row * DM + 1024 + gch] = hv;
        float q = bf2f(hv); q = q * q;
        q += shflx(q, lane2, 1); q += shflx(q, lane2, 2); q += shflx(q, lane2, 4); q += shflx(q, lane2, 8); q += shflx(q, lane2, 16);
        if ((lane2 & 31) == 0) atomicAdd(ssq_l + row, q); }
    }
  }
  if (PASS == 1) {
    __syncthreads();
    if (tid < 256) { const int dir = tid >> 7, ch = tid & 127, cgp = ch >> 5, jj = ch & 31; float A = 1.f, B = 0.f;
      if (dir == 0) { for (int w2 = 0; w2 < 8; ++w2) { const f32x2 ab = comp[((cgp * 2 + 0) * 8 + w2) * 32 + jj]; B = ab.x * B + ab.y; A *= ab.x; } }
      else { for (int w2 = 7; w2 >= 0; --w2) { const f32x2 ab = comp[((cgp * 2 + 1) * 8 + w2) * 32 + jj]; B = ab.x * B + ab.y; A *= ab.x; } }
      agg[(size_t)(dir * NCHUNK + chunk) * 1024 + n * 128 + ch] = (f32x2){A, B}; }
  }
  __syncthreads();
#undef WSRC
}
}

__device__ __forceinline__ void tr_item(const float* W, int ldw, int K, int srccol0, const float* gk, bf16_t* dst, int k0, LAS float* scr, int lane) {
  { const int n4 = (lane & 7) * 4; f32x4 v[8];
#pragma unroll
    for (int i = 0; i < 8; ++i) { const int kk = 8 * i + (lane >> 3); v[i] = (f32x4){0.f, 0.f, 0.f, 0.f};
      if (srccol0 >= 0) { v[i] = *(const f32x4*)(W + (size_t)(k0 + kk) * ldw + srccol0 + n4); if (gk) v[i] = v[i] * gk[kk]; } }
#pragma unroll
    for (int i = 0; i < 8; ++i) { const int kk = 8 * i + (lane >> 3); LAS float* d = scr + kk * 33 + n4; d[0] = v[i][0]; d[1] = v[i][1]; d[2] = v[i][2]; d[3] = v[i][3]; } }
  asm volatile("s_waitcnt lgkmcnt(0)" ::: "memory");
  const int c = lane & 7;
#pragma unroll
  for (int jq = 0; jq < 4; ++jq) { const int nn = (lane >> 3) + 8 * jq; const LAS float* s = scr + (8 * c) * 33 + nn;
    u32x4 o; o.x = cvt_pk_bf16(s[0 * 33], s[1 * 33]); o.y = cvt_pk_bf16(s[2 * 33], s[3 * 33]); o.z = cvt_pk_bf16(s[4 * 33], s[5 * 33]); o.w = cvt_pk_bf16(s[6 * 33], s[7 * 33]);
    *(u32x4*)(dst + (size_t)nn * K + k0 + 8 * c) = o; }
  asm volatile("s_waitcnt lgkmcnt(0)" ::: "memory");
}

__device__ __forceinline__ void p0_prologue(const Params& p, LAS unsigned char* lds, int vcu, int G) {
  int tid_ = threadIdx.x; asm volatile("" : "+v"(tid_));
  const int tid = tid_, lane = tid & 63, wave = __builtin_amdgcn_readfirstlane(tid >> 6);
  const int gw = vcu * 8 + wave, NGW = G * 8;
  const size_t gt = (size_t)blockIdx.x * 512 + tid, NGT = (size_t)G * 512;
  unsigned char* ws = p.ws;
  { float* z = (float*)(ws + WS_ZERO); for (size_t i = gt; i < ZERO_BYTES / 4; i += NGT) z[i] = 0.f; }
  { f32x2* rt = (f32x2*)(ws + WS_ROPE);
    for (size_t i = gt; i < (size_t)SEQP * 32; i += NGT) { const int s = (int)(i >> 5), f = (int)(i & 31);
      double rev = (double)s * INV_FREQ[f] * 0.15915494309189535; rev -= __builtin_rint(rev); const float r = (float)rev;
      rt[i] = (f32x2){__builtin_amdgcn_cosf(r), __builtin_amdgcn_sinf(r)}; } }
  { bf16_t* wf = (bf16_t*)(ws + WS_BRG);
    for (size_t ci = gt; ci < 65536; ci += NGT) { const int ln = (int)(ci & 63), ks = (int)((ci >> 6) & 7), cgp = (int)((ci >> 9) & 3), dw = (int)((ci >> 11) & 3), n = (int)(ci >> 13);
      const int jj = ln & 31, kg = ln >> 5, dir = dw >> 1, wh = dw & 1;
      const float* src = (wh ? p.in[14] : p.in[12]) + (size_t)(dir * 8 + n) * 128 * 128 + (size_t)(16 * ks + 8 * kg) * 128 + 32 * cgp + jj;
      u32x4 o; o.x = cvt_pk_bf16(src[0], src[128]); o.y = cvt_pk_bf16(src[256], src[384]); o.z = cvt_pk_bf16(src[512], src[640]); o.w = cvt_pk_bf16(src[768], src[896]);
      *(u32x4*)(wf + ci * 8) = o; } }
  { bf16_t* xb = (bf16_t*)(ws + WS_XB); float* rs1 = (float*)(ws + WS_RS1);
    for (int m0 = gw; m0 < M; m0 += 4 * NGW) {
      int mr[4]; const float* xr[4]; f32x4 v[4][8]; float ss[4];
#pragma unroll
      for (int t = 0; t < 4; ++t) { mr[t] = (m0 + t * NGW < M) ? m0 + t * NGW : m0; xr[t] = (mr[t] < MP) ? p.in[0] + (size_t)mr[t] * DM : p.in[1] + (size_t)(mr[t] - MP) * DM; }
#pragma unroll
      for (int q = 0; q < 8; ++q)
#pragma unroll
        for (int t = 0; t < 4; ++t) v[t][q] = *(const f32x4*)(xr[t] + q * 256 + lane * 4);
#pragma unroll
      for (int t = 0; t < 4; ++t) { float a = 0.f;
#pragma unroll
        for (int q = 0; q < 8; ++q) a += (v[t][q][0] * v[t][q][0] + v[t][q][1] * v[t][q][1]) + (v[t][q][2] * v[t][q][2] + v[t][q][3] * v[t][q][3]);
        ss[t] = wave_sum(a); }
      if (lane == 0) {
#pragma unroll
        for (int t = 0; t < 4; ++t) rs1[mr[t]] = 1.0f / sqrtf(ss[t] * (1.0f / DM) + EPS); }
#pragma unroll
      for (int t = 0; t < 4; ++t)
#pragma unroll
        for (int q = 0; q < 8; ++q) { u32x2 w; w.x = cvt_pk_bf16(v[t][q][0], v[t][q][1]); w.y = cvt_pk_bf16(v[t][q][2], v[t][q][3]); *(u32x2*)(xb + (size_t)mr[t] * DM + q * 256 + lane * 4) = w; } } }
  LAS float* scr = (LAS float*)(lds + wave * 16384);
  constexpr int I_IN = 96 * 32, I_UQ = 64 * 8, I_UKV = 64 * 4, I_OUT = 64 * 32, I_GU = 352 * 32, I_DN = 64 * 88;
  constexpr int NITEMS = I_IN + I_UQ + I_UKV + I_OUT + I_GU + I_DN;
  for (int it = gw; it < NITEMS; it += NGW) {
    int r = it;
    if (r < I_IN) { const int ng = r >> 5, kb = r & 31, dc = ng * 32; int sc;
      if (dc < 768) sc = dc; else if (dc < 1792) sc = dc - 768 + 832; else if (dc < 2816) sc = dc - 1792 + 1856; else if (dc < 2880) sc = dc - 2816 + 768; else sc = -1;
      tr_item(p.in[3], 2880, 2048, sc, p.in[2] + kb * 64, (bf16_t*)(ws + WS_BIN) + (size_t)dc * 2048, kb * 64, scr, lane); continue; } r -= I_IN;
    if (r < I_UQ) { const int ng = r >> 3, kb = r & 7, h = ng >> 3, t0 = (ng & 7) * 32; int d;
      if (t0 < 96) d = t0; else if (t0 == 96) d = 128; else if (t0 == 128) d = 96; else if (t0 == 224) d = 160; else d = -1;
      tr_item(p.in[5], 1536, 512, d < 0 ? -1 : h * 192 + d, p.in[4] + kb * 64, (bf16_t*)(ws + WS_BUQ) + (size_t)(ng * 32) * 512, kb * 64, scr, lane); continue; } r -= I_UQ;
    if (r < I_UKV) { const int ng = r >> 2, kb = r & 3;
      tr_item(p.in[7], 2048, 256, ng * 32, p.in[6] + kb * 64, (bf16_t*)(ws + WS_BUKV) + (size_t)(ng * 32) * 256, kb * 64, scr, lane); continue; } r -= I_UKV;
    if (r < I_OUT) { const int ng = r >> 5, kb = r & 31; const float* gk = (kb < 16) ? p.in[17] + kb * 64 : p.in[18] + (kb - 16) * 64;
      tr_item(p.in[19], 2048, 2048, ng * 32, gk, (bf16_t*)(ws + WS_BOUT) + (size_t)(ng * 32) * 2048, kb * 64, scr, lane); continue; } r -= I_OUT;
    if (r < I_GU) { const int ng = r >> 5, kb = r & 31, R = ng * 32, pn = R >> 8, within = R & 255, bj = within >> 7, c = within & 127;
      tr_item(bj ? p.in[22] : p.in[21], DFF, 2048, pn * 128 + c, p.in[20] + kb * 64, (bf16_t*)(ws + WS_BGU) + (size_t)R * 2048, kb * 64, scr, lane); continue; } r -= I_GU;
    { const int ng = r / 88, kb = r % 88;
      tr_item(p.in[23], 2048, DFF, ng * 32, nullptr, (bf16_t*)(ws + WS_BDN) + (size_t)(ng * 32) * DFF, kb * 64, scr, lane); }
  }
}

__global__ void __launch_bounds__(512, 2) hymba_fwd(Params p) {
  extern __shared__ __attribute__((aligned(16))) unsigned char lds[];
  cg::grid_group grid = cg::this_grid();
  LAS unsigned char* ldsl = (LAS unsigned char*)lds;
  const int G = gridDim.x, bx = blockIdx.x;
  const int vcu = (G % 8 == 0) ? (bx % 8) * (G / 8) + bx / 8 : bx;
  unsigned char* ws = p.ws;
  float* const dummy = (float*)(ws + WS_DUMMY);
#ifndef PROBE_TA
#define PROBE_TA -1
#define PROBE_TB -1
#endif
  unsigned long long t_a = 0, t_b = 0;
#define STAMP(k) do { if (PROBE_TA >= 0) { if ((k) == PROBE_TA) t_a = __builtin_amdgcn_s_memrealtime(); if ((k) == PROBE_TB) t_b = __builtin_amdgcn_s_memrealtime(); } } while (0)
  STAMP(0);

#ifndef NO_P0
  for (int rep = 0; rep < NREP(0); ++rep) p0_prologue(p, ldsl, vcu, G);
#endif
  grid.sync(); STAMP(1);

  for (int rep = 0; rep < NREP(1); ++rep) { pg8::Gemm g{(const bf16_t*)(ws + WS_XB), (const bf16_t*)(ws + WS_BIN), DM, LDU, DM}; pg8::StaticOrder S; S.init(M, LDU, G, bx);
    pg8::EpiU E{(bf16_t*)(ws + WS_U), (const float*)(ws + WS_RS1), rep ? dummy : (float*)(ws + WS_SSQ_Q), rep ? dummy : (float*)(ws + WS_SSQ_KV), rep ? dummy : (float*)(ws + WS_SSQ_PE)};

#ifndef NO_EPIU
    pg8::gemm_phase<pg8::EpiU>(ldsl, g, S, E);
#endif
  }
  grid.sync(); STAMP(2);

  for (int rep = 0; rep < NREP(2); ++rep) {
  { pg8::Gemm g{(const bf16_t*)(ws + WS_U) + UC_Q, (const bf16_t*)(ws + WS_BUQ), LDU, 2048, 512}; pg8::StaticOrder S; S.init(M, 2048, G, bx);
    pg8::EpiQ E{(bf16_t*)(ws + WS_Q), (const float*)(ws + WS_SSQ_Q), p.in[8], (const f32x2*)(ws + WS_ROPE), (LAS float*)(ldsl + XCH_OFF)};

#ifndef NO_EPIQ
    pg8::gemm_phase<pg8::EpiQ>(ldsl, g, S, E);
#endif
  }
  { pg8::Gemm g{(const bf16_t*)(ws + WS_U) + UC_KV, (const bf16_t*)(ws + WS_BUKV), LDU, 2048, 256}; pg8::StaticOrder S; S.init(M, 2048, G, bx);
    pg8::EpiKV E{(bf16_t*)(ws + WS_K), (bf16_t*)(ws + WS_V), (const bf16_t*)(ws + WS_U), (const float*)(ws + WS_SSQ_KV), (const float*)(ws + WS_SSQ_PE), p.in[9], (const f32x2*)(ws + WS_ROPE), (LAS float*)(ldsl + XCH_OFF)};

#ifndef NO_EPIKV
    pg8::gemm_phase<pg8::EpiKV>(ldsl, g, S, E);
#endif
  }
#ifndef NO_LRU1
  for (int u = vcu; u < NCHUNK * 8; u += G) lru::unit<1>(p, u >> 3, u & 7, (char*)lds, nullptr);
#endif
  }
  grid.sync(); STAMP(3);

#ifndef NO_LRU2
  for (int rep = 0; rep < NREP(3); ++rep)
  for (int u = vcu; u < NCHUNK * 8; u += G) lru::unit<2>(p, u >> 3, u & 7, (char*)lds, rep ? dummy : (float*)(ws + WS_SSQ_L));
#endif
  STAMP(4);

#ifndef NO_ATT
  { const bf16_t* Qt = (const bf16_t*)(ws + WS_Q); const bf16_t* Kt = (const bf16_t*)(ws + WS_K); const bf16_t* Vt = (const bf16_t*)(ws + WS_V);
    bf16_t* mixed = (bf16_t*)(ws + WS_XB); float* ssq_a = (float*)(ws + WS_SSQ_A);
    float kbound; { const int ln = threadIdx.x & 63; float gm = fmaxf(fmaxf(fabsf(p.in[9][ln]), fabsf(p.in[9][64 + ln])), fabsf(p.in[9][128 + ln]));
#pragma unroll
      for (int o = 1; o < 64; o <<= 1) gm = fmaxf(gm, __shfl_xor(gm, o));
      kbound = 13.856406460551018f * 1.02f * gm; }
    const int nrp = (1024 + G - 1) / G, nrs = (256 + G - 1) / G;
    for (int rep = 0; rep < NREP(4); ++rep)
    for (int i = 0; i < nrp + nrs; ++i) { int pl, qb, seq, row0; size_t prow;
      if (i < nrp) { if (G == 256) { pl = 2 * (vcu >> 5) + (i >> 1); qb = (vcu & 31) + 32 * (i & 1); } else { const int uu = i * G + vcu; if (uu >= 1024) continue; pl = uu >> 6; qb = uu & 63; }
        prow = (size_t)pl * SEQP; seq = SEQP; row0 = (pl >> 3) * SEQP + qb * 256; }
      else { const int uu = (i - nrp) * G + vcu; if (uu >= 256) continue; pl = uu >> 3; qb = uu & 7; prow = (size_t)MP * NH + (size_t)pl * SEQS; seq = SEQS; row0 = MP + (pl >> 3) * SEQS + qb * 256; }
      const int h = pl & 7;
      att::attn_unit(Qt + (prow + qb * 256) * DK, Kt + prow * DK, Vt + prow * DV, mixed + (size_t)row0 * DM + h * 128, (rep ? dummy : ssq_a) + row0, seq, kbound, (char*)lds, ldsl); }
  }
#endif
  grid.sync(); STAMP(5);

  for (int rep = 0; rep < NREP(5); ++rep) { pg8::Gemm g{(const bf16_t*)(ws + WS_XB), (const bf16_t*)(ws + WS_BOUT), DM, DM, DM}; pg8::StaticOrder S; S.init(M, DM, G, bx);
    pg8::EpiOut E{p.in[0], p.in[1], p.out, (bf16_t*)(ws + WS_U), (const float*)(ws + WS_SSQ_A), (const float*)(ws + WS_SSQ_L), rep ? dummy : (float*)(ws + WS_SSQ_2)};

#ifndef NO_EPIOUT
    pg8::gemm_phase<pg8::EpiOut>(ldsl, g, S, E);
#endif
  }
  grid.sync(); STAMP(6);

  for (int rep = 0; rep < NREP(6); ++rep) { pg8::Gemm g{(const bf16_t*)(ws + WS_U), (const bf16_t*)(ws + WS_BGU), DM, 2 * DFF, DM}; pg8::StaticOrder S; S.init(M, 2 * DFF, G, bx);
    pg8::EpiGU E{(bf16_t*)(ws + WS_ACT), (const float*)(ws + WS_SSQ_2)};

#ifndef NO_EPIGU
    pg8::gemm_phase<pg8::EpiGU>(ldsl, g, S, E);
#endif
  }
  grid.sync(); STAMP(7);

  { pg8::Gemm g{(const bf16_t*)(ws + WS_ACT), (const bf16_t*)(ws + WS_BDN), DFF, DM, DFF}; pg8::StaticOrder S; S.init(M, DM, G, bx);
    pg8::EpiDown E{p.out};

#ifndef NO_EPIDOWN
    pg8::gemm_phase<pg8::EpiDown>(ldsl, g, S, E);
#endif
  }
  if (PROBE_TA >= 0) { grid.sync(); STAMP(8); if (bx == 0 && threadIdx.x == 0) p.out[(size_t)MP * DM + 12345] += (float)(t_b - t_a) * 1e-5f; }
}

extern "C" void kernel_launch(void* const* d_in, const int* in_sizes, int n_in, void* d_out, int out_size, void* d_ws, size_t ws_size, hipStream_t stream) {
  static int grid = 0;
  if (grid == 0) {
    if (n_in != 24 || out_size != M * DM || ws_size < WS_END) { fprintf(stderr, "kernel_launch: unexpected shapes: n_in %d out %d ws %zu (need %zu)\n", n_in, out_size, ws_size, (size_t)WS_END); grid = -1; return; }
    int dev = 0, cus = 0, per_cu = 0;
    hipGetDevice(&dev); hipDeviceGetAttribute(&cus, hipDeviceAttributeMultiprocessorCount, dev);
    if (hipFuncSetAttribute((const void*)hymba_fwd, hipFuncAttributeMaxDynamicSharedMemorySize, LDS_BYTES) != hipSuccess) { fprintf(stderr, "kernel_launch: hipFuncSetAttribute failed\n"); grid = -1; return; }
    if (hipOccupancyMaxActiveBlocksPerMultiprocessor(&per_cu, (const void*)hymba_fwd, 512, LDS_BYTES) != hipSuccess || per_cu < 1) { fprintf(stderr, "kernel_launch: occupancy query says %d\n", per_cu); per_cu = 1; }
    (void)hipGetLastError();
    grid = cus * 1;
  }
  if (grid < 0) return;
  Params p{};
  for (int i = 0; i < 24; ++i) p.in[i] = (const float*)d_in[i];
  p.out = (float*)d_out; p.ws = (unsigned char*)d_ws;
  void* args[] = {&p};
  hipError_t e = hipLaunchCooperativeKernel((const void*)hymba_fwd, dim3(grid), dim3(512), args, LDS_BYTES, stream);
  if (e != hipSuccess) fprintf(stderr, "cooperative launch failed: %s (grid %d)\n", hipGetErrorString(e), grid);
}
```
